# Optimizing an MI355X kernel written in HIP

```python
import math
import jax, jax.numpy as jnp
from jax import lax
import numpy as np

D_MODEL = 1024
BATCH = 4
SEQ = 4096
DEPTH = 1

GRID_W = 64
CTX_LEN = 256
N_HEADS = 8
HEAD_DIM = 64
V_DIM = 2 * HEAD_DIM
QK_W = N_HEADS * 2 * HEAD_DIM
ATTN_W = N_HEADS * V_DIM
S5_W = 512
S5_GROUP = 16
S5_GROUPS = S5_W // S5_GROUP
S5_STATE = 64
D_FF = 2816
CONV_W = 3
Q_BLOCK = 128
ROPE_THETA = 10000.0
EPS = 1e-6
MIN_NEG_RE = -1e-4
Q_OFF = 0
K_OFF = QK_W
V_OFF = 2 * QK_W
U_OFF = 2 * QK_W + ATTN_W
G_OFF = U_OFF + S5_W
N_IN = G_OFF + 2 * D_MODEL

kernel_name = 'hybrid_s5_diffattn_convffn_block'


def rms_norm(x, w):
    xf = x.astype(jnp.float32)
    y = xf * lax.rsqrt(jnp.mean(xf * xf, axis=-1, keepdims=True) + EPS)
    return y.astype(x.dtype) * w


def modulate(x, w, shift, scale):
    return rms_norm(x, w) * (1 + scale) + shift


def axial_rope_tables(rows):
    row = jnp.repeat(jnp.arange(rows), GRID_W).astype(jnp.float32)
    col = jnp.tile(jnp.arange(GRID_W), rows).astype(jnp.float32)
    half = HEAD_DIM // 2
    inv_freq = ROPE_THETA ** (-jnp.arange(0, half, 2, dtype=jnp.float32) / half)
    ang_r = row[:, None] * inv_freq
    ang_c = col[:, None] * inv_freq
    shp = (rows * GRID_W, 1, 1, half // 2)
    return (jnp.cos(ang_r).reshape(shp), jnp.sin(ang_r).reshape(shp),
            jnp.cos(ang_c).reshape(shp), jnp.sin(ang_c).reshape(shp))


def rope_1d(x, cos, sin):
    x1, x2 = jnp.split(x, 2, axis=-1)
    return jnp.concatenate([x1 * cos - x2 * sin, x2 * cos + x1 * sin], axis=-1)


def rope_2d(x, tabs):
    cos_r, sin_r, cos_c, sin_c = tabs
    x_row, x_col = jnp.split(x, 2, axis=-1)
    out = jnp.concatenate([rope_1d(x_row, cos_r, sin_r), rope_1d(x_col, cos_c, sin_c)], axis=-1)
    return out.astype(x.dtype)


def diff_attention(q, k, v, lam):
    s = jnp.einsum('bqhmd,bkhmd->bhmqk', q, k, preferred_element_type=jnp.float32) * (HEAD_DIM ** -0.5)
    p = jax.nn.softmax(s, axis=-1)
    a = p[:, :, 0] - lam.astype(jnp.float32) * p[:, :, 1]
    return jnp.einsum('bhqk,bkhe->bqhe', a.astype(v.dtype), v)


def blocked_latent_diff_attention(q, k_all, v_all, lam):
    b, l, h, m, dh = q.shape
    nb = l // Q_BLOCK
    qb = jnp.moveaxis(q.reshape(b, nb, Q_BLOCK, h, m, dh), 1, 0)
    ob = lax.map(lambda qi: diff_attention(qi, k_all, v_all, lam), qb)
    return jnp.moveaxis(ob, 0, 1).reshape(b, l, h, V_DIM)


def diff_head_out(o, subln_w, lam_init, w_branch):
    o = rms_norm(o, subln_w) * (1.0 - lam_init)
    return o.reshape(o.shape[0], o.shape[1], ATTN_W) @ w_branch


def s5_discretise(a_re, a_im, log_dt, b_re, b_im):
    lam = lax.complex(jnp.minimum(a_re.astype(jnp.float32), MIN_NEG_RE), a_im.astype(jnp.float32))
    dt = jnp.exp(log_dt.astype(jnp.float32))[:, None]
    a_bar = jnp.exp(lam * dt)
    b = lax.complex(b_re.astype(jnp.float32), b_im.astype(jnp.float32))
    b_bar = ((a_bar - 1.0) / lam)[..., None] * b
    return a_bar, b_bar


def ssm_combine(e1, e2):
    a1, b1 = e1
    a2, b2 = e2
    return a1 * a2, a2 * b1 + b2


def ssm_scan(bu, a_bar, s0, reverse):
    if s0 is not None:
        first = -1 if reverse else 0
        bu = bu.at[:, first].add(a_bar * s0)
    a = jnp.broadcast_to(a_bar, bu.shape)
    _, states = lax.associative_scan(ssm_combine, (a, bu), axis=1, reverse=reverse)
    return states


def s5_glu_proj(y, glu_w, glu_b, w_branch):
    h = jax.nn.gelu(y)
    return (h * jax.nn.sigmoid(h @ glu_w + glu_b)) @ w_branch


def s5_branch(u, uc, p, need_ctx):
    b, l, _ = u.shape
    n = uc.shape[1]
    ug = u.astype(jnp.float32).reshape(b, l, S5_GROUPS, S5_GROUP)
    ucg = uc.astype(jnp.float32).reshape(b, n, S5_GROUPS, S5_GROUP)
    d_skip = p['s5_d'].astype(jnp.float32)
    y = d_skip * u.astype(jnp.float32)
    yc = d_skip * uc.astype(jnp.float32) if need_ctx else None
    for d in range(2):
        rev = d == 1
        a_bar, b_bar = s5_discretise(p['s5_a_re'][d], p['s5_a_im'][d], p['s5_log_dt'][d],
                                     p['s5_b_re'][d], p['s5_b_im'][d])
        c_mat = lax.complex(p['s5_c_re'][d].astype(jnp.float32), p['s5_c_im'][d].astype(jnp.float32))
        s_ctx = ssm_scan(jnp.einsum('bngc,gpc->bngp', ucg, b_bar), a_bar, None, rev)
        s0 = s_ctx[:, 0] if rev else s_ctx[:, -1]
        s_lat = ssm_scan(jnp.einsum('blgc,gpc->blgp', ug, b_bar), a_bar, s0, rev)
        y = y + jnp.einsum('blgp,gcp->blgc', s_lat, c_mat).real.reshape(b, l, S5_W)
        if need_ctx:
            yc = yc + jnp.einsum('bngp,gcp->bngc', s_ctx, c_mat).real.reshape(b, n, S5_W)
    ys = s5_glu_proj(y.astype(u.dtype), p['glu_w'], p['glu_b'], p['w_branch_s5'])
    ysc = s5_glu_proj(yc.astype(uc.dtype), p['glu_w'], p['glu_b'], p['w_branch_s5']) if need_ctx else None
    return ys, ysc


def merge_branches(g, y_s5, y_attn, b_gate, w_out):
    g_s, g_a = jnp.split(g + b_gate, 2, axis=-1)
    return (jax.nn.sigmoid(g_s) * y_s5 + jax.nn.sigmoid(g_a) * y_attn) @ w_out


def conv_ffn(h, w_up, conv_w, conv_b, w_down):
    u = h @ w_up
    n = u.shape[1]
    pad = CONV_W // 2
    up = jnp.pad(u, ((0, 0), (pad, pad), (0, 0)))
    y = conv_b
    for j in range(CONV_W):
        y = y + up[:, j:j + n] * conv_w[j]
    a, g = jnp.split(y, 2, axis=-1)
    return (jax.nn.silu(g) * a) @ w_down


def hybrid_layer(x, xc, mod_x, mod_c, rope, p, lam_init, update_ctx):
    b, l, _ = x.shape
    n = xc.shape[1]
    sh1, sc1, ga1, sh2, sc2, ga2 = jnp.split(mod_x, 6, axis=-1)
    csh1, csc1, cga1, csh2, csc2, cga2 = jnp.split(mod_c, 6, axis=-1)
    w_in = p['w_in']
    z = modulate(x, p['norm1_w'], sh1, sc1) @ w_in
    q = rms_norm(z[..., Q_OFF:K_OFF].reshape(b, l, N_HEADS, 2, HEAD_DIM), p['q_norm_w'])
    k = rms_norm(z[..., K_OFF:V_OFF].reshape(b, l, N_HEADS, 2, HEAD_DIM), p['k_norm_w'])
    v = z[..., V_OFF:U_OFF].reshape(b, l, N_HEADS, V_DIM)
    u = z[..., U_OFF:G_OFF]
    g = z[..., G_OFF:]
    q = rope_2d(q, rope)
    k = rope_2d(k, rope)
    hc = modulate(xc, p['norm1_w'], csh1, csc1)
    zc = hc @ w_in[:, K_OFF:G_OFF]
    kc = rms_norm(zc[..., :QK_W].reshape(b, n, N_HEADS, 2, HEAD_DIM), p['k_norm_w'])
    vc = zc[..., QK_W:QK_W + ATTN_W].reshape(b, n, N_HEADS, V_DIM)
    uc = zc[..., QK_W + ATTN_W:]
    lam = (jnp.exp(jnp.sum((p['lam_q1'] * p['lam_k1']).astype(jnp.float32)))
           - jnp.exp(jnp.sum((p['lam_q2'] * p['lam_k2']).astype(jnp.float32))) + lam_init)
    k_all = jnp.concatenate([kc, k], axis=1)
    v_all = jnp.concatenate([vc, v], axis=1)
    y_attn = diff_head_out(blocked_latent_diff_attention(q, k_all, v_all, lam),
                           p['subln_w'], lam_init, p['w_branch_attn'])
    y_s5, y_s5_c = s5_branch(u, uc, p, update_ctx)
    x = x + ga1 * merge_branches(g, y_s5, y_attn, p['b_gate'], p['w_out'])
    x = x + ga2 * conv_ffn(modulate(x, p['norm2_w'], sh2, sc2), p['w_up'], p['conv_w'], p['conv_b'], p['w_down'])
    if update_ctx:
        qc = rms_norm((hc @ w_in[:, Q_OFF:K_OFF]).reshape(b, n, N_HEADS, 2, HEAD_DIM), p['q_norm_w'])
        gc = hc @ w_in[:, G_OFF:]
        yc_attn = diff_head_out(diff_attention(qc, kc, vc, lam), p['subln_w'], lam_init, p['w_branch_attn'])
        xc = xc + cga1 * merge_branches(gc, y_s5_c, yc_attn, p['b_gate'], p['w_out'])
        xc = xc + cga2 * conv_ffn(modulate(xc, p['norm2_w'], csh2, csc2), p['w_up'], p['conv_w'], p['conv_b'], p['w_down'])
    return x, xc


def setup_inputs(seed: int = 0) -> dict:
    key = jax.random.key(seed)
    ks = iter(jax.random.split(key, 40))

    def nrm(shape, s):
        return jax.random.normal(next(ks), shape, jnp.float32) * s

    G, P = S5_GROUPS, S5_STATE
    return {
        'x': nrm((BATCH, SEQ, D_MODEL), 1.0),
        'c': nrm((BATCH, D_MODEL), 1.0),
        'ctx': nrm((BATCH, CTX_LEN, D_MODEL), 1.0),
        'c_ctx': nrm((D_MODEL,), 1.0),
        'ada_w': nrm((DEPTH, D_MODEL, 6 * D_MODEL), 0.5 * D_MODEL ** -0.5),
        'ada_b': nrm((DEPTH, 6 * D_MODEL), 0.01),
        'norm1_w': 1.0 + nrm((DEPTH, D_MODEL), 0.01),
        'w_in': nrm((DEPTH, D_MODEL, N_IN), D_MODEL ** -0.5),
        'b_gate': nrm((DEPTH, 2 * D_MODEL), 0.01),
        'q_norm_w': 1.0 + nrm((DEPTH, HEAD_DIM), 0.01),
        'k_norm_w': 1.0 + nrm((DEPTH, HEAD_DIM), 0.01),
        'lam_q1': nrm((DEPTH, HEAD_DIM), 0.1),
        'lam_k1': nrm((DEPTH, HEAD_DIM), 0.1),
        'lam_q2': nrm((DEPTH, HEAD_DIM), 0.1),
        'lam_k2': nrm((DEPTH, HEAD_DIM), 0.1),
        'subln_w': 1.0 + nrm((DEPTH, V_DIM), 0.01),
        's5_a_re': -0.5 + nrm((DEPTH, 2, G, P), 0.01),
        's5_a_im': jnp.pi * jnp.arange(P, dtype=jnp.float32) + nrm((DEPTH, 2, G, P), 0.01),
        's5_log_dt': jax.random.uniform(next(ks), (DEPTH, 2, G), jnp.float32, math.log(1e-3), math.log(1e-1)),
        's5_b_re': nrm((DEPTH, 2, G, P, S5_GROUP), (2 * S5_GROUP) ** -0.5),
        's5_b_im': nrm((DEPTH, 2, G, P, S5_GROUP), (2 * S5_GROUP) ** -0.5),
        's5_c_re': nrm((DEPTH, 2, G, S5_GROUP, P), (2 * P) ** -0.5),
        's5_c_im': nrm((DEPTH, 2, G, S5_GROUP, P), (2 * P) ** -0.5),
        's5_d': nrm((DEPTH, S5_W), 1.0),
        'glu_w': nrm((DEPTH, S5_W, S5_W), S5_W ** -0.5),
        'glu_b': nrm((DEPTH, S5_W), 0.01),
        'w_branch_s5': nrm((DEPTH, S5_W, D_MODEL), S5_W ** -0.5),
        'w_branch_attn': nrm((DEPTH, ATTN_W, D_MODEL), ATTN_W ** -0.5),
        'w_out': nrm((DEPTH, D_MODEL, D_MODEL), D_MODEL ** -0.5),
        'norm2_w': 1.0 + nrm((DEPTH, D_MODEL), 0.01),
        'w_up': nrm((DEPTH, D_MODEL, 2 * D_FF), D_MODEL ** -0.5),
        'conv_w': nrm((DEPTH, CONV_W, 2 * D_FF), CONV_W ** -0.5),
        'conv_b': nrm((DEPTH, 2 * D_FF), 0.01),
        'w_down': nrm((DEPTH, D_FF, D_MODEL), D_FF ** -0.5),
    }


def reference(x, c, ctx, c_ctx, ada_w, ada_b, norm1_w, w_in, b_gate, q_norm_w, k_norm_w,
              lam_q1, lam_k1, lam_q2, lam_k2, subln_w, s5_a_re, s5_a_im, s5_log_dt,
              s5_b_re, s5_b_im, s5_c_re, s5_c_im, s5_d, glu_w, glu_b, w_branch_s5,
              w_branch_attn, w_out, norm2_w, w_up, conv_w, conv_b, w_down):
    rows = x.shape[1] // GRID_W
    rope = axial_rope_tables(rows)
    xc = ctx
    for li in range(DEPTH):
        p = {
            'norm1_w': norm1_w[li], 'w_in': w_in[li], 'b_gate': b_gate[li],
            'q_norm_w': q_norm_w[li], 'k_norm_w': k_norm_w[li],
            'lam_q1': lam_q1[li], 'lam_k1': lam_k1[li], 'lam_q2': lam_q2[li], 'lam_k2': lam_k2[li],
            'subln_w': subln_w[li],
            's5_a_re': s5_a_re[li], 's5_a_im': s5_a_im[li], 's5_log_dt': s5_log_dt[li],
            's5_b_re': s5_b_re[li], 's5_b_im': s5_b_im[li], 's5_c_re': s5_c_re[li], 's5_c_im': s5_c_im[li],
            's5_d': s5_d[li], 'glu_w': glu_w[li], 'glu_b': glu_b[li],
            'w_branch_s5': w_branch_s5[li], 'w_branch_attn': w_branch_attn[li], 'w_out': w_out[li],
            'norm2_w': norm2_w[li], 'w_up': w_up[li], 'conv_w': conv_w[li], 'conv_b': conv_b[li],
            'w_down': w_down[li],
        }
        mod_x = (jax.nn.silu(c) @ ada_w[li] + ada_b[li])[:, None, :]
        mod_c = (jax.nn.silu(c_ctx) @ ada_w[li] + ada_b[li])[None, None, :]
        lam_init = 0.8 - 0.6 * math.exp(-0.3 * li)
        x, xc = hybrid_layer(x, xc, mod_x, mod_c, rope, p, lam_init, li + 1 < DEPTH)
    return x
```

```cpp
#include <hip/hip_runtime.h>
#include <cstdint>
#include <cstdio>

constexpr int NB = 4, SEQL = 4096, NCTX = 256, DM = 1024, MR = NB * SEQL, MCX = NB * NCTX, MT = MR + MCX;
constexpr int NHEAD = 8, HDIM = 64, VDIM = 128, S5W = 512, NGRP = 32, NST = 64, DFF = 2816, NIN = 5632;
constexpr int KOFF = 1024, VOFF = 2048, UOFF = 3072, GOFF = 3584;
constexpr int NKEY = NCTX + SEQL, NKT = NKEY / 64, NCH = SEQL / 16 + NCTX / 16;
constexpr float EPSN = 1e-6f, LAM_INIT = 0.2f;
constexpr float C2 = 0.125f * 1.4426950408889634f;

typedef unsigned short bf16_t;
__host__ __device__ __forceinline__ float bf2f(bf16_t v) { union { unsigned u; float f; } x; x.u = ((unsigned)v) << 16; return x.f; }
__host__ __device__ __forceinline__ bf16_t f2bf(float f) { union { unsigned u; float f; } x; x.f = f; return (bf16_t)((x.u + 0x7fffu + ((x.u >> 16) & 1u)) >> 16); }

constexpr size_t MiB = 1u << 20;
constexpr size_t WS_CTL = 0;
constexpr size_t WS_MODPART = 1 * MiB;
constexpr size_t WS_MODFIN = 2 * MiB;
constexpr size_t WS_BIASUP = 2 * MiB + 128 * 1024;
constexpr size_t WS_ROPE = 2 * MiB + 256 * 1024;
constexpr size_t WS_ROWSQ = 2 * MiB + 512 * 1024;
constexpr size_t WS_BIASPART = 4 * MiB;
constexpr size_t WS_WIN = 6 * MiB;
constexpr size_t WS_WUP = 17 * MiB;
constexpr size_t WS_WDOWN = 28 * MiB;
constexpr size_t WS_WOUT = 34 * MiB;
constexpr size_t WS_WBA = 36 * MiB;
constexpr size_t WS_WBS = 38 * MiB;
constexpr size_t WS_WGLU = 39 * MiB;
constexpr size_t WS_TQ = 40 * MiB;
constexpr size_t WS_PST = 48 * MiB;
constexpr size_t WS_RH = 52 * MiB;
constexpr size_t WS_RQ = 86 * MiB;
constexpr size_t WS_RK = 118 * MiB;
constexpr size_t WS_RV = 152 * MiB;
constexpr size_t WS_RU = 186 * MiB;
constexpr size_t WS_HS = 221 * MiB;
constexpr size_t WS_END = 237 * MiB;
constexpr size_t WS_T = WS_RK;
constexpr size_t WS_MB = WS_RU;
constexpr size_t WS_X1B = WS_RH + 8192;
constexpr size_t WS_HS2 = WS_RH;
constexpr size_t WS_ACT = WS_RK;
constexpr size_t WS_YTF = WS_RH;
constexpr size_t WS_YTB = WS_RK;

__host__ __device__ __forceinline__ size_t q_idx(int b, int t, int h, int m, int d) { return ((size_t)(b * SEQL + t)) * 1024 + h * 128 + m * 64 + d; }
__host__ __device__ __forceinline__ size_t k_idx(int b, int h, int m, int key, int d) {
    return ((((((size_t)(b * NHEAD + h) * 2 + m) * NKT + (key >> 6)) * 8 + (d >> 3)) * 64 + (key & 63)) * 8) + (d & 7);
}
__host__ __device__ __forceinline__ size_t v_idx(int b, int h, int key, int d) {
    const int row = key & 63;
    return (((((size_t)(b * NHEAD + h) * NKT + (key >> 6)) * 16 + (d >> 5) * 4 + (row >> 4)) * 16 + (row & 15)) * 32) + (d & 31);
}
__host__ __device__ __forceinline__ size_t u_idx(int b, int g, int chunk, int sig, int c) { return (((size_t)(b * NGRP + g) * NCH + chunk) * 512) + sig * 16 + c; }

struct Ptrs {
    const float* in[34];
    float* out;
    unsigned char* ws;
};
#define IN_X 0
#define IN_C 1
#define IN_CTX 2
#define IN_CCTX 3
#define IN_ADAW 4
#define IN_ADAB 5
#define IN_N1W 6
#define IN_WIN 7
#define IN_BGATE 8
#define IN_QNW 9
#define IN_KNW 10
#define IN_LQ1 11
#define IN_LK1 12
#define IN_LQ2 13
#define IN_LK2 14
#define IN_SUBLN 15
#define IN_ARE 16
#define IN_AIM 17
#define IN_LOGDT 18
#define IN_BRE 19
#define IN_BIM 20
#define IN_CRE 21
#define IN_CIM 22
#define IN_S5D 23
#define IN_GLUW 24
#define IN_GLUB 25
#define IN_WBS 26
#define IN_WBA 27
#define IN_WOUT 28
#define IN_N2W 29
#define IN_WUP 30
#define IN_CONVW 31
#define IN_CONVB 32
#define IN_WDOWN 33

__device__ __forceinline__ float wave_sum(float v) {
#pragma unroll
    for (int o = 1; o < 64; o <<= 1) v += __shfl_xor(v, o);
    return v;
}
__device__ __forceinline__ float wave_max(float v) {
#pragma unroll
    for (int o = 1; o < 64; o <<= 1) v = fmaxf(v, __shfl_xor(v, o));
    return v;
}
__device__ __forceinline__ float sigmoidf_(float x) { return 1.f / (1.f + __expf(-x)); }
__device__ __forceinline__ float siluf_(float x) { return x / (1.f + __expf(-x)); }
__device__ __forceinline__ float gelu_tanh(float x) { const float u = 0.7978845608028654f * (x + 0.044715f * x * x * x); return 0.5f * x * (1.f + tanhf(u)); }

__global__ void nk_mod(Ptrs P) {
    const int col = blockIdx.x * 256 + threadIdx.x, row = blockIdx.y;
    const float* cv = row < 4 ? P.in[IN_C] + row * DM : P.in[IN_CCTX];
    const float* W = P.in[IN_ADAW];
    float acc = 0.f;
    for (int k = 0; k < DM; ++k) acc += siluf_(cv[k]) * W[(size_t)k * 6144 + col];
    ((float*)(P.ws + WS_MODFIN))[row * 6144 + col] = acc + P.in[IN_ADAB][col];
}
__global__ void nk_biasup(Ptrs P) {
    const int n = blockIdx.x * 256 + threadIdx.x, b = blockIdx.y;
    const float* sh2 = (const float*)(P.ws + WS_MODFIN) + b * 6144 + 3072;
    const float* W = P.in[IN_WUP];
    float acc = 0.f;
    for (int k = 0; k < DM; ++k) acc += sh2[k] * W[(size_t)k * NIN + n];
    ((float*)(P.ws + WS_BIASUP))[b * NIN + n] = acc;
}
__global__ void nk_rope(Ptrs P) {
    const int i = blockIdx.x * 256 + threadIdx.x;
    const int pos = i >> 4, f = i & 15;
    const float inv = powf(10000.f, -(float)(2 * f) / 32.f);
    const float ang = (float)pos * inv;
    float* tab = (float*)(P.ws + WS_ROPE);
    tab[2 * i] = cosf(ang); tab[2 * i + 1] = sinf(ang);
}
__global__ void nk_modulate(Ptrs P) {
    const int r = blockIdx.x * 4 + (threadIdx.x >> 6), lane = threadIdx.x & 63;
    if (r >= MT) return;
    const float* xr = r < MR ? P.in[IN_X] + (size_t)r * DM : P.in[IN_CTX] + (size_t)(r - MR) * DM;
    const float* mod = (const float*)(P.ws + WS_MODFIN) + (r < MR ? r / SEQL : 4) * 6144;
    const float* w = P.in[IN_N1W];
    float v[16]; float ss = 0.f;
#pragma unroll
    for (int j = 0; j < 16; ++j) { v[j] = xr[lane + 64 * j]; ss += v[j] * v[j]; }
    const float rstd = rsqrtf(wave_sum(ss) * (1.f / DM) + EPSN);
    bf16_t* H = (bf16_t*)(P.ws + WS_RH) + (size_t)r * DM;
#pragma unroll
    for (int j = 0; j < 16; ++j) { const int k = lane + 64 * j; H[k] = f2bf(v[j] * rstd * w[k] * (1.f + mod[1024 + k]) + mod[k]); }
}

__device__ void ntile(const bf16_t* A, int lda, long row0, long rowmax, const float* W, int ldw, int col0, int K, float (*Z)[65]) {
    __shared__ float As[16][65];
    __shared__ float Ws[16][64];
    const int tid = threadIdx.x, tx = tid & 15, ty = tid >> 4;
    float acc[4][4];
#pragma unroll
    for (int i = 0; i < 4; ++i)
#pragma unroll
        for (int j = 0; j < 4; ++j) acc[i][j] = 0.f;
    for (int k0 = 0; k0 < K; k0 += 16) {
        {
            const int ar = tid >> 2, ak = (tid & 3) * 4;
            long gr = row0 + ar; gr = gr < 0 ? 0 : (gr > rowmax ? rowmax : gr);
            const bf16_t* ap = A + (size_t)gr * lda + k0 + ak;
#pragma unroll
            for (int q = 0; q < 4; ++q) As[ak + q][ar] = bf2f(ap[q]);
            const int wk = tid >> 4, wc = (tid & 15) * 4;
            const float4 wv = *(const float4*)(W + (size_t)(k0 + wk) * ldw + col0 + wc);
            Ws[wk][wc] = wv.x; Ws[wk][wc + 1] = wv.y; Ws[wk][wc + 2] = wv.z; Ws[wk][wc + 3] = wv.w;
        }
        __syncthreads();
#pragma unroll
        for (int kk = 0; kk < 16; ++kk) {
            float a[4], w[4];
#pragma unroll
            for (int i = 0; i < 4; ++i) a[i] = As[kk][ty * 4 + i];
#pragma unroll
            for (int j = 0; j < 4; ++j) w[j] = Ws[kk][tx * 4 + j];
#pragma unroll
            for (int i = 0; i < 4; ++i)
#pragma unroll
                for (int j = 0; j < 4; ++j) acc[i][j] += a[i] * w[j];
        }
        __syncthreads();
    }
#pragma unroll
    for (int i = 0; i < 4; ++i)
#pragma unroll
        for (int j = 0; j < 4; ++j) Z[ty * 4 + i][tx * 4 + j] = acc[i][j];
    __syncthreads();
}

__global__ void __launch_bounds__(256) nk_inproj(Ptrs P) {
    __shared__ float Z[64][65];
    const int c0 = blockIdx.x * 64; const long r0 = (long)blockIdx.y * 64;
    ntile((const bf16_t*)(P.ws + WS_RH), DM, r0, MT - 1, P.in[IN_WIN], NIN, c0, DM, Z);
    const int tid = threadIdx.x, lr = tid >> 2, j0 = (tid & 3) * 16;
    const int r = (int)r0 + lr;
    const bool isctx = r >= MR;
    const int b = isctx ? (r - MR) / NCTX : r / SEQL, t = isctx ? (r - MR) % NCTX : r % SEQL;
    const int key = isctx ? t : NCTX + t, chunk = isctx ? 256 + (t >> 4) : (t >> 4), sig = t & 15;
    const float* zr = Z[lr];
    if (c0 < VOFF) {
        const bool isq = c0 < KOFF;
        if (isq && isctx) return;
        const float* w = isq ? P.in[IN_QNW] : P.in[IN_KNW];
        float ss = 0.f;
        for (int j = 0; j < 64; ++j) ss += zr[j] * zr[j];
        const float rs = rsqrtf(ss * (1.f / 64.f) + EPSN);
        const int cc = isq ? c0 : c0 - KOFF, h = cc / 128, m = (cc / 64) & 1;
        const float* tab = (const float*)(P.ws + WS_ROPE);
        for (int d = j0; d < j0 + 16; ++d) {
            float val = zr[d] * rs * w[d];
            if (!isctx) {
                const int half = d >> 5, dd = d & 31, i = dd & 15, second = dd >> 4;
                const int pd = second ? d - 16 : d + 16;
                const float pv = zr[pd] * rs * w[pd];
                const int pos = half == 0 ? (t >> 6) : (t & 63);
                const float cs = tab[(pos * 16 + i) * 2], sn = tab[(pos * 16 + i) * 2 + 1];
                val = second ? (val * cs + pv * sn) : (val * cs - pv * sn);
            }
            if (isq) ((bf16_t*)(P.ws + WS_RQ))[q_idx(b, t, h, m, d)] = f2bf(val * C2);
            else ((bf16_t*)(P.ws + WS_RK))[k_idx(b, h, m, key, d)] = f2bf(val);
        }
    } else if (c0 < UOFF) {
        const int cc = c0 - VOFF, h = cc / 128, dbase = cc % 128;
        for (int j = j0; j < j0 + 16; ++j) ((bf16_t*)(P.ws + WS_RV))[v_idx(b, h, key, dbase + j)] = f2bf(zr[j]);
    } else if (c0 < GOFF) {
        for (int j = j0; j < j0 + 16; ++j) { const int cc = c0 - UOFF + j; ((bf16_t*)(P.ws + WS_RU))[u_idx(b, cc >> 4, chunk, sig, cc & 15)] = f2bf(zr[j]); }
    } else {
        if (isctx) return;
        bf16_t* G = (bf16_t*)P.out;
        for (int j = j0; j < j0 + 16; ++j) { const int cc = c0 - GOFF + j; G[(size_t)r * 2048 + cc] = f2bf(sigmoidf_(zr[j] + P.in[IN_BGATE][cc])); }
    }
}

__global__ void __launch_bounds__(64) nk_attn(Ptrs P) {
    __shared__ float p0[NKEY], p1[NKEY], qs[128];
    const int bid = blockIdx.x, lane = threadIdx.x;
    const int b = bid / (NHEAD * SEQL), h = (bid / SEQL) % NHEAD, t = bid % SEQL;
    bf16_t* Q = (bf16_t*)(P.ws + WS_RQ); const bf16_t* K = (const bf16_t*)(P.ws + WS_RK); const bf16_t* V = (const bf16_t*)(P.ws + WS_RV);
    qs[lane] = bf2f(Q[q_idx(b, t, h, 0, lane)]); qs[64 + lane] = bf2f(Q[q_idx(b, t, h, 1, lane)]);
    const float lam = __expf(wave_sum(P.in[IN_LQ1][lane] * P.in[IN_LK1][lane])) - __expf(wave_sum(P.in[IN_LQ2][lane] * P.in[IN_LK2][lane])) + LAM_INIT;
    const float mshift = 8.f * 1.4426950408889634f * wave_max(fabsf(P.in[IN_QNW][lane])) * wave_max(fabsf(P.in[IN_KNW][lane]));
    __syncthreads();
    float l0 = 0.f, l1 = 0.f;
    for (int i = 0; i < NKT; ++i) {
        const int key = i * 64 + lane;
#pragma unroll
        for (int m = 0; m < 2; ++m) {
            float s = 0.f;
#pragma unroll
            for (int ch = 0; ch < 8; ++ch) {
                const uint4 kv = *(const uint4*)(K + k_idx(b, h, m, key, ch * 8));
                const unsigned w[4] = {kv.x, kv.y, kv.z, kv.w};
#pragma unroll
                for (int e = 0; e < 4; ++e) { s += qs[m * 64 + ch * 8 + 2 * e] * bf2f((bf16_t)(w[e] & 0xffff)) + qs[m * 64 + ch * 8 + 2 * e + 1] * bf2f((bf16_t)(w[e] >> 16)); }
            }
            const float p = exp2f(s - mshift);
            if (m == 0) { p0[key] = p; l0 += p; } else { p1[key] = p; l1 += p; }
        }
    }
    l0 = wave_sum(l0); l1 = wave_sum(l1);
    __syncthreads();
    const float i0 = 1.f / l0, i1 = lam / l1;
    float o0 = 0.f, o1 = 0.f;
    for (int key = 0; key < NKEY; ++key) {
        const float a = p0[key] * i0 - p1[key] * i1;
        o0 += a * bf2f(V[v_idx(b, h, key, lane)]); o1 += a * bf2f(V[v_idx(b, h, key, lane + 64)]);
    }
    const float rs = rsqrtf(wave_sum(o0 * o0 + o1 * o1) * (1.f / 128.f) + EPSN) * (1.f - LAM_INIT);
    bf16_t* On = Q;
    const size_t ob = ((size_t)(b * SEQL + t)) * 1024 + h * 128;
    On[ob + lane] = f2bf(o0 * rs * P.in[IN_SUBLN][lane]); On[ob + 64 + lane] = f2bf(o1 * rs * P.in[IN_SUBLN][64 + lane]);
}

__global__ void __launch_bounds__(128) nk_s5(Ptrs P) {
    const int b = blockIdx.x / NGRP, g = blockIdx.x % NGRP, d = threadIdx.x >> 6, p = threadIdx.x & 63;
    const int gi = (d * NGRP + g) * NST + p;
    const float lre = fminf(P.in[IN_ARE][gi], -1e-4f), lim = P.in[IN_AIM][gi], dt = __expf(P.in[IN_LOGDT][d * NGRP + g]);
    const float mag = __expf(lre * dt); float sn, cs; sincosf(lim * dt, &sn, &cs);
    const float ar = mag * cs, ai = mag * sn;
    const float nr = ar - 1.f, ni = ai, den = lre * lre + lim * lim;
    const float fr = (nr * lre + ni * lim) / den, fi = (ni * lre - nr * lim) / den;
    float bre[16], bim[16], cre[16], cim[16];
#pragma unroll
    for (int c = 0; c < 16; ++c) {
        const float br = P.in[IN_BRE][(size_t)gi * 16 + c], bi = P.in[IN_BIM][(size_t)gi * 16 + c];
        bre[c] = fr * br - fi * bi; bim[c] = fr * bi + fi * br;
        cre[c] = P.in[IN_CRE][((size_t)(d * NGRP + g) * 16 + c) * NST + p]; cim[c] = P.in[IN_CIM][((size_t)(d * NGRP + g) * 16 + c) * NST + p];
    }
    const bf16_t* U = (const bf16_t*)(P.ws + WS_RU);
    float* yt = (float*)(P.ws + (d == 0 ? WS_YTF : WS_YTB)) + (size_t)(b * NGRP + g) * SEQL * 16;
    float sr = 0.f, si = 0.f;
    for (int step = 0; step < NKEY; ++step) {
        const bool isctx = step < NCTX;
        const int idx = isctx ? step : step - NCTX;
        const int t = d == 0 ? idx : (isctx ? NCTX - 1 - idx : SEQL - 1 - idx);
        const int chunk = isctx ? 256 + (t >> 4) : (t >> 4);
        const bf16_t* up = U + u_idx(b, g, chunk, t & 15, 0);
        float bur = 0.f, bui = 0.f;
#pragma unroll
        for (int c = 0; c < 16; ++c) { const float u = bf2f(up[c]); bur += bre[c] * u; bui += bim[c] * u; }
        const float nsr = ar * sr - ai * si + bur, nsi = ar * si + ai * sr + bui;
        sr = nsr; si = nsi;
        if (!isctx) {
            float mine = 0.f;
#pragma unroll
            for (int c = 0; c < 16; ++c) { const float v = wave_sum(cre[c] * sr - cim[c] * si); if (p == c) mine = v; }
            if (p < 16) yt[(size_t)t * 16 + p] = mine;
        }
    }
}
__global__ void nk_s5fin(Ptrs P) {
    const size_t i = (size_t)blockIdx.x * 256 + threadIdx.x;
    const int ch = (int)(i % 512); const size_t bt = i / 512; const int b = (int)(bt / SEQL), t = (int)(bt % SEQL), g = ch >> 4, c = ch & 15;
    const float u = bf2f(((const bf16_t*)(P.ws + WS_RU))[u_idx(b, g, t >> 4, t & 15, c)]);
    const size_t yi = ((size_t)(b * NGRP + g) * SEQL + t) * 16 + c;
    const float y = P.in[IN_S5D][ch] * u + ((const float*)(P.ws + WS_YTF))[yi] + ((const float*)(P.ws + WS_YTB))[yi];
    ((bf16_t*)(P.ws + WS_HS))[i] = f2bf(gelu_tanh(y));
}

__global__ void __launch_bounds__(256) nk_glu(Ptrs P) {
    __shared__ float Z[64][65];
    const int c0 = blockIdx.x * 64; const long r0 = (long)blockIdx.y * 64;
    const bf16_t* Hs = (const bf16_t*)(P.ws + WS_HS);
    ntile(Hs, S5W, r0, MR - 1, P.in[IN_GLUW], S5W, c0, S5W, Z);
    const int lr = threadIdx.x >> 2, j0 = (threadIdx.x & 3) * 16; const size_t r = r0 + lr;
    for (int j = j0; j < j0 + 16; ++j) { const int c = c0 + j; ((bf16_t*)(P.ws + WS_HS2))[r * S5W + c] = f2bf(bf2f(Hs[r * S5W + c]) * sigmoidf_(Z[lr][j] + P.in[IN_GLUB][c])); }
}
__global__ void __launch_bounds__(256) nk_ys(Ptrs P) {
    __shared__ float Z[64][65];
    const int c0 = blockIdx.x * 64; const long r0 = (long)blockIdx.y * 64;
    ntile((const bf16_t*)(P.ws + WS_HS2), S5W, r0, MR - 1, P.in[IN_WBS], DM, c0, S5W, Z);
    const int lr = threadIdx.x >> 2, j0 = (threadIdx.x & 3) * 16; const size_t r = r0 + lr;
    const bf16_t* G = (const bf16_t*)P.out;
    for (int j = j0; j < j0 + 16; ++j) { const int c = c0 + j; ((float*)(P.ws + WS_T))[r * DM + c] = bf2f(G[r * 2048 + c]) * Z[lr][j]; }
}
__global__ void __launch_bounds__(256) nk_ya(Ptrs P) {
    __shared__ float Z[64][65];
    const int c0 = blockIdx.x * 64; const long r0 = (long)blockIdx.y * 64;
    ntile((const bf16_t*)(P.ws + WS_RQ), DM, r0, MR - 1, P.in[IN_WBA], DM, c0, DM, Z);
    const int lr = threadIdx.x >> 2, j0 = (threadIdx.x & 3) * 16; const size_t r = r0 + lr;
    const bf16_t* G = (const bf16_t*)P.out;
    for (int j = j0; j < j0 + 16; ++j) { const int c = c0 + j; ((bf16_t*)(P.ws + WS_MB))[r * DM + c] = f2bf(((const float*)(P.ws + WS_T))[r * DM + c] + bf2f(G[r * 2048 + 1024 + c]) * Z[lr][j]); }
}
__global__ void __launch_bounds__(256) nk_out(Ptrs P) {
    __shared__ float Z[64][65];
    const int c0 = blockIdx.x * 64; const long r0 = (long)blockIdx.y * 64;
    ntile((const bf16_t*)(P.ws + WS_MB), DM, r0, MR - 1, P.in[IN_WOUT], DM, c0, DM, Z);
    const int lr = threadIdx.x >> 2, j0 = (threadIdx.x & 3) * 16; const size_t r = r0 + lr; const int b = (int)(r / SEQL);
    const float* mod = (const float*)(P.ws + WS_MODFIN) + b * 6144;
    float ss = 0.f;
    for (int j = j0; j < j0 + 16; ++j) {
        const int c = c0 + j;
        const float x1 = P.in[IN_X][r * DM + c] + mod[2048 + c] * Z[lr][j];
        Z[lr][j] = x1;
        ((bf16_t*)(P.ws + WS_X1B))[r * DM + c] = f2bf(x1 * P.in[IN_N2W][c] * (1.f + mod[4096 + c]));
        ss += x1 * x1;
    }
    ss += __shfl_xor(ss, 1); ss += __shfl_xor(ss, 2);
    if ((threadIdx.x & 3) == 0) ((float*)(P.ws + WS_ROWSQ))[(size_t)blockIdx.x * MR + r] = ss;
    __syncthreads();
    for (int j = j0; j < j0 + 16; ++j) P.out[r * DM + c0 + j] = Z[lr][j];
}
__global__ void __launch_bounds__(256) nk_up(Ptrs P) {
    __shared__ float Za[64][65];
    __shared__ float Zg[64][65];
    const int c0 = blockIdx.x * 64;
    const int b = blockIdx.y / 67, ti = blockIdx.y % 67;
    const long r0 = (long)b * SEQL + 62 * ti - 1;
    const bf16_t* A = (const bf16_t*)(P.ws + WS_X1B);
    ntile(A, DM, r0, MR - 1, P.in[IN_WUP], NIN, c0, DM, Za);
    ntile(A, DM, r0, MR - 1, P.in[IN_WUP], NIN, DFF + c0, DM, Zg);
    const int lr = threadIdx.x >> 2, j0 = (threadIdx.x & 3) * 16;
    {
        const int tok = 62 * ti + lr - 1; const bool valid = tok >= 0 && tok < SEQL;
        float rstd = 0.f;
        if (valid) { const size_t r = (size_t)b * SEQL + tok; float s = 0.f; for (int q = 0; q < 16; ++q) s += ((const float*)(P.ws + WS_ROWSQ))[(size_t)q * MR + r]; rstd = rsqrtf(s * (1.f / DM) + EPSN); }
        const float* bu = (const float*)(P.ws + WS_BIASUP) + b * NIN;
        for (int j = j0; j < j0 + 16; ++j) { Za[lr][j] = valid ? rstd * Za[lr][j] + bu[c0 + j] : 0.f; Zg[lr][j] = valid ? rstd * Zg[lr][j] + bu[DFF + c0 + j] : 0.f; }
    }
    __syncthreads();
    const int tok = 62 * ti + lr - 1;
    if (lr >= 1 && lr <= 62 && tok < SEQL) {
        const float* cw = P.in[IN_CONVW]; const float* cb = P.in[IN_CONVB];
        const size_t r = (size_t)b * SEQL + tok;
        for (int j = j0; j < j0 + 16; ++j) {
            const int ca = c0 + j, cg = DFF + c0 + j;
            const float ya = cb[ca] + cw[ca] * Za[lr - 1][j] + cw[NIN + ca] * Za[lr][j] + cw[2 * NIN + ca] * Za[lr + 1][j];
            const float yg = cb[cg] + cw[cg] * Zg[lr - 1][j] + cw[NIN + cg] * Zg[lr][j] + cw[2 * NIN + cg] * Zg[lr + 1][j];
            ((bf16_t*)(P.ws + WS_ACT))[r * DFF + ca] = f2bf(siluf_(yg) * ya);
        }
    }
}
__global__ void __launch_bounds__(256) nk_down(Ptrs P) {
    __shared__ float Z[64][65];
    const int c0 = blockIdx.x * 64; const long r0 = (long)blockIdx.y * 64;
    ntile((const bf16_t*)(P.ws + WS_ACT), DFF, r0, MR - 1, P.in[IN_WDOWN], DM, c0, DFF, Z);
    const int lr = threadIdx.x >> 2, j0 = (threadIdx.x & 3) * 16; const size_t r = r0 + lr; const int b = (int)(r / SEQL);
    const float* mod = (const float*)(P.ws + WS_MODFIN) + b * 6144;
    for (int j = j0; j < j0 + 16; ++j) { const int c = c0 + j; P.out[r * DM + c] = P.out[r * DM + c] + mod[5120 + c] * Z[lr][j]; }
}

extern "C" void kernel_launch(void* const* d_in, const int* in_sizes, int n_in, void* d_out, int out_size, void* d_ws, size_t ws_size, hipStream_t stream) {
    if (n_in != 34 || ws_size < WS_END) { fprintf(stderr, "kernel_launch: unexpected inputs (n_in %d, ws %zu)\n", n_in, ws_size); return; }
    Ptrs P{};
    for (int i = 0; i < 34; ++i) P.in[i] = (const float*)d_in[i];
    P.out = (float*)d_out; P.ws = (unsigned char*)d_ws;
    (void)hipMemsetAsync((char*)d_ws + WS_CTL, 0, 1 * MiB, stream);
    hipLaunchKernelGGL(nk_mod, dim3(24, 5), dim3(256), 0, stream, P);
    hipLaunchKernelGGL(nk_biasup, dim3(22, 4), dim3(256), 0, stream, P);
    hipLaunchKernelGGL(nk_rope, dim3(4), dim3(256), 0, stream, P);
    hipLaunchKernelGGL(nk_modulate, dim3(MT / 4), dim3(256), 0, stream, P);
    hipLaunchKernelGGL(nk_inproj, dim3(NIN / 64, MT / 64), dim3(256), 0, stream, P);
    hipLaunchKernelGGL(nk_attn, dim3(NB * NHEAD * SEQL), dim3(64), 0, stream, P);
    hipLaunchKernelGGL(nk_s5, dim3(NB * NGRP), dim3(128), 0, stream, P);
    hipLaunchKernelGGL(nk_s5fin, dim3(MR * S5W / 256), dim3(256), 0, stream, P);
    hipLaunchKernelGGL(nk_glu, dim3(S5W / 64, MR / 64), dim3(256), 0, stream, P);
    hipLaunchKernelGGL(nk_ys, dim3(DM / 64, MR / 64), dim3(256), 0, stream, P);
    hipLaunchKernelGGL(nk_ya, dim3(DM / 64, MR / 64), dim3(256), 0, stream, P);
    hipLaunchKernelGGL(nk_out, dim3(DM / 64, MR / 64), dim3(256), 0, stream, P);
    hipLaunchKernelGGL(nk_up, dim3(DFF / 64, NB * 67), dim3(256), 0, stream, P);
    hipLaunchKernelGGL(nk_down, dim3(DM / 64, MR / 64), dim3(256), 0, stream, P);
}
```

```cpp
#include <hip/hip_runtime.h>
#include <cstdint>
#include <cstdio>

constexpr int NB = 4, SEQL = 4096, NCTX = 256, DM = 1024, MR = NB * SEQL, MCX = NB * NCTX, MT = MR + MCX;
constexpr int NHEAD = 8, HDIM = 64, VDIM = 128, S5W = 512, NGRP = 32, NST = 64, DFF = 2816, NIN = 5632;
constexpr int KOFF = 1024, VOFF = 2048, UOFF = 3072, GOFF = 3584;
constexpr int NKEY = NCTX + SEQL, NKT = NKEY / 64, NCH = SEQL / 16 + NCTX / 16;
constexpr float EPSN = 1e-6f, LAM_INIT = 0.2f;
constexpr float C2 = 0.125f * 1.4426950408889634f;

typedef unsigned short bf16_t;
__host__ __device__ __forceinline__ float bf2f(bf16_t v) { union { unsigned u; float f; } x; x.u = ((unsigned)v) << 16; return x.f; }
__host__ __device__ __forceinline__ bf16_t f2bf(float f) { union { unsigned u; float f; } x; x.f = f; return (bf16_t)((x.u + 0x7fffu + ((x.u >> 16) & 1u)) >> 16); }

constexpr size_t MiB = 1u << 20;
constexpr size_t WS_CTL = 0;
constexpr size_t WS_MODPART = 1 * MiB;
constexpr size_t WS_MODFIN = 512 * 1024;
constexpr size_t WS_BIASUP = 512 * 1024 + 128 * 1024;
constexpr size_t WS_ROPE = 2 * MiB + 256 * 1024;
constexpr size_t WS_A16 = WS_ROPE + 16384;
constexpr size_t WS_ROWSQ0 = 2 * MiB + 512 * 1024;
constexpr size_t WS_ROWSQ = WS_ROWSQ0 + 256;
constexpr size_t WS_CONVTAB = 4 * MiB;
constexpr size_t WS_BIASPART = 4 * MiB;
constexpr size_t WS_WIN = 6 * MiB;
constexpr size_t WS_WUP = 17 * MiB;
constexpr size_t WS_WDOWN = 28 * MiB;
constexpr size_t WS_WOUT = 34 * MiB;
constexpr size_t WS_WBA = 36 * MiB;
constexpr size_t WS_WBS = 38 * MiB;
constexpr size_t WS_WGLU = 39 * MiB;
constexpr size_t WS_TQ = 40 * MiB;
constexpr size_t WS_PST = 48 * MiB;
constexpr size_t WS_RH = 52 * MiB;
constexpr size_t WS_RQ = 86 * MiB;
constexpr size_t WS_RK = 118 * MiB;
constexpr size_t WS_RV = 152 * MiB;
constexpr size_t WS_RU = 186 * MiB;
constexpr size_t WS_HS = 221 * MiB;
constexpr size_t WS_END = 237 * MiB;
constexpr size_t WS_T = WS_RK;
constexpr size_t WS_MB = WS_RU;
constexpr size_t WS_X1B = WS_RH + 8192;
constexpr size_t WS_HS2 = WS_RH;
constexpr size_t WS_ACT = WS_RK;
constexpr size_t WS_YTF = WS_RH;
constexpr size_t WS_YTB = WS_RK;

__host__ __device__ __forceinline__ unsigned q_idx(int b, int t, int h, int m, int d) { return (unsigned)((b * SEQL + t) * 1024 + h * 128 + m * 64 + d); }
__host__ __device__ __forceinline__ unsigned k_idx(int b, int h, int m, int key, int d) {
    return (unsigned)((((((b * NHEAD + h) * 2 + m) * NKT + (key >> 6)) * 8 + (d >> 3)) * 64 + (key & 63)) * 8 + (d & 7));
}
__host__ __device__ __forceinline__ unsigned v_idx(int b, int h, int key, int d) {
    const int row = key & 63;
    return (unsigned)(((((b * NHEAD + h) * NKT + (key >> 6)) * 16 + (d >> 5) * 4 + (row >> 4)) * 16 + (row & 15)) * 32 + (d & 31));
}
__host__ __device__ __forceinline__ unsigned u_idx(int b, int g, int chunk, int sig, int c) { return (unsigned)((((b * NGRP + g) * NCH + chunk) * 512) + sig * 16 + c); }

struct Ptrs {
    const float* in[34];
    float* out;
    unsigned char* ws;
};
#define IN_X 0
#define IN_C 1
#define IN_CTX 2
#define IN_CCTX 3
#define IN_ADAW 4
#define IN_ADAB 5
#define IN_N1W 6
#define IN_WIN 7
#define IN_BGATE 8
#define IN_QNW 9
#define IN_KNW 10
#define IN_LQ1 11
#define IN_LK1 12
#define IN_LQ2 13
#define IN_LK2 14
#define IN_SUBLN 15
#define IN_ARE 16
#define IN_AIM 17
#define IN_LOGDT 18
#define IN_BRE 19
#define IN_BIM 20
#define IN_CRE 21
#define IN_CIM 22
#define IN_S5D 23
#define IN_GLUW 24
#define IN_GLUB 25
#define IN_WBS 26
#define IN_WBA 27
#define IN_WOUT 28
#define IN_N2W 29
#define IN_WUP 30
#define IN_CONVW 31
#define IN_CONVB 32
#define IN_WDOWN 33

__device__ __forceinline__ float wave_sum(float v) {
#pragma unroll
    for (int o = 1; o < 64; o <<= 1) v += __shfl_xor(v, o);
    return v;
}
__device__ __forceinline__ float wave_max(float v) {
#pragma unroll
    for (int o = 1; o < 64; o <<= 1) v = fmaxf(v, __shfl_xor(v, o));
    return v;
}
__device__ __forceinline__ float sigmoidf_(float x) { return 1.f / (1.f + __expf(-x)); }
__device__ __forceinline__ float siluf_(float x) { return x / (1.f + __expf(-x)); }
__device__ __forceinline__ float gelu_tanh(float x) { const float u = 0.7978845608028654f * (x + 0.044715f * x * x * x); return 0.5f * x * (1.f + tanhf(u)); }

#define LAS __attribute__((address_space(3)))
__device__ __forceinline__ int lane_id() { return (int)__builtin_amdgcn_mbcnt_hi(~0u, __builtin_amdgcn_mbcnt_lo(~0u, 0u)); }
constexpr int NB_AS = 0, NB_WS = 4160, NB_Z = 8256, NB_Z2 = 24896, NB_LDS = 41536;

__device__ void nb_mod(const Ptrs& P, int vbx, int vby, int vt) {
    const int col = vbx * 256 + vt, row = vby;
    const float* cv = row < 4 ? P.in[IN_C] + row * DM : P.in[IN_CCTX];
    const float* W = P.in[IN_ADAW];
    float acc = 0.f;
    for (int k = 0; k < DM; ++k) acc += siluf_(cv[k]) * W[(size_t)k * 6144 + col];
    ((float*)(P.ws + WS_MODFIN))[row * 6144 + col] = acc + P.in[IN_ADAB][col];
}
__device__ void nb_biasup(const Ptrs& P, int vbx, int vby, int vt) {
    const int n = vbx * 256 + vt, b = vby;
    const float* sh2 = (const float*)(P.ws + WS_MODFIN) + b * 6144 + 3072;
    const float* W = P.in[IN_WUP];
    float acc = 0.f;
    for (int k = 0; k < DM; ++k) acc += sh2[k] * W[(size_t)k * NIN + n];
    ((float*)(P.ws + WS_BIASUP))[b * NIN + n] = acc;
}
__device__ void nb_rope(const Ptrs& P, int vbx, int vt) {
    const int i = vbx * 256 + vt;
    const int pos = i >> 4, f = i & 15;
    const float inv = powf(10000.f, -(float)(2 * f) / 32.f);
    const float ang = (float)pos * inv;
    float* tab = (float*)(P.ws + WS_ROPE);
    tab[2 * i] = cosf(ang); tab[2 * i + 1] = sinf(ang);
}
__device__ void nb_modulate(const Ptrs& P, int vbx, int vt) {
    const int r = vbx * 4 + (vt >> 6), lane = vt & 63;
    const float* xr = r < MR ? P.in[IN_X] + (size_t)r * DM : P.in[IN_CTX] + (size_t)(r - MR) * DM;
    const float* mod = (const float*)(P.ws + WS_MODFIN) + (r < MR ? r / SEQL : 4) * 6144;
    const float* w = P.in[IN_N1W];
    float v[16]; float ss = 0.f;
#pragma unroll
    for (int j = 0; j < 16; ++j) { v[j] = xr[lane + 64 * j]; ss += v[j] * v[j]; }
    const float rstd = rsqrtf(wave_sum(ss) * (1.f / DM) + EPSN);
    bf16_t* H = (bf16_t*)(P.ws + WS_RH) + (size_t)r * DM;
#pragma unroll
    for (int j = 0; j < 16; ++j) { const int k = lane + 64 * j; H[k] = f2bf(v[j] * rstd * w[k] * (1.f + mod[1024 + k]) + mod[k]); }
}
__device__ void ntile(const bf16_t* A, int lda, long row0, long rowmax, const float* W, int ldw, int col0, int K, char* lh, int zoff, int tid) {
    float (*As)[65] = (float (*)[65])(lh + NB_AS);
    float (*Ws)[64] = (float (*)[64])(lh + NB_WS);
    float (*Z)[65] = (float (*)[65])(lh + zoff);
    const int tx = tid & 15, ty = tid >> 4;
    float acc[4][4];
#pragma unroll
    for (int i = 0; i < 4; ++i)
#pragma unroll
        for (int j = 0; j < 4; ++j) acc[i][j] = 0.f;
    for (int k0 = 0; k0 < K; k0 += 16) {
        {
            const int ar = tid >> 2, ak = (tid & 3) * 4;
            long gr = row0 + ar; gr = gr < 0 ? 0 : (gr > rowmax ? rowmax : gr);
            const bf16_t* ap = A + (size_t)gr * lda + k0 + ak;
#pragma unroll
            for (int q = 0; q < 4; ++q) As[ak + q][ar] = bf2f(ap[q]);
            const int wk = tid >> 4, wc = (tid & 15) * 4;
            const float4 wv = *(const float4*)(W + (size_t)(k0 + wk) * ldw + col0 + wc);
            Ws[wk][wc] = wv.x; Ws[wk][wc + 1] = wv.y; Ws[wk][wc + 2] = wv.z; Ws[wk][wc + 3] = wv.w;
        }
        __syncthreads();
#pragma unroll
        for (int kk = 0; kk < 16; ++kk) {
            float a[4], w[4];
#pragma unroll
            for (int i = 0; i < 4; ++i) a[i] = As[kk][ty * 4 + i];
#pragma unroll
            for (int j = 0; j < 4; ++j) w[j] = Ws[kk][tx * 4 + j];
#pragma unroll
            for (int i = 0; i < 4; ++i)
#pragma unroll
                for (int j = 0; j < 4; ++j) acc[i][j] += a[i] * w[j];
        }
        __syncthreads();
    }
#pragma unroll
    for (int i = 0; i < 4; ++i)
#pragma unroll
        for (int j = 0; j < 4; ++j) Z[ty * 4 + i][tx * 4 + j] = acc[i][j];
    __syncthreads();
}
__device__ void nb_inproj(const Ptrs& P, int vbx, int vby, int tid, char* lh) {
    float (*Z)[65] = (float (*)[65])(lh + NB_Z);
    const int c0 = vbx * 64; const long r0 = (long)vby * 64;
    ntile((const bf16_t*)(P.ws + WS_RH), DM, r0, MT - 1, P.in[IN_WIN], NIN, c0, DM, lh, NB_Z, tid);
    const int lr = tid >> 2, j0 = (tid & 3) * 16;
    const int r = (int)r0 + lr;
    const bool isctx = r >= MR;
    const int b = isctx ? (r - MR) / NCTX : r / SEQL, t = isctx ? (r - MR) % NCTX : r % SEQL;
    const int key = isctx ? t : NCTX + t, chunk = isctx ? 256 + (t >> 4) : (t >> 4), sig = t & 15;
    const float* zr = Z[lr];
    if (c0 < VOFF) {
        const bool isq = c0 < KOFF;
        if (!(isq && isctx)) {
            const float* w = isq ? P.in[IN_QNW] : P.in[IN_KNW];
            float ss = 0.f;
            for (int j = 0; j < 64; ++j) ss += zr[j] * zr[j];
            const float rs = rsqrtf(ss * (1.f / 64.f) + EPSN);
            const int cc = isq ? c0 : c0 - KOFF, h = cc / 128, m = (cc / 64) & 1;
            const float* tab = (const float*)(P.ws + WS_ROPE);
            for (int d = j0; d < j0 + 16; ++d) {
                float val = zr[d] * rs * w[d];
                if (!isctx) {
                    const int half = d >> 5, dd = d & 31, i = dd & 15, second = dd >> 4;
                    const int pd = second ? d - 16 : d + 16;
                    const float pv = zr[pd] * rs * w[pd];
                    const int pos = half == 0 ? (t >> 6) : (t & 63);
                    const float cs = tab[(pos * 16 + i) * 2], sn = tab[(pos * 16 + i) * 2 + 1];
                    val = second ? (val * cs + pv * sn) : (val * cs - pv * sn);
                }
                if (isq) ((bf16_t*)(P.ws + WS_RQ))[q_idx(b, t, h, m, d)] = f2bf(val * C2);
                else ((bf16_t*)(P.ws + WS_RK))[k_idx(b, h, m, key, d)] = f2bf(val);
            }
        }
    } else if (c0 < UOFF) {
        const int cc = c0 - VOFF, h = cc / 128, dbase = cc % 128;
        for (int j = j0; j < j0 + 16; ++j) ((bf16_t*)(P.ws + WS_RV))[v_idx(b, h, key, dbase + j)] = f2bf(zr[j]);
    } else if (c0 < GOFF) {
        for (int j = j0; j < j0 + 16; ++j) { const int cc = c0 - UOFF + j; ((bf16_t*)(P.ws + WS_RU))[u_idx(b, cc >> 4, chunk, sig, cc & 15)] = f2bf(zr[j]); }
    } else if (!isctx) {
        bf16_t* G = (bf16_t*)P.out;
        for (int j = j0; j < j0 + 16; ++j) { const int cc = c0 - GOFF + j; G[(size_t)r * 2048 + cc] = f2bf(sigmoidf_(zr[j] + P.in[IN_BGATE][cc])); }
    }
    __syncthreads();
}
__device__ void nb_attn(const Ptrs& P, int item, int lane, char* lw) {
    float* p0 = (float*)lw; float* p1 = p0 + NKEY; float* qs = p1 + NKEY;
    const int b = item / (NHEAD * SEQL), h = (item / SEQL) % NHEAD, t = item % SEQL;
    bf16_t* Q = (bf16_t*)(P.ws + WS_RQ); const bf16_t* K = (const bf16_t*)(P.ws + WS_RK); const bf16_t* V = (const bf16_t*)(P.ws + WS_RV);
    qs[lane] = bf2f(Q[q_idx(b, t, h, 0, lane)]); qs[64 + lane] = bf2f(Q[q_idx(b, t, h, 1, lane)]);
    const float lam = __expf(wave_sum(P.in[IN_LQ1][lane] * P.in[IN_LK1][lane])) - __expf(wave_sum(P.in[IN_LQ2][lane] * P.in[IN_LK2][lane])) + LAM_INIT;
    const float mshift = 8.f * 1.4426950408889634f * wave_max(fabsf(P.in[IN_QNW][lane])) * wave_max(fabsf(P.in[IN_KNW][lane]));
    __builtin_amdgcn_s_waitcnt(0xc07f); __builtin_amdgcn_wave_barrier();
    float l0 = 0.f, l1 = 0.f;
    for (int i = 0; i < NKT; ++i) {
        const int key = i * 64 + lane;
#pragma unroll
        for (int m = 0; m < 2; ++m) {
            float s = 0.f;
#pragma unroll
            for (int ch = 0; ch < 8; ++ch) {
                const uint4 kv = *(const uint4*)(K + k_idx(b, h, m, key, ch * 8));
                const unsigned w[4] = {kv.x, kv.y, kv.z, kv.w};
#pragma unroll
                for (int e = 0; e < 4; ++e) { s += qs[m * 64 + ch * 8 + 2 * e] * bf2f((bf16_t)(w[e] & 0xffff)) + qs[m * 64 + ch * 8 + 2 * e + 1] * bf2f((bf16_t)(w[e] >> 16)); }
            }
            const float p = exp2f(s - mshift);
            if (m == 0) { p0[key] = p; l0 += p; } else { p1[key] = p; l1 += p; }
        }
    }
    l0 = wave_sum(l0); l1 = wave_sum(l1);
    __builtin_amdgcn_s_waitcnt(0xc07f); __builtin_amdgcn_wave_barrier();
    const float i0 = 1.f / l0, i1 = lam / l1;
    float o0 = 0.f, o1 = 0.f;
    for (int key = 0; key < NKEY; ++key) {
        const float a = p0[key] * i0 - p1[key] * i1;
        o0 += a * bf2f(V[v_idx(b, h, key, lane)]); o1 += a * bf2f(V[v_idx(b, h, key, lane + 64)]);
    }
    const float rs = rsqrtf(wave_sum(o0 * o0 + o1 * o1) * (1.f / 128.f) + EPSN) * (1.f - LAM_INIT);
    bf16_t* On = Q;
    const size_t ob = ((size_t)(b * SEQL + t)) * 1024 + h * 128;
    On[ob + lane] = f2bf(o0 * rs * P.in[IN_SUBLN][lane]); On[ob + 64 + lane] = f2bf(o1 * rs * P.in[IN_SUBLN][64 + lane]);
    __builtin_amdgcn_s_waitcnt(0xc07f); __builtin_amdgcn_wave_barrier();
}
__device__ void nb_s5(const Ptrs& P, int item, int p) {
    const int d = item & 1, bg = item >> 1, b = bg / NGRP, g = bg % NGRP;
    const int gi = (d * NGRP + g) * NST + p;
    const float lre = fminf(P.in[IN_ARE][gi], -1e-4f), lim = P.in[IN_AIM][gi], dt = __expf(P.in[IN_LOGDT][d * NGRP + g]);
    const float mag = __expf(lre * dt); float sn, cs; sincosf(lim * dt, &sn, &cs);
    const float ar = mag * cs, ai = mag * sn;
    const float nr = ar - 1.f, ni = ai, den = lre * lre + lim * lim;
    const float fr = (nr * lre + ni * lim) / den, fi = (ni * lre - nr * lim) / den;
    float bre[16], bim[16], cre[16], cim[16];
#pragma unroll
    for (int c = 0; c < 16; ++c) {
        const float br = P.in[IN_BRE][(size_t)gi * 16 + c], bi = P.in[IN_BIM][(size_t)gi * 16 + c];
        bre[c] = fr * br - fi * bi; bim[c] = fr * bi + fi * br;
        cre[c] = P.in[IN_CRE][((size_t)(d * NGRP + g) * 16 + c) * NST + p]; cim[c] = P.in[IN_CIM][((size_t)(d * NGRP + g) * 16 + c) * NST + p];
    }
    const bf16_t* U = (const bf16_t*)(P.ws + WS_RU);
    float* yt = (float*)(P.ws + (d == 0 ? WS_YTF : WS_YTB)) + (size_t)(b * NGRP + g) * SEQL * 16;
    float sr = 0.f, si = 0.f;
    for (int step = 0; step < NKEY; ++step) {
        const bool isctx = step < NCTX;
        const int idx = isctx ? step : step - NCTX;
        const int t = d == 0 ? idx : (isctx ? NCTX - 1 - idx : SEQL - 1 - idx);
        const int chunk = isctx ? 256 + (t >> 4) : (t >> 4);
        const bf16_t* up = U + u_idx(b, g, chunk, t & 15, 0);
        float bur = 0.f, bui = 0.f;
#pragma unroll
        for (int c = 0; c < 16; ++c) { const float u = bf2f(up[c]); bur += bre[c] * u; bui += bim[c] * u; }
        const float nsr = ar * sr - ai * si + bur, nsi = ar * si + ai * sr + bui;
        sr = nsr; si = nsi;
        if (!isctx) {
            float mine = 0.f;
#pragma unroll
            for (int c = 0; c < 16; ++c) { const float v = wave_sum(cre[c] * sr - cim[c] * si); if (p == c) mine = v; }
            if (p < 16) yt[(size_t)t * 16 + p] = mine;
        }
    }
}
__device__ void nb_s5fin(const Ptrs& P, int vbx, int vt) {
    const size_t i = (size_t)vbx * 256 + vt;
    const int ch = (int)(i % 512); const size_t bt = i / 512; const int b = (int)(bt / SEQL), t = (int)(bt % SEQL), g = ch >> 4, c = ch & 15;
    const float u = bf2f(((const bf16_t*)(P.ws + WS_RU))[u_idx(b, g, t >> 4, t & 15, c)]);
    const size_t yi = ((size_t)(b * NGRP + g) * SEQL + t) * 16 + c;
    const float y = P.in[IN_S5D][ch] * u + ((const float*)(P.ws + WS_YTF))[yi] + ((const float*)(P.ws + WS_YTB))[yi];
    ((bf16_t*)(P.ws + WS_HS))[i] = f2bf(gelu_tanh(y));
}
__device__ void nb_glu(const Ptrs& P, int vbx, int vby, int tid, char* lh) {
    float (*Z)[65] = (float (*)[65])(lh + NB_Z);
    const int c0 = vbx * 64; const long r0 = (long)vby * 64;
    const bf16_t* Hs = (const bf16_t*)(P.ws + WS_HS);
    ntile(Hs, S5W, r0, MR - 1, P.in[IN_GLUW], S5W, c0, S5W, lh, NB_Z, tid);
    const int lr = tid >> 2, j0 = (tid & 3) * 16; const size_t r = r0 + lr;
    for (int j = j0; j < j0 + 16; ++j) { const int c = c0 + j; ((bf16_t*)(P.ws + WS_HS2))[r * S5W + c] = f2bf(bf2f(Hs[r * S5W + c]) * sigmoidf_(Z[lr][j] + P.in[IN_GLUB][c])); }
    __syncthreads();
}
__device__ void nb_ys(const Ptrs& P, int vbx, int vby, int tid, char* lh) {
    float (*Z)[65] = (float (*)[65])(lh + NB_Z);
    const int c0 = vbx * 64; const long r0 = (long)vby * 64;
    ntile((const bf16_t*)(P.ws + WS_HS2), S5W, r0, MR - 1, P.in[IN_WBS], DM, c0, S5W, lh, NB_Z, tid);
    const int lr = tid >> 2, j0 = (tid & 3) * 16; const size_t r = r0 + lr;
    const bf16_t* G = (const bf16_t*)P.out;
    for (int j = j0; j < j0 + 16; ++j) { const int c = c0 + j; ((float*)(P.ws + WS_T))[r * DM + c] = bf2f(G[r * 2048 + c]) * Z[lr][j]; }
    __syncthreads();
}
__device__ void nb_ya(const Ptrs& P, int vbx, int vby, int tid, char* lh) {
    float (*Z)[65] = (float (*)[65])(lh + NB_Z);
    const int c0 = vbx * 64; const long r0 = (long)vby * 64;
    ntile((const bf16_t*)(P.ws + WS_RQ), DM, r0, MR - 1, P.in[IN_WBA], DM, c0, DM, lh, NB_Z, tid);
    const int lr = tid >> 2, j0 = (tid & 3) * 16; const size_t r = r0 + lr;
    const bf16_t* G = (const bf16_t*)P.out;
    for (int j = j0; j < j0 + 16; ++j) { const int c = c0 + j; ((bf16_t*)(P.ws + WS_MB))[r * DM + c] = f2bf(((const float*)(P.ws + WS_T))[r * DM + c] + bf2f(G[r * 2048 + 1024 + c]) * Z[lr][j]); }
    __syncthreads();
}
__device__ void nb_out(const Ptrs& P, int vbx, int vby, int tid, char* lh) {
    float (*Z)[65] = (float (*)[65])(lh + NB_Z);
    const int c0 = vbx * 64; const long r0 = (long)vby * 64;
    ntile((const bf16_t*)(P.ws + WS_MB), DM, r0, MR - 1, P.in[IN_WOUT], DM, c0, DM, lh, NB_Z, tid);
    const int lr = tid >> 2, j0 = (tid & 3) * 16; const size_t r = r0 + lr; const int b = (int)(r / SEQL);
    const float* mod = (const float*)(P.ws + WS_MODFIN) + b * 6144;
    float ss = 0.f;
    for (int j = j0; j < j0 + 16; ++j) {
        const int c = c0 + j;
        const float x1 = P.in[IN_X][r * DM + c] + mod[2048 + c] * Z[lr][j];
        P.out[r * DM + c] = x1;
        ((bf16_t*)(P.ws + WS_X1B))[r * DM + c] = f2bf(x1 * P.in[IN_N2W][c] * (1.f + mod[4096 + c]));
        ss += x1 * x1;
    }
    ss += __shfl_xor(ss, 1); ss += __shfl_xor(ss, 2);
    if ((tid & 3) == 0) atomicAdd((float*)(P.ws + WS_ROWSQ) + r, ss);
    __syncthreads();
}
__device__ void nb_up(const Ptrs& P, int vbx, int vby, int tid, char* lh) {
    float (*Za)[65] = (float (*)[65])(lh + NB_Z);
    float (*Zg)[65] = (float (*)[65])(lh + NB_Z2);
    const int c0 = vbx * 64;
    const int b = vby / 67, ti = vby % 67;
    const long r0 = (long)b * SEQL + 62 * ti - 1;
    const bf16_t* A = (const bf16_t*)(P.ws + WS_X1B);
    ntile(A, DM, r0, MR - 1, P.in[IN_WUP], NIN, c0, DM, lh, NB_Z, tid);
    ntile(A, DM, r0, MR - 1, P.in[IN_WUP], NIN, DFF + c0, DM, lh, NB_Z2, tid);
    const int lr = tid >> 2, j0 = (tid & 3) * 16;
    {
        const int tok = 62 * ti + lr - 1; const bool valid = tok >= 0 && tok < SEQL;
        float rstd = 0.f;
        if (valid) { const size_t r = (size_t)b * SEQL + tok; rstd = rsqrtf(((const float*)(P.ws + WS_ROWSQ))[r] * (1.f / DM) + EPSN); }
        const float* bu = (const float*)(P.ws + WS_BIASUP) + b * NIN;
        for (int j = j0; j < j0 + 16; ++j) { Za[lr][j] = valid ? rstd * Za[lr][j] + bu[c0 + j] : 0.f; Zg[lr][j] = valid ? rstd * Zg[lr][j] + bu[DFF + c0 + j] : 0.f; }
    }
    __syncthreads();
    const int tok = 62 * ti + lr - 1;
    if (lr >= 1 && lr <= 62 && tok < SEQL) {
        const float* cw = P.in[IN_CONVW]; const float* cb = P.in[IN_CONVB];
        const size_t r = (size_t)b * SEQL + tok;
        for (int j = j0; j < j0 + 16; ++j) {
            const int ca = c0 + j, cg = DFF + c0 + j;
            const float ya = cb[ca] + cw[ca] * Za[lr - 1][j] + cw[NIN + ca] * Za[lr][j] + cw[2 * NIN + ca] * Za[lr + 1][j];
            const float yg = cb[cg] + cw[cg] * Zg[lr - 1][j] + cw[NIN + cg] * Zg[lr][j] + cw[2 * NIN + cg] * Zg[lr + 1][j];
            ((bf16_t*)(P.ws + WS_ACT))[r * DFF + ca] = f2bf(siluf_(yg) * ya);
        }
    }
    __syncthreads();
}
__device__ void nb_down(const Ptrs& P, int vbx, int vby, int tid, char* lh) {
    float (*Z)[65] = (float (*)[65])(lh + NB_Z);
    const int c0 = vbx * 64; const long r0 = (long)vby * 64;
    ntile((const bf16_t*)(P.ws + WS_ACT), DFF, r0, MR - 1, P.in[IN_WDOWN], DM, c0, DFF, lh, NB_Z, tid);
    const int lr = tid >> 2, j0 = (tid & 3) * 16; const size_t r = r0 + lr; const int b = (int)(r / SEQL);
    const float* mod = (const float*)(P.ws + WS_MODFIN) + b * 6144;
    for (int j = j0; j < j0 + 16; ++j) { const int c = c0 + j; P.out[r * DM + c] = P.out[r * DM + c] + mod[5120 + c] * Z[lr][j]; }
    __syncthreads();
}
namespace pg8 {
typedef short bf16x8 __attribute__((ext_vector_type(8)));
typedef float f32x4 __attribute__((ext_vector_type(4)));
typedef unsigned u32x4 __attribute__((ext_vector_type(4)));
typedef unsigned u32x2 __attribute__((ext_vector_type(2)));
constexpr int BM = 256, BK = 64, HALF = 128, HTB = HALF * BK * 2, STAGE_BYTES = 8 * HTB;
__host__ __device__ __forceinline__ int lds_byte(int r, int c) { const int st = (r >> 4) * 2 + (c >> 5), rr = r & 15, cc = c & 31, ob = rr * 64 + cc * 2; return st * 1024 + (ob ^ (((ob >> 9) & 1) << 5)); }
__host__ __device__ __forceinline__ void stage_rc(int b, int& R, int& C) { const int st = b / 1024, sb = b % 1024, swz = sb ^ (((sb >> 9) & 1) << 5); R = (st >> 1) * 16 + swz / 64; C = (st & 1) * 32 + (swz % 64) / 2; }
__host__ __device__ __forceinline__ int perm32(int rho) { const int n = rho >> 4, i = rho & 15; return 8 * (i >> 2) + 4 * n + (i & 3); }
struct Unit { int arow, brow, pm, pn; };
struct Gemm { const bf16_t* A; const bf16_t* Bt; int K, lda, ldb; };
typedef float f32x2c __attribute__((ext_vector_type(2))); typedef __bf16 bf16x2c __attribute__((ext_vector_type(2)));
__device__ __forceinline__ unsigned cvt_pk_bf16(float lo, float hi) { const f32x2c v = {lo, hi}; const bf16x2c b = __builtin_convertvector(v, bf16x2c); return __builtin_bit_cast(unsigned, b); }

template <class Epi, class Sched, bool ALIGN_EPI, int SHR>
__device__ __forceinline__ void gemm_phase(LAS unsigned char* lds, const Gemm g, const Sched& S, const Epi& E, int wave) {
    int tid_ = wave * 64 + lane_id(); asm volatile("" : "+v"(tid_));
    const int tid = tid_, wid = __builtin_amdgcn_readfirstlane(tid >> 6), lane = tid & 63, wr = wid >> 2, wc = wid & 3, fr = lane & 15, fq = lane >> 4;
    int nt_ = g.K / BK; asm volatile("" : "+s"(nt_)); const int nt = nt_;
    unsigned voffA[2], voffB[2];
#pragma unroll
    for (int i = 0; i < 2; ++i) { int R, C; stage_rc(tid * 16 + i * 8192, R, C); const int Rb = Epi::PERM ? ((R & ~31) + perm32(R & 31)) : R;
        voffA[i] = (unsigned)((R - SHR * (R >> 6)) * g.lda + C) * 2u; voffB[i] = (unsigned)(Rb * g.ldb + C) * 2u; }
    const size_t kstep = (size_t)(BK * 2);
    const size_t hA = (size_t)(HALF - 2 * SHR) * g.lda * 2, hB = (size_t)HALF * g.ldb * 2;
    const unsigned ldsw = (unsigned)wid * 1024u;
    const int aoff = lds_byte(wr * 64 + fr, fq * 8), boff = lds_byte(wc * 32 + fr, fq * 8);
#define PG8_SA(b, h) (((b) * 2 + (h)) * HTB)
#define PG8_SB(b, h) ((4 + (b) * 2 + (h)) * HTB)
#define PG8_STAGE(bufoff, gbase, voff) do { _Pragma("unroll") for (int _i = 0; _i < 2; ++_i) \
        __builtin_amdgcn_global_load_lds((const unsigned*)((const char*)(gbase) + (voff)[_i]), (LAS unsigned*)(lds + (bufoff) + ldsw + _i * 8192), 16, 0, 0); } while (0)
#define PG8_LDA(dst, b, h) do { _Pragma("unroll") for (int m = 0; m < 4; ++m) _Pragma("unroll") for (int k = 0; k < 2; ++k) dst[m][k] = *(const LAS bf16x8*)(lds + PG8_SA(b, h) + aoff + m * 2048 + k * 1024); } while (0)
#define PG8_LDB(dst, b, h) do { _Pragma("unroll") for (int n = 0; n < 2; ++n) _Pragma("unroll") for (int k = 0; k < 2; ++k) dst[n][k] = *(const LAS bf16x8*)(lds + PG8_SB(b, h) + boff + n * 2048 + k * 1024); } while (0)
#define PG8_MMA(ai, bj, At, Bt) do { __builtin_amdgcn_s_setprio(1); _Pragma("unroll") for (int m = 0; m < 4; ++m) _Pragma("unroll") for (int n = 0; n < 2; ++n) _Pragma("unroll") for (int k = 0; k < 2; ++k) \
        acc[ai][bj][m][n] = __builtin_amdgcn_mfma_f32_16x16x32_bf16(Bt[n][k], At[m][k], acc[ai][bj][m][n], 0, 0, 0); __builtin_amdgcn_s_setprio(0); } while (0)
#define PG8_WAIT_V(n) asm volatile("s_waitcnt vmcnt(" #n ")" ::: "memory")
#define PG8_WAIT_L(n) asm volatile("s_waitcnt lgkmcnt(" #n ")" ::: "memory")
#define PG8_BAR __builtin_amdgcn_s_barrier()
#define PG8_SCHED __builtin_amdgcn_sched_barrier(0)
    Unit cur, nxt; int ui = 0;
    if (!S.next(0, cur)) return;
    f32x4 acc[2][2][4][2];
#pragma unroll
    for (int a = 0; a < 2; ++a)
#pragma unroll
        for (int b = 0; b < 2; ++b)
#pragma unroll
            for (int m = 0; m < 4; ++m)
#pragma unroll
                for (int n = 0; n < 2; ++n) acc[a][b][m][n] = (f32x4){0.f, 0.f, 0.f, 0.f};
    bf16x8 At[4][2], B0[2][2], B1[2][2];
    const char* cA = (const char*)g.A + (long)cur.arow * g.lda * 2; const char* cB = (const char*)g.Bt + (long)cur.brow * g.ldb * 2;
    PG8_STAGE(PG8_SB(0, 0), cB, voffB); PG8_STAGE(PG8_SB(0, 1), cB + hB, voffB); PG8_STAGE(PG8_SA(0, 0), cA, voffA); PG8_STAGE(PG8_SA(0, 1), cA + hA, voffA);
    if (wr == 1) PG8_BAR;
    PG8_WAIT_V(2); PG8_BAR;
    PG8_STAGE(PG8_SB(1, 0), cB + kstep, voffB); PG8_STAGE(PG8_SA(1, 0), cA + kstep, voffA); PG8_STAGE(PG8_SB(1, 1), cB + hB + kstep, voffB);
    PG8_WAIT_V(6); PG8_BAR;
    for (;;) {
        const bool has_next = S.next(ui + 1, nxt);
        const char* nA = has_next ? (const char*)g.A + (long)nxt.arow * g.lda * 2 : cA; const char* nB = has_next ? (const char*)g.Bt + (long)nxt.brow * g.ldb * 2 : cB;
#pragma unroll 1
        for (int t = 0; t < nt; t += 2) {
            const bool last = (t == nt - 2);
            const char* a1 = cA + (size_t)(t + 1) * kstep;
            const char* a2 = last ? nA : cA + (size_t)(t + 2) * kstep; const char* b2 = last ? nB : cB + (size_t)(t + 2) * kstep;
            const char* a3 = a2 + kstep; const char* b3 = b2 + kstep;
            PG8_LDB(B0, 0, 0); PG8_LDB(B1, 0, 1); PG8_SCHED; PG8_LDA(At, 0, 0); PG8_STAGE(PG8_SA(1, 1), a1 + hA, voffA);
            PG8_WAIT_V(8); PG8_WAIT_L(0); PG8_BAR; PG8_MMA(0, 0, At, B0); PG8_MMA(0, 1, At, B1); PG8_BAR; PG8_SCHED;
            PG8_LDA(At, 0, 1); PG8_STAGE(PG8_SB(0, 0), b2, voffB); PG8_STAGE(PG8_SB(0, 1), b2 + hB, voffB); PG8_STAGE(PG8_SA(0, 0), a2, voffA);
            PG8_WAIT_V(8); PG8_WAIT_L(0); PG8_BAR; PG8_MMA(1, 0, At, B0); PG8_MMA(1, 1, At, B1); PG8_BAR; PG8_SCHED;
            PG8_LDB(B0, 1, 0); PG8_LDB(B1, 1, 1); PG8_SCHED; PG8_LDA(At, 1, 0); PG8_STAGE(PG8_SA(0, 1), a2 + hA, voffA);
            PG8_WAIT_V(8); PG8_WAIT_L(0); PG8_BAR; PG8_MMA(0, 0, At, B0); PG8_MMA(0, 1, At, B1); PG8_BAR; PG8_SCHED;
            PG8_LDA(At, 1, 1); PG8_STAGE(PG8_SB(1, 0), b3, voffB); PG8_STAGE(PG8_SB(1, 1), b3 + hB, voffB); PG8_STAGE(PG8_SA(1, 0), a3, voffA);
            PG8_WAIT_V(8); PG8_WAIT_L(0); PG8_BAR; PG8_MMA(1, 0, At, B0); PG8_MMA(1, 1, At, B1); PG8_BAR; PG8_SCHED;
        }
        if constexpr (ALIGN_EPI) { if (wr == 0) PG8_BAR; }
        { int fr_ = fr, fq_ = fq, wr_ = wr, wc_ = wc; asm volatile("" : "+v"(fr_), "+v"(fq_), "+s"(wr_), "+s"(wc_));
          E(acc, cur, wr_, wc_, fr_, fq_); }
        if (!has_next) break;
#pragma unroll
        for (int a = 0; a < 2; ++a)
#pragma unroll
            for (int b = 0; b < 2; ++b)
#pragma unroll
                for (int m = 0; m < 4; ++m)
#pragma unroll
                    for (int n = 0; n < 2; ++n) acc[a][b][m][n] = (f32x4){0.f, 0.f, 0.f, 0.f};
        cur = nxt; cA = nA; cB = nB; ++ui;
        if constexpr (ALIGN_EPI) { if (wr == 1) PG8_BAR; }
    }
    PG8_WAIT_V(0);
    if constexpr (!ALIGN_EPI) { if (wr == 0) PG8_BAR; }
    PG8_BAR;
#undef PG8_SA
#undef PG8_SB
#undef PG8_STAGE
#undef PG8_LDA
#undef PG8_LDB
#undef PG8_MMA
#undef PG8_WAIT_V
#undef PG8_WAIT_L
#undef PG8_BAR
#undef PG8_SCHED
}
}
namespace og {
using pg8::Unit; using pg8::f32x4; using pg8::u32x4; using pg8::u32x2; using pg8::cvt_pk_bf16;
__device__ __forceinline__ void grid2d(int L, int nM, int nN, int& pm, int& pn) {
    const int nwg = nM * nN; int wgid = L;
    { const int q = nwg / 8, r = nwg % 8, xcd = wgid % 8, off = wgid / 8; wgid = (xcd < r ? xcd * (q + 1) : r * (q + 1) + (xcd - r) * q) + off; }
    const int nig = 8 * nN, gid = wgid / nig, fm = gid * 8, gsz = (nM - fm) < 8 ? (nM - fm) : 8;
    pm = fm + ((wgid % nig) % gsz); pn = (wgid % nig) / gsz;
}
struct SchedMN { int nM, nN, G, c;
    __device__ __forceinline__ bool next(int i, Unit& u) const { const int L = i * G + c; if (L >= nM * nN) return false; grid2d(L, nM, nN, u.pm, u.pn); u.arow = 256 * u.pm; u.brow = 256 * u.pn; return true; } };
struct SchedIn { int G, c;
    __device__ __forceinline__ bool next(int i, Unit& u) const { const int L = i * G + c;
        if (L < 1408) { grid2d(L, 64, 22, u.pm, u.pn); } else if (L < 1448) { const int lc = L - 1408; u.pm = 64 + lc / 10; u.pn = 4 + lc % 10; } else return false;
        u.arow = 256 * u.pm; u.brow = 256 * u.pn; return true; } };
struct SchedUp { int G, c;
    __device__ __forceinline__ bool next(int i, Unit& u) const { const int L = i * G + c; if (L >= 68 * 22) return false; grid2d(L, 68, 22, u.pm, u.pn);
        u.arow = (u.pm / 17) * SEQL + 248 * (u.pm % 17) - 1; u.brow = 256 * u.pn; return true; } };
struct SchedOne { Unit v; __device__ __forceinline__ bool next(int i, Unit& u) const { if (i) return false; u = v; return true; } };

__device__ __forceinline__ u32x4 pack8(const f32x4 a, const f32x4 b) { u32x4 w; w.x = cvt_pk_bf16(a[0], a[1]); w.y = cvt_pk_bf16(a[2], a[3]); w.z = cvt_pk_bf16(b[0], b[1]); w.w = cvt_pk_bf16(b[2], b[3]); return w; }
__device__ __forceinline__ u32x2 pack4(const f32x4 a) { u32x2 w; w.x = cvt_pk_bf16(a[0], a[1]); w.y = cvt_pk_bf16(a[2], a[3]); return w; }
__device__ __forceinline__ u32x4 ld_nt(const u32x4* p) { return __builtin_nontemporal_load(p); }
__device__ __forceinline__ f32x4 ld_nt(const f32x4* p) { return __builtin_nontemporal_load(p); }
__device__ __forceinline__ f32x4 unpk_lo(const u32x4 w) { return (f32x4){__uint_as_float(w.x << 16), __uint_as_float(w.x & 0xffff0000u), __uint_as_float(w.y << 16), __uint_as_float(w.y & 0xffff0000u)}; }
__device__ __forceinline__ f32x4 unpk_hi(const u32x4 w) { return (f32x4){__uint_as_float(w.z << 16), __uint_as_float(w.z & 0xffff0000u), __uint_as_float(w.w << 16), __uint_as_float(w.w & 0xffff0000u)}; }
__device__ __forceinline__ float sigf(float x) { return __builtin_amdgcn_rcpf(1.f + __builtin_amdgcn_exp2f(-1.4426950408889634f * x)); }
__device__ __forceinline__ f32x4 sig4(const f32x4 x) { return (f32x4){sigf(x[0]), sigf(x[1]), sigf(x[2]), sigf(x[3])}; }

struct EpiIn {
    static constexpr bool PERM = true;
    const Ptrs* Pp;
    __device__ __forceinline__ void operator()(const f32x4 (&acc)[2][2][4][2], const Unit& u, int wr, int wc, int fr, int fq) const {
        const Ptrs& P = *Pp;
        const bool isctx = u.pm >= 64; const int pn = u.pn;
        if (pn < 8) {
            const bool isq = pn < 4;
            const float* w = isq ? P.in[IN_QNW] : P.in[IN_KNW];
            f32x4 wv[2][2];
#pragma unroll
            for (int bj = 0; bj < 2; ++bj)
#pragma unroll
                for (int n = 0; n < 2; ++n) wv[bj][n] = *(const f32x4*)(w + 32 * bj + 16 * n + 4 * fq);
            const int h = (pn & 3) * 2 + (wc >> 1), mm = wc & 1;
            const float* tab = (const float*)(P.ws + WS_ROPE);
#pragma unroll
            for (int ai = 0; ai < 2; ++ai)
#pragma unroll
                for (int m = 0; m < 4; ++m) {
                    const int r = 256 * u.pm + 128 * ai + 64 * wr + 16 * m + fr;
                    const int b = isctx ? (r - MR) / NCTX : r / SEQL, t = isctx ? (r - MR) % NCTX : r % SEQL, key = isctx ? t : NCTX + t;
                    float ss = 0.f;
#pragma unroll
                    for (int bj = 0; bj < 2; ++bj)
#pragma unroll
                        for (int n = 0; n < 2; ++n) { const f32x4 x = acc[ai][bj][m][n]; ss += (x[0] * x[0] + x[1] * x[1]) + (x[2] * x[2] + x[3] * x[3]); }
                    ss += __shfl_xor(ss, 16); ss += __shfl_xor(ss, 32);
                    const float rs = __builtin_amdgcn_rsqf(ss * (1.f / 64.f) + EPSN);
#pragma unroll
                    for (int bj = 0; bj < 2; ++bj) {
                        f32x4 x1 = acc[ai][bj][m][0] * rs * wv[bj][0], x2 = acc[ai][bj][m][1] * rs * wv[bj][1];
                        if (!isctx) {
                            const int pos = bj == 0 ? (t >> 6) : (t & 63);
                            const f32x4 t0 = *(const f32x4*)(tab + (pos * 16 + 4 * fq) * 2), t1 = *(const f32x4*)(tab + (pos * 16 + 4 * fq) * 2 + 4);
                            const f32x4 cs = (f32x4){t0[0], t0[2], t1[0], t1[2]}, sn = (f32x4){t0[1], t0[3], t1[1], t1[3]};
                            const f32x4 o1 = x1 * cs - x2 * sn, o2 = x2 * cs + x1 * sn;
                            x1 = o1; x2 = o2;
                        }
                        if (isq) {
                            bf16_t* q = (bf16_t*)(P.ws + WS_RQ);
                            *(u32x2*)(q + q_idx(b, t, h, mm, 32 * bj + 4 * fq)) = pack4(x1 * C2);
                            *(u32x2*)(q + q_idx(b, t, h, mm, 32 * bj + 16 + 4 * fq)) = pack4(x2 * C2);
                        } else {
                            bf16_t* k = (bf16_t*)(P.ws + WS_RK);
                            *(u32x2*)(k + k_idx(b, h, mm, key, 32 * bj + 4 * fq)) = pack4(x1);
                            *(u32x2*)(k + k_idx(b, h, mm, key, 32 * bj + 16 + 4 * fq)) = pack4(x2);
                        }
                    }
                }
        } else if (pn < 12) {
#pragma unroll
            for (int ai = 0; ai < 2; ++ai)
#pragma unroll
                for (int m = 0; m < 4; ++m) {
                    const int r = 256 * u.pm + 128 * ai + 64 * wr + 16 * m + fr;
                    const int b = isctx ? (r - MR) / NCTX : r / SEQL, t = isctx ? (r - MR) % NCTX : r % SEQL, key = isctx ? t : NCTX + t;
#pragma unroll
                    for (int bj = 0; bj < 2; ++bj)
                        *(u32x4*)((bf16_t*)(P.ws + WS_RV) + v_idx(b, 2 * (pn - 8) + bj, key, 32 * wc + 8 * fq)) = pack8(acc[ai][bj][m][0], acc[ai][bj][m][1]);
                }
        } else if (pn < 14) {
#pragma unroll
            for (int ai = 0; ai < 2; ++ai)
#pragma unroll
                for (int m = 0; m < 4; ++m) {
                    const int r = 256 * u.pm + 128 * ai + 64 * wr + 16 * m + fr;
                    const int b = isctx ? (r - MR) / NCTX : r / SEQL, t = isctx ? (r - MR) % NCTX : r % SEQL;
                    const int chunk = isctx ? 256 + (t >> 4) : (t >> 4), sig = t & 15;
#pragma unroll
                    for (int bj = 0; bj < 2; ++bj) { const int c = 256 * (pn - 12) + 128 * bj + 32 * wc + 8 * fq;
                        *(u32x4*)((bf16_t*)(P.ws + WS_RU) + u_idx(b, c >> 4, chunk, sig, c & 15)) = pack8(acc[ai][bj][m][0], acc[ai][bj][m][1]); }
                }
        } else if (!isctx) {
#pragma unroll
            for (int bj = 0; bj < 2; ++bj) {
                const int c = 256 * (pn - 14) + 128 * bj + 32 * wc + 8 * fq;
                const f32x4 b0 = *(const f32x4*)(P.in[IN_BGATE] + c), b1 = *(const f32x4*)(P.in[IN_BGATE] + c + 4);
#pragma unroll
                for (int ai = 0; ai < 2; ++ai)
#pragma unroll
                    for (int m = 0; m < 4; ++m) {
                        const int r = 256 * u.pm + 128 * ai + 64 * wr + 16 * m + fr;
                        *(u32x4*)((bf16_t*)P.out + (size_t)r * 2048 + c) = pack8(sig4(acc[ai][bj][m][0] + b0), sig4(acc[ai][bj][m][1] + b1));
                    }
            }
        }
    }
};
struct EpiGlu {
    static constexpr bool PERM = true;
    const Ptrs* Pp;
    __device__ __forceinline__ void operator()(const f32x4 (&acc)[2][2][4][2], const Unit& u, int wr, int wc, int fr, int fq) const {
        const Ptrs& P = *Pp;
#pragma unroll
        for (int bj = 0; bj < 2; ++bj) {
            const int c = 256 * u.pn + 128 * bj + 32 * wc + 8 * fq;
            const f32x4 b0 = *(const f32x4*)(P.in[IN_GLUB] + c), b1 = *(const f32x4*)(P.in[IN_GLUB] + c + 4);
#pragma unroll
            for (int ai = 0; ai < 2; ++ai)
#pragma unroll
                for (int m = 0; m < 4; ++m) {
                    const size_t r = 256 * u.pm + 128 * ai + 64 * wr + 16 * m + fr;
                    const u32x4 hs = *(const u32x4*)((const bf16_t*)(P.ws + WS_HS) + r * S5W + c);
                    *(u32x4*)((bf16_t*)(P.ws + WS_HS2) + r * S5W + c) = pack8(unpk_lo(hs) * sig4(acc[ai][bj][m][0] + b0), unpk_hi(hs) * sig4(acc[ai][bj][m][1] + b1));
                }
        }
    }
};
template <int STEP, int GO> struct EpiBranch {
    static constexpr bool PERM = true;
    const Ptrs* Pp;
    __device__ __forceinline__ void operator()(const f32x4 (&acc)[2][2][4][2], const Unit& u, int wr, int wc, int fr, int fq) const {
        const Ptrs& P = *Pp;
#pragma unroll
        for (int ai = 0; ai < 2; ++ai)
#pragma unroll
            for (int m = 0; m < 4; ++m) {
                const size_t r = 256 * u.pm + 128 * ai + 64 * wr + 16 * m + fr;
#pragma unroll
                for (int bj = 0; bj < 2; ++bj) {
                    const int c = 256 * u.pn + 128 * bj + 32 * wc + 8 * fq;
                    const u32x4 gt = *(const u32x4*)((const bf16_t*)P.out + r * 2048 + GO + c);
                    float* T = (float*)(P.ws + WS_T) + r * DM + c;
                    if (STEP == 0) { *(f32x4*)T = unpk_lo(gt) * acc[ai][bj][m][0]; *(f32x4*)(T + 4) = unpk_hi(gt) * acc[ai][bj][m][1]; }
                    else { const f32x4 t0 = *(const f32x4*)T, t1 = *(const f32x4*)(T + 4);
                        *(u32x4*)((bf16_t*)(P.ws + WS_MB) + r * DM + c) = pack8(t0 + unpk_lo(gt) * acc[ai][bj][m][0], t1 + unpk_hi(gt) * acc[ai][bj][m][1]); }
                }
            }
    }
};
struct EpiOut {
    static constexpr bool PERM = true;
    const Ptrs* Pp;
    __device__ __forceinline__ void operator()(const f32x4 (&acc)[2][2][4][2], const Unit& u, int wr, int wc, int fr, int fq) const {
        const Ptrs& P = *Pp;
        const int b = u.pm / 16;
        const float* mod = (const float*)(P.ws + WS_MODFIN) + b * 6144;
        f32x4 ga[2][2], sw[2][2];
#pragma unroll
        for (int bj = 0; bj < 2; ++bj)
#pragma unroll
            for (int n = 0; n < 2; ++n) { const int c = 256 * u.pn + 128 * bj + 32 * wc + 8 * fq + 4 * n;
                ga[bj][n] = *(const f32x4*)(mod + 2048 + c); sw[bj][n] = *(const f32x4*)(P.in[IN_N2W] + c) * (*(const f32x4*)(mod + 4096 + c) + 1.f); }
#pragma unroll
        for (int ai = 0; ai < 2; ++ai)
#pragma unroll
            for (int m = 0; m < 4; ++m) {
                const size_t r = 256 * u.pm + 128 * ai + 64 * wr + 16 * m + fr;
                float ss = 0.f;
#pragma unroll
                for (int bj = 0; bj < 2; ++bj) {
                    const int c = 256 * u.pn + 128 * bj + 32 * wc + 8 * fq;
                    const f32x4 x0 = ld_nt((const f32x4*)(P.in[IN_X] + r * DM + c)) + ga[bj][0] * acc[ai][bj][m][0], x1 = ld_nt((const f32x4*)(P.in[IN_X] + r * DM + c + 4)) + ga[bj][1] * acc[ai][bj][m][1];
                    *(f32x4*)(P.out + r * DM + c) = x0; *(f32x4*)(P.out + r * DM + c + 4) = x1;
                    *(u32x4*)((bf16_t*)(P.ws + WS_X1B) + r * DM + c) = pack8(x0 * sw[bj][0], x1 * sw[bj][1]);
                    ss += (x0[0] * x0[0] + x0[1] * x0[1]) + (x0[2] * x0[2] + x0[3] * x0[3]) + (x1[0] * x1[0] + x1[1] * x1[1]) + (x1[2] * x1[2] + x1[3] * x1[3]);
                }
                ss += __shfl_xor(ss, 16); ss += __shfl_xor(ss, 32);
                if (fq == 0) atomicAdd((float*)(P.ws + WS_ROWSQ) + r, ss);
            }
    }
};
struct EpiDown {
    static constexpr bool PERM = true;
    const Ptrs* Pp;
    __device__ __forceinline__ void operator()(const f32x4 (&acc)[2][2][4][2], const Unit& u, int wr, int wc, int fr, int fq) const {
        const Ptrs& P = *Pp;
        const float* mod = (const float*)(P.ws + WS_MODFIN) + (u.pm / 16) * 6144 + 5120;
#pragma unroll
        for (int bj = 0; bj < 2; ++bj) {
            const int c = 256 * u.pn + 128 * bj + 32 * wc + 8 * fq;
            const f32x4 g0 = *(const f32x4*)(mod + c), g1 = *(const f32x4*)(mod + c + 4);
#pragma unroll
            for (int ai = 0; ai < 2; ++ai)
#pragma unroll
                for (int m = 0; m < 4; ++m) {
                    float* o = P.out + (size_t)(256 * u.pm + 128 * ai + 64 * wr + 16 * m + fr) * DM + c;
                    __builtin_nontemporal_store(*(const f32x4*)o + g0 * acc[ai][bj][m][0], (f32x4*)o); __builtin_nontemporal_store(*(const f32x4*)(o + 4) + g1 * acc[ai][bj][m][1], (f32x4*)(o + 4));
                }
        }
    }
};
__device__ __forceinline__ float dpp_ror1(float v) { return __int_as_float(__builtin_amdgcn_mov_dpp(__float_as_int(v), 0x121, 0xf, 0xf, true)); }
__device__ __forceinline__ float dpp_rol1(float v) { return __int_as_float(__builtin_amdgcn_mov_dpp(__float_as_int(v), 0x12f, 0xf, 0xf, true)); }
__device__ __forceinline__ float dpp_shr1_zero(float v) { return __int_as_float(__builtin_amdgcn_mov_dpp(__float_as_int(v), 0x111, 0xf, 0xf, true)); }
__device__ __forceinline__ float dpp_shl1_zero(float v) { return __int_as_float(__builtin_amdgcn_mov_dpp(__float_as_int(v), 0x101, 0xf, 0xf, true)); }
__device__ __forceinline__ float dpp_shr1_keep(float old, float v) { return __int_as_float(__builtin_amdgcn_update_dpp(__float_as_int(old), __float_as_int(v), 0x111, 0xf, 0xf, false)); }
__device__ __forceinline__ float dpp_shl1_keep(float old, float v) { return __int_as_float(__builtin_amdgcn_update_dpp(__float_as_int(old), __float_as_int(v), 0x101, 0xf, 0xf, false)); }
struct EpiUp {
    static constexpr bool PERM = true;
    const Ptrs* Pp;
    __device__ __forceinline__ void operator()(const f32x4 (&acc)[2][2][4][2], const Unit& u, int wr_, int wc_, int fr_, int fq_) const {
        const Ptrs& P = *Pp;
        const int wr = wr_, wc = wc_, fr = fr_, fq = fq_;
        const int b = u.pm / 17, ti = u.pm % 17;
        const float* rq = (const float*)(P.ws + WS_ROWSQ) + (size_t)b * SEQL + 248 * ti + 62 * wr + fr - 1;
        const f32x4* ct = (const f32x4*)(P.ws + WS_CONVTAB) + (size_t)((((b * 22 + u.pn) * 4 + wc) * 4 + fq) * 20);
        const int ca0 = 128 * u.pn + 32 * wc + 8 * fq;
        float rstd[2][4]; bool valid[2][4];
#pragma unroll
        for (int ai = 0; ai < 2; ++ai)
#pragma unroll
            for (int m = 0; m < 4; ++m) {
                const int tok = 248 * ti + 62 * (2 * ai + wr) + 16 * m + fr - 1;
                valid[ai][m] = tok >= 0 && tok < SEQL;
                rstd[ai][m] = __builtin_amdgcn_rsqf(rq[124 * ai + 16 * m] * (1.f / DM) + EPSN);
            }
        bf16_t* ACT = (bf16_t*)(P.ws + WS_ACT);
#pragma unroll
        for (int ai = 0; ai < 2; ++ai) {
            float ya[4][2][4];
#pragma unroll
            for (int bj = 0; bj < 2; ++bj)
#pragma unroll
                for (int n = 0; n < 2; ++n) {
                    const f32x4 w0 = ct[(bj * 2 + n) * 5 + 0], w1 = ct[(bj * 2 + n) * 5 + 1], w2 = ct[(bj * 2 + n) * 5 + 2], bb = ct[(bj * 2 + n) * 5 + 3], bv = ct[(bj * 2 + n) * 5 + 4];
#pragma unroll
                    for (int j = 0; j < 4; ++j) {
                        float x[4], up[4], dn[4];
#pragma unroll
                        for (int m = 0; m < 4; ++m) { const float v = acc[ai][bj][m][n][j] * rstd[ai][m] + bv[j]; x[m] = valid[ai][m] ? v : 0.f; }
                        up[0] = dpp_shr1_zero(x[0]);
                        dn[3] = dpp_shl1_zero(x[3]);
#pragma unroll
                        for (int m = 1; m < 4; ++m) up[m] = dpp_shr1_keep(dpp_ror1(x[m - 1]), x[m]);
#pragma unroll
                        for (int m = 0; m < 3; ++m) dn[m] = dpp_shl1_keep(dpp_rol1(x[m + 1]), x[m]);
#pragma unroll
                        for (int m = 0; m < 4; ++m) {
                            const float y = bb[j] + w0[j] * up[m] + w1[j] * x[m] + w2[j] * dn[m];
                            if (bj == 0) ya[m][n][j] = y; else ya[m][n][j] = y * __builtin_amdgcn_rcpf(1.f + __builtin_amdgcn_exp2f(-1.4426950408889634f * y)) * ya[m][n][j];
                        }
                        asm volatile("" : "+v"(ya[0][n][j]), "+v"(ya[1][n][j]), "+v"(ya[2][n][j]), "+v"(ya[3][n][j]));
                        __builtin_amdgcn_sched_barrier(0);
                    }
                    asm volatile("" ::: "memory");
                }
#pragma unroll
            for (int m = 0; m < 4; ++m) {
                const int w = 16 * m + fr, tok = 248 * ti + 62 * (2 * ai + wr) + w - 1;
                u32x4 o; o.x = cvt_pk_bf16(ya[m][0][0], ya[m][0][1]); o.y = cvt_pk_bf16(ya[m][0][2], ya[m][0][3]); o.z = cvt_pk_bf16(ya[m][1][0], ya[m][1][1]); o.w = cvt_pk_bf16(ya[m][1][2], ya[m][1][3]);
                if (w >= 1 && w <= 62 && tok < SEQL) *(u32x4*)(ACT + ((size_t)b * SEQL + tok) * DFF + ca0) = o;
                __builtin_amdgcn_sched_barrier(0);
            }
        }
    }
};

__device__ __forceinline__ unsigned f2bf_u(float f) { unsigned u = __float_as_uint(f); return (u + 0x7fffu + ((u >> 16) & 1u)) >> 16; }
__device__ __forceinline__ unsigned pk2(float lo, float hi) { return f2bf_u(lo) | (f2bf_u(hi) << 16); }
template <class F>
__device__ __forceinline__ void transpose_item(const float* W, int K, int N, bf16_t* WT, LAS float* scr, int item, int lane, F srccol) {
    const int nblk = N / 32, kb = item / nblk, nb = item % nblk, k0 = 64 * kb, n0 = 32 * nb;
    const int col = srccol(n0 + (lane & 31));
    float v_[32];
#pragma unroll
    for (int i = 0; i < 32; ++i) v_[i] = __builtin_nontemporal_load(W + (size_t)(k0 + 2 * i + (lane >> 5)) * N + col);
#pragma unroll
    for (int i = 0; i < 32; ++i) scr[(2 * i + (lane >> 5)) * 33 + (lane & 31)] = v_[i];
    asm volatile("s_waitcnt lgkmcnt(0)" ::: "memory");
    const int c = lane & 7;
#pragma unroll
    for (int j = 0; j < 4; ++j) { const int n = (lane >> 3) + 8 * j; const LAS float* s = scr + (8 * c) * 33 + n;
        u32x4 o; o.x = cvt_pk_bf16(s[0 * 33], s[1 * 33]); o.y = cvt_pk_bf16(s[2 * 33], s[3 * 33]); o.z = cvt_pk_bf16(s[4 * 33], s[5 * 33]); o.w = cvt_pk_bf16(s[6 * 33], s[7 * 33]);
        *(u32x4*)(WT + (size_t)(n0 + n) * K + k0 + 8 * c) = o; }
    asm volatile("s_waitcnt lgkmcnt(0)" ::: "memory");
}
__device__ __forceinline__ void build_convtab(const Ptrs& P, int gtid) {
    if (gtid >= 1408 * 80) return;
    const int e = gtid % 80, entry = gtid / 80, bj = e / 40, n = (e / 20) & 1, k = (e >> 2) % 5, j = e & 3;
    const int fq = entry & 3, wc = (entry >> 2) & 3, pn = (entry >> 4) % 22, b = entry / 352;
    const int col = bj * DFF + 128 * pn + 32 * wc + 8 * fq + 4 * n + j;
    const float v = k < 3 ? P.in[IN_CONVW][k * NIN + col] : (k == 3 ? P.in[IN_CONVB][col] : ((const float*)(P.ws + WS_BIASUP))[b * NIN + col]);
    ((float*)(P.ws + WS_CONVTAB))[gtid] = v;
}
struct ColId { __device__ __forceinline__ int operator()(int n) const { return n; } };
struct ColIn { __device__ __forceinline__ int operator()(int n) const {
        if (n >= 2048) return n; const int s = n & 255, bj = s >> 7, wc = (s >> 5) & 3, fq = (s >> 3) & 3, nn = (s >> 2) & 1, j = s & 3; return (n & ~255) + 64 * wc + 32 * bj + 16 * nn + 4 * fq + j; } };
struct ColUp { __device__ __forceinline__ int operator()(int n) const { const int pn = n >> 8, s = n & 255; return s < 128 ? 128 * pn + s : DFF + 128 * pn + (s - 128); } };
constexpr int I_IN = 16 * 176, I_UP = 16 * 176, I_DN = 44 * 32, I_OUT = 16 * 32, I_BA = 16 * 32, I_BS = 8 * 32, I_GLU = 8 * 16;
constexpr int NTR_ITEMS = I_IN + I_UP + I_DN + I_OUT + I_BA + I_BS + I_GLU;
__device__ __forceinline__ void transpose_dispatch(const Ptrs& P, LAS float* scr, int r, int lane) {
    if (r < I_IN) { transpose_item(P.in[IN_WIN], DM, NIN, (bf16_t*)(P.ws + WS_WIN), scr, r, lane, ColIn()); return; } r -= I_IN;
    if (r < I_UP) { transpose_item(P.in[IN_WUP], DM, NIN, (bf16_t*)(P.ws + WS_WUP), scr, r, lane, ColUp()); return; } r -= I_UP;
    if (r < I_DN) { transpose_item(P.in[IN_WDOWN], DFF, DM, (bf16_t*)(P.ws + WS_WDOWN), scr, r, lane, ColId()); return; } r -= I_DN;
    if (r < I_OUT) { transpose_item(P.in[IN_WOUT], DM, DM, (bf16_t*)(P.ws + WS_WOUT), scr, r, lane, ColId()); return; } r -= I_OUT;
    if (r < I_BA) { transpose_item(P.in[IN_WBA], DM, DM, (bf16_t*)(P.ws + WS_WBA), scr, r, lane, ColId()); return; } r -= I_BA;
    if (r < I_BS) { transpose_item(P.in[IN_WBS], S5W, DM, (bf16_t*)(P.ws + WS_WBS), scr, r, lane, ColId()); return; } r -= I_BS;
    transpose_item(P.in[IN_GLUW], S5W, S5W, (bf16_t*)(P.ws + WS_WGLU), scr, r, lane, ColId());
}
__device__ __forceinline__ void p0_transposes(const Ptrs& P, LAS unsigned char* lds, int gw, int NGW, int wave, int lane) {
    LAS float* scr = (LAS float*)(lds + wave * 8704);
    const bool std_grid = NGW == 2048;
    const int bulk = std_grid ? (NTR_ITEMS / NGW) * NGW : NTR_ITEMS;
    for (int it = gw; it < bulk; it += NGW) transpose_dispatch(P, scr, it, lane);
    if (std_grid) {
        const int e = ((gw >> 3) - 192) * 8 + wave;
        if ((gw >> 3) >= 192 && e < NTR_ITEMS - bulk) transpose_dispatch(P, scr, bulk + e, lane);
    }
}
}
#ifndef PROBE_MFMA
#define PROBE_MFMA 0
#endif
#ifndef PROBE_EXP
#define PROBE_EXP 0
#endif
#ifndef PROBE_LDS
#define PROBE_LDS 0
#endif
namespace at {
typedef float f32x16 __attribute__((ext_vector_type(16)));
typedef short bf16x8 __attribute__((ext_vector_type(8)));
typedef short s16x4 __attribute__((ext_vector_type(4)));
typedef unsigned u32x4 __attribute__((ext_vector_type(4)));
constexpr int SLOT = 32768, XOFF = 65536, WSF = 131072;
__device__ __forceinline__ int crow(int r, int hi) { return (r & 3) + 8 * (r >> 2) + 4 * hi; }
typedef float f32x2_t __attribute__((ext_vector_type(2))); typedef __bf16 bf16x2_t __attribute__((ext_vector_type(2)));
__device__ __forceinline__ unsigned cvtpk(float lo, float hi) { f32x2_t v = {lo, hi}; bf16x2_t b = __builtin_convertvector(v, bf16x2_t); return __builtin_bit_cast(unsigned, b); }
__device__ __forceinline__ s16x4 vtr(const LAS unsigned char* p) { return __builtin_bit_cast(s16x4, __builtin_amdgcn_ds_read_tr16_b64_v4i16((LAS s16x4*)p)); }
#define AT_WAITBAR(N) asm volatile("s_waitcnt vmcnt(" #N ") lgkmcnt(0)\n\ts_barrier" ::: "memory")

struct Srcs { const char* k0; const char* k1; const char* v; };
__device__ __forceinline__ void glds16(const void* gsrc, unsigned lds_dst) { unsigned keep;
    asm volatile("s_mov_b32 %0, m0\n\ts_mov_b32 m0, %2\n\ts_nop 0\n\tglobal_load_lds_dwordx4 %1, off\n\ts_mov_b32 m0, %0" : "=&s"(keep) : "v"(gsrc), "s"(lds_dst) : "memory"); }
__device__ __forceinline__ void dma_piece(unsigned lds0, const Srcs& s, int t, int slot, int wid, int pc) {
    const unsigned d = (unsigned)__builtin_amdgcn_readfirstlane((int)(lds0 + slot * SLOT + wid * 1024));
    if (pc == 0) glds16(s.k0 + (size_t)t * 8192, d);
    else if (pc == 1) glds16(s.k1 + (size_t)t * 8192, d + 8192);
    else if (pc == 2) glds16(s.v + (size_t)t * 16384, d + 16384 + wid * 1024);
    else glds16(s.v + (size_t)t * 16384 + 1024, d + 16384 + wid * 1024 + 1024);
}
__device__ __forceinline__ void dma_tile(unsigned lds0, const Srcs& s, int t, int slot, int wid) {
#pragma unroll
    for (int pc = 0; pc < 4; ++pc) dma_piece(lds0, s, t, slot, wid, pc);
}
__device__ __forceinline__ Srcs unit_srcs(const Ptrs& P, int unit, int wid, int lane) {
    const int b = unit / (NHEAD * 32), h = (unit / 32) % NHEAD;
    Srcs s;
    s.k0 = (const char*)((const bf16_t*)(P.ws + WS_RK) + k_idx(b, h, 0, 0, 0)) + wid * 1024 + lane * 16;
    s.k1 = (const char*)((const bf16_t*)(P.ws + WS_RK) + k_idx(b, h, 1, 0, 0)) + wid * 1024 + lane * 16;
    s.v = (const char*)((const bf16_t*)(P.ws + WS_RV) + v_idx(b, h, 0, 0)) + wid * 2048 + lane * 16;
    return s;
}
__device__ __forceinline__ void attn_unit(const Ptrs& P, LAS unsigned char* lds, int unit, int next_unit, bool first, float lam, float mshift, int wid, bf16_t* Obase) {
    int lane_ = lane_id(); asm volatile("" : "+v"(lane_));
    const int lane = lane_, r32 = lane & 31, hi = lane >> 5;
    const int mp = wid >> 2, wq = wid & 3;
    const int b = unit / (NHEAD * 32), h = (unit / 32) % NHEAD, q0 = (unit % 32) * 128;
    const Srcs S = unit_srcs(P, unit, wid, lane);
    const unsigned lds0 = (unsigned)(uintptr_t)lds;
    if (first) { dma_tile(lds0, S, 0, 0, wid); dma_tile(lds0, S, 1, 1, wid); }
    bf16_t* Qg = (bf16_t*)(P.ws + WS_RQ);
    bf16x8 qr[4];
#pragma unroll
    for (int d0 = 0; d0 < 4; ++d0) qr[d0] = *(const bf16x8*)(Qg + q_idx(b, q0 + wq * 32 + r32, h, mp, d0 * 16 + hi * 8));
    const f32x16 zero16 = (f32x16){0.f, 0.f, 0.f, 0.f, 0.f, 0.f, 0.f, 0.f, 0.f, 0.f, 0.f, 0.f, 0.f, 0.f, 0.f, 0.f};
    f32x16 o[4];
#pragma unroll
    for (int d0 = 0; d0 < 4; ++d0) o[d0] = zero16;
    float s0 = 0.f, s1 = 0.f;
    const int koff = mp * 8192 + hi * 1024 + r32 * 16;
    const int voff = 16384 + ((lane >> 4) & 1) * 32 + (lane & 3) * 8 + (4 * hi + ((lane & 15) >> 2)) * 64;
#define AT_SB() __builtin_amdgcn_sched_barrier(0)
#define AT_VF(src, k4) (bf16x8){src[2 * (k4)][0], src[2 * (k4)][1], src[2 * (k4)][2], src[2 * (k4)][3], src[2 * (k4) + 1][0], src[2 * (k4) + 1][1], src[2 * (k4) + 1][2], src[2 * (k4) + 1][3]}
#define AT_VT(vs_, d0, j) vtr(vs_ + (d0) * 4096 + ((j) >> 1) * 1024 + ((j) & 1) * 512)
#define AT_PACK() do { _Pragma("unroll") for (int q = 0; q < 4; ++q) { pw[0][q] = cvtpk(p0[2 * q], p0[2 * q + 1]); pw[1][q] = cvtpk(p0[8 + 2 * q], p0[8 + 2 * q + 1]); pw[2][q] = cvtpk(p1[2 * q], p1[2 * q + 1]); pw[3][q] = cvtpk(p1[8 + 2 * q], p1[8 + 2 * q + 1]); } } while (0)
    AT_WAITBAR(4);
    if (2 < NKT) dma_tile(lds0, S, 2, 2, wid);
    f32x16 p0, p1; u32x4 pw[4];
    {
        const LAS unsigned char* ks = lds + koff;
        bf16x8 kf[8];
#pragma unroll
        for (int i = 0; i < 8; ++i) kf[i] = *(const LAS bf16x8*)(ks + (i >> 1) * 2048 + (i & 1) * 512);
#pragma unroll
        for (int d0 = 0; d0 < 4; ++d0) {
            p0 = __builtin_amdgcn_mfma_f32_32x32x16_bf16(kf[2 * d0], qr[d0], d0 == 0 ? zero16 : p0, 0, 0, 0);
            p1 = __builtin_amdgcn_mfma_f32_32x32x16_bf16(kf[2 * d0 + 1], qr[d0], d0 == 0 ? zero16 : p1, 0, 0, 0);
        }
#pragma unroll
        for (int r = 0; r < 16; ++r) { p0[r] = __builtin_amdgcn_exp2f(p0[r]); p1[r] = __builtin_amdgcn_exp2f(p1[r]); s0 += p0[r]; s1 += p1[r]; }
    }
    for (int t = 0; t < NKT; ++t) {
        const bool more = t + 1 < NKT;
        if (t + 2 < NKT) { AT_WAITBAR(4); } else { AT_WAITBAR(0); }
        const bool pf = t + 3 < NKT;
        const LAS unsigned char* ks = lds + ((t + 1) & 3) * SLOT + koff;
        const LAS unsigned char* vs = lds + (t & 3) * SLOT + voff;
        bf16x8 kf[8]; s16x4 va[8], vb[8];
        if (more) {
#pragma unroll
            for (int i = 0; i < 8; ++i) kf[i] = *(const LAS bf16x8*)(ks + (i >> 1) * 2048 + (i & 1) * 512);
        }
#pragma unroll
        for (int j = 0; j < 8; ++j) va[j] = AT_VT(vs, 0, j);
        AT_SB();
        AT_PACK();
        AT_SB();
        if (more) {
#pragma unroll
            for (int i = 0; i < 8; ++i) {
                if ((i & 1) == 0) p0 = __builtin_amdgcn_mfma_f32_32x32x16_bf16(kf[i], qr[i >> 1], i < 2 ? zero16 : p0, 0, 0, 0);
                else p1 = __builtin_amdgcn_mfma_f32_32x32x16_bf16(kf[i], qr[i >> 1], i < 2 ? zero16 : p1, 0, 0, 0);
                vb[i] = AT_VT(vs, 1, i);
                if ((i & 1) && pf) dma_piece(lds0, S, t + 3, (t + 3) & 3, wid, i >> 1);
                AT_SB();
            }
        } else {
#pragma unroll
            for (int j = 0; j < 8; ++j) vb[j] = AT_VT(vs, 1, j);
            AT_SB();
        }
#pragma unroll
        for (int i = 0; i < 16; ++i) {
            const int d0 = i >> 2, k4 = i & 3;
            if ((d0 & 1) == 0) o[d0] = __builtin_amdgcn_mfma_f32_32x32x16_bf16(__builtin_bit_cast(bf16x8, pw[k4]), AT_VF(va, k4), o[d0], 0, 0, 0);
            else o[d0] = __builtin_amdgcn_mfma_f32_32x32x16_bf16(__builtin_bit_cast(bf16x8, pw[k4]), AT_VF(vb, k4), o[d0], 0, 0, 0);
            if (more) {
                const int r = 2 * (i & 7);
                if (i < 8) { p0[r] = __builtin_amdgcn_exp2f(p0[r]); p0[r + 1] = __builtin_amdgcn_exp2f(p0[r + 1]); s0 += p0[r]; s1 += p0[r + 1]; }
                else { p1[r] = __builtin_amdgcn_exp2f(p1[r]); p1[r + 1] = __builtin_amdgcn_exp2f(p1[r + 1]); s0 += p1[r]; s1 += p1[r + 1]; }
            }
            if (i >= 4 && i < 8) { va[2 * (i - 4)] = AT_VT(vs, 2, 2 * (i - 4)); va[2 * (i - 4) + 1] = AT_VT(vs, 2, 2 * (i - 4) + 1); }
            if (i >= 8 && i < 12) { vb[2 * (i - 8)] = AT_VT(vs, 3, 2 * (i - 8)); vb[2 * (i - 8) + 1] = AT_VT(vs, 3, 2 * (i - 8) + 1); }
            AT_SB();
        }
    }
    float l_reg = s0 + s1;
#undef AT_VF
#undef AT_VT
#undef AT_PACK
#undef AT_SB
    AT_WAITBAR(0);
    if (next_unit >= 0) { const Srcs N = unit_srcs(P, next_unit, wid, lane); dma_tile(lds0, N, 0, 0, wid); dma_tile(lds0, N, 1, 1, wid); }
    l_reg += __shfl_xor(l_reg, 32);
    LAS float* wsf = (LAS float*)(lds + WSF) + wid * 64;
    if (hi == 0) wsf[r32] = (mp == 0 ? 1.f : lam) / l_reg;
    asm volatile("s_waitcnt lgkmcnt(0)" ::: "memory");
    float fac[16];
#pragma unroll
    for (int r = 0; r < 16; ++r) fac[r] = wsf[crow(r, hi)];
    LAS float* X = (LAS float*)(lds + XOFF) + wq * 4096;
    if (mp == 1) {
#pragma unroll
        for (int d0 = 0; d0 < 4; ++d0)
#pragma unroll
            for (int r = 0; r < 16; ++r) X[(d0 * 16 + r) * 64 + lane] = o[d0][r] * fac[r];
    }
    AT_WAITBAR(4);
    if (mp == 0) {
        float ss[16];
#pragma unroll
        for (int r = 0; r < 16; ++r) ss[r] = 0.f;
#pragma unroll
        for (int d0 = 0; d0 < 4; ++d0)
#pragma unroll
            for (int r = 0; r < 16; ++r) { const float v = o[d0][r] * fac[r] - X[(d0 * 16 + r) * 64 + lane]; o[d0][r] = v; ss[r] += v * v; }
#pragma unroll
        for (int r = 0; r < 16; ++r) {
            float s = ss[r];
            s += __shfl_xor(s, 1); s += __shfl_xor(s, 2); s += __shfl_xor(s, 4); s += __shfl_xor(s, 8); s += __shfl_xor(s, 16);
            ss[r] = __builtin_amdgcn_rsqf(s * (1.f / 128.f) + EPSN) * (1.f - LAM_INIT);
        }
        asm volatile("s_waitcnt lgkmcnt(0)" ::: "memory");
        LAS bf16_t* stg = (LAS bf16_t*)(lds + XOFF + wq * 16384);
#pragma unroll
        for (int d0 = 0; d0 < 4; ++d0) {
            const float sw = P.in[IN_SUBLN][d0 * 32 + r32];
#pragma unroll
            for (int r = 0; r < 16; r += 2) { const unsigned pk = cvtpk(o[d0][r] * ss[r] * sw, o[d0][r + 1] * ss[r + 1] * sw);
                stg[crow(r, hi) * 128 + d0 * 32 + r32] = (bf16_t)(pk & 0xffffu); stg[crow(r + 1, hi) * 128 + d0 * 32 + r32] = (bf16_t)(pk >> 16); }
        }
        asm volatile("s_waitcnt lgkmcnt(0)" ::: "memory");
        bf16_t* On = Obase + ((size_t)(b * SEQL + q0 + wq * 32)) * 1024 + h * 128;
#pragma unroll
        for (int i = 0; i < 8; ++i) { const int row = i * 4 + (lane >> 4), ch = lane & 15;
            const u32x4 v = *(const LAS u32x4*)(stg + row * 128 + ch * 8);
            *(u32x4*)(On + (size_t)row * 1024 + ch * 8) = v; }
    }
}
#undef AT_WAITBAR
__device__ __forceinline__ void attn_phase(const Ptrs& P, LAS unsigned char* lds, int G, int bx, int wave, bf16_t* Obase) {
    const int lane = lane_id();
    const float lam = __expf(wave_sum(P.in[IN_LQ1][lane] * P.in[IN_LK1][lane])) - __expf(wave_sum(P.in[IN_LQ2][lane] * P.in[IN_LK2][lane])) + LAM_INIT;
    const float mshift = 8.f * 1.4426950408889634f * wave_max(fabsf(P.in[IN_QNW][lane])) * wave_max(fabsf(P.in[IN_KNW][lane]));
    const int vcu = (G % 8 == 0) ? (bx % 8) * (G / 8) + bx / 8 : bx;
    const int NU = NB * NHEAD * 32;
    bool first = true;
    for (int u = vcu; u < NU; u += G) { attn_unit(P, lds, u, u + G < NU ? u + G : -1, first, lam, mshift, wave, Obase); first = false; }
    asm volatile("s_waitcnt vmcnt(0) lgkmcnt(0)" ::: "memory");
    __syncthreads();
}
}
namespace s5 {
using pg8::Unit; using pg8::f32x4; using pg8::u32x4;
typedef float f2 __attribute__((ext_vector_type(2)));
__device__ __forceinline__ f2 cmul(f2 a, f2 b) { return (f2){a.x * b.x - a.y * b.y, a.x * b.y + a.y * b.x}; }

__device__ void build_tables(const Ptrs& P, LAS unsigned char* lds, int item, int tid) {
    const int g = item >> 3, qt = item & 7;
    LAS f2* apow = (LAS f2*)lds;
    LAS f2* BB = (LAS f2*)(lds + 17408);
    LAS f2* CC = (LAS f2*)(lds + 33792);
    LAS float* Mt = (LAS float*)(lds + 50176);
    if (tid < 128) {
        const int d = tid >> 6, p = tid & 63, gi = (d * NGRP + g) * NST + p;
        const float lre = fminf(P.in[IN_ARE][gi], -1e-4f), lim = P.in[IN_AIM][gi], dt = __expf(P.in[IN_LOGDT][d * NGRP + g]);
        for (int n = 0; n <= 16; ++n) { const float mag = __expf(lre * dt * (float)n); float sn, cs; sincosf(lim * dt * (float)n, &sn, &cs); apow[(d * 64 + p) * 17 + n] = (f2){mag * cs, mag * sn}; }
        if (qt == 0) ((f2*)(P.ws + WS_A16))[(g * 2 + d) * 64 + p] = apow[(d * 64 + p) * 17 + 16];
        const f2 a1 = apow[(d * 64 + p) * 17 + 1];
        const float nr = a1.x - 1.f, ni = a1.y, den = lre * lre + lim * lim;
        const f2 fz = (f2){(nr * lre + ni * lim) / den, (ni * lre - nr * lim) / den};
        for (int c = 0; c < 16; ++c) {
            BB[(d * 64 + p) * 16 + c] = cmul(fz, (f2){P.in[IN_BRE][(size_t)gi * 16 + c], P.in[IN_BIM][(size_t)gi * 16 + c]});
            CC[(d * 64 + p) * 16 + c] = (f2){P.in[IN_CRE][((size_t)(d * NGRP + g) * 16 + c) * NST + p], P.in[IN_CIM][((size_t)(d * NGRP + g) * 16 + c) * NST + p]};
        }
    }
    __syncthreads();
    {
        const int d = tid >> 8, dl = (tid >> 4) & 15, c = tid & 15;
        const int np = (d == 0 ? dl <= 2 * qt + 1 : dl <= 15 - 2 * qt) ? 64 : 0;
        float acc[16];
#pragma unroll
        for (int cp = 0; cp < 16; ++cp) acc[cp] = 0.f;
        for (int p = 0; p < np; ++p) {
            const f2 t = cmul(CC[(d * 64 + p) * 16 + c], apow[(d * 64 + p) * 17 + dl]);
#pragma unroll
            for (int cp = 0; cp < 16; ++cp) { const f2 bb = BB[(d * 64 + p) * 16 + cp]; acc[cp] += t.x * bb.x - t.y * bb.y; }
        }
#pragma unroll
        for (int cp = 0; cp < 16; ++cp) Mt[((d * 16 + dl) * 16 + c) * 16 + cp] = acc[cp];
    }
    __syncthreads();
    bf16_t* TQ = (bf16_t*)(P.ws + WS_TQ) + (size_t)g * 256 * 512;
    for (int e = tid; e < 32 * 512; e += 512) {
        const int row = qt * 32 + (e >> 9), K = e & 511, tau = row >> 4, c = row & 15;
        float v;
        if (K < 256) { const int sg = K >> 4, cp = K & 15;
            v = tau > sg ? Mt[((0 * 16 + (tau - sg)) * 16 + c) * 16 + cp] : (tau < sg ? Mt[((1 * 16 + (sg - tau)) * 16 + c) * 16 + cp] : Mt[(0 * 16 * 16 + c) * 16 + cp] + Mt[((1 * 16) * 16 + c) * 16 + cp]);
        } else { const int r = K - 256, d = r >> 7, ri = (r >> 6) & 1, p = r & 63;
            const f2 t = cmul(CC[(d * 64 + p) * 16 + c], apow[(d * 64 + p) * 17 + (d == 0 ? tau + 1 : 16 - tau)]);
            v = ri == 0 ? t.x : -t.y; }
        TQ[(size_t)row * 512 + K] = f2bf(v);
    }
    bf16_t* PS = (bf16_t*)(P.ws + WS_PST) + (size_t)g * 256 * 256;
    for (int e = tid; e < 32 * 256; e += 512) {
        const int r = qt * 32 + (e >> 8), K = e & 255, sg = K >> 4, cp = K & 15, d = r >> 7, ri = (r >> 6) & 1, p = r & 63;
        const f2 t = cmul(apow[(d * 64 + p) * 17 + (d == 0 ? 15 - sg : sg)], BB[(d * 64 + p) * 16 + cp]);
        PS[(size_t)r * 256 + K] = f2bf(ri == 0 ? t.x : t.y);
    }
    __syncthreads();
}

struct SchedE { int bg, g; __device__ __forceinline__ bool next(int i, Unit& u) const { if (i >= 1) return false; u.arow = bg * NCH; u.brow = g * 256; u.pm = 0; u.pn = 0; return true; } };
struct EpiE {
    static constexpr bool PERM = true;
    float* Es;
    __device__ __forceinline__ void operator()(const f32x4 (&acc)[2][2][4][2], const Unit& u, int wr, int wc, int fr, int fq) const {
#pragma unroll
        for (int ai = 0; ai < 2; ++ai)
#pragma unroll
            for (int m = 0; m < 4; ++m) {
                const int j = 256 * u.pm + 128 * ai + 64 * wr + 16 * m + fr;
                if (j < NCH) {
#pragma unroll
                    for (int bj = 0; bj < 2; ++bj) { float* e = Es + (size_t)j * 256 + 128 * bj + 32 * wc + 8 * fq; *(f32x4*)e = acc[ai][bj][m][0]; *(f32x4*)(e + 4) = acc[ai][bj][m][1]; }
                }
            }
    }
};
struct EpiY {
    static constexpr bool PERM = true;
    const Ptrs* Pp; int b, g;
    __device__ __forceinline__ void operator()(const f32x4 (&acc)[2][2][4][2], const Unit& u, int wr, int wc, int fr, int fq) const {
        const Ptrs& P = *Pp;
        const int c0 = 8 * (fq & 1);
        const f32x4 d0 = *(const f32x4*)(P.in[IN_S5D] + g * 16 + c0), d1 = *(const f32x4*)(P.in[IN_S5D] + g * 16 + c0 + 4);
#pragma unroll
        for (int ai = 0; ai < 2; ++ai)
#pragma unroll
            for (int m = 0; m < 4; ++m) {
                const int j = 128 * ai + 64 * wr + 16 * m + fr;
#pragma unroll
                for (int bj = 0; bj < 2; ++bj) {
                    const int tau = 8 * bj + 2 * wc + (fq >> 1);
                    const u32x4 uu = *(const u32x4*)((const bf16_t*)(P.ws + WS_RU) + u_idx(b, g, j, tau, c0));
                    f32x4 y0 = acc[ai][bj][m][0] + d0 * og::unpk_lo(uu), y1 = acc[ai][bj][m][1] + d1 * og::unpk_hi(uu);
#pragma unroll
                    for (int q = 0; q < 4; ++q) {
                        const float a = y0[q], bb = y1[q];
                        y0[q] = a * __builtin_amdgcn_rcpf(1.f + __builtin_amdgcn_exp2f(-2.f * 1.4426950408889634f * 0.7978845608028654f * (a + 0.044715f * a * a * a)));
                        y1[q] = bb * __builtin_amdgcn_rcpf(1.f + __builtin_amdgcn_exp2f(-2.f * 1.4426950408889634f * 0.7978845608028654f * (bb + 0.044715f * bb * bb * bb)));
                    }
                    *(u32x4*)((bf16_t*)(P.ws + WS_HS) + ((size_t)(b * SEQL + 16 * j + tau)) * S5W + g * 16 + c0) = og::pack8(y0, y1);
                }
            }
    }
};
__device__ __forceinline__ void scan(const Ptrs& P, int bg, int g, const float* Es, int tid) {
    if (tid >= 128) return;
    const int d = tid >> 6, p = tid & 63;
    const f2 a16 = ((const f2*)(P.ws + WS_A16))[(g * 2 + d) * 64 + p];
    const float ar = a16.x, ai = a16.y;
    const float* er = Es + d * 128 + p; const float* ei = er + 64;
    bf16_t* U = (bf16_t*)(P.ws + WS_RU) + (size_t)bg * NCH * 512 + 256 + d * 128 + p;
    float sr = 0.f, si = 0.f;
    for (int k = 0; k < 16; ++k) { const int j = d == 0 ? 256 + k : 271 - k; const float xr = er[(size_t)j * 256], xi = ei[(size_t)j * 256];
        const float nr = ar * sr - ai * si + xr, ni = ar * si + ai * sr + xi; sr = nr; si = ni; }
    float xr[16], xi[16], nr_[16], ni_[16];
#pragma unroll
    for (int k = 0; k < 16; ++k) { const int j = d == 0 ? k : 255 - k; xr[k] = er[(size_t)j * 256]; xi[k] = ei[(size_t)j * 256]; }
    for (int k0 = 0; k0 < 256; k0 += 16) {
        if (k0 + 16 < 256) {
#pragma unroll
            for (int k = 0; k < 16; ++k) { const int j = d == 0 ? k0 + 16 + k : 255 - k0 - 16 - k; nr_[k] = er[(size_t)j * 256]; ni_[k] = ei[(size_t)j * 256]; }
        }
#pragma unroll
        for (int k = 0; k < 16; ++k) { const int j = d == 0 ? k0 + k : 255 - k0 - k;
            U[(size_t)j * 512] = f2bf(sr); U[(size_t)j * 512 + 64] = f2bf(si);
            const float nr = ar * sr - ai * si + xr[k], ni = ar * si + ai * sr + xi[k]; sr = nr; si = ni; }
#pragma unroll
        for (int k = 0; k < 16; ++k) { xr[k] = nr_[k]; xi[k] = ni_[k]; }
    }
}
__device__ __forceinline__ void ctx_states(const Ptrs& P, int bg, int g, float* Es, int wave, int lane) {
    typedef short bf16x8 __attribute__((ext_vector_type(8)));
    const int i16 = lane & 15, kq = lane >> 4;
    const bf16_t* Ua = (const bf16_t*)(P.ws + WS_RU) + ((size_t)bg * NCH + 256 + i16) * 512 + 8 * kq;
    bf16x8 af[8];
#pragma unroll
    for (int ks = 0; ks < 8; ++ks) af[ks] = *(const bf16x8*)(Ua + 32 * ks);
#pragma unroll
    for (int q = 0; q < 2; ++q) {
        const int nt = 2 * wave + q;
        const bf16_t* Pb = (const bf16_t*)(P.ws + WS_PST) + ((size_t)g * 256 + 16 * nt + i16) * 256 + 8 * kq;
        f32x4 acc = (f32x4){0.f, 0.f, 0.f, 0.f};
#pragma unroll
        for (int ks = 0; ks < 8; ++ks) acc = __builtin_amdgcn_mfma_f32_16x16x32_bf16(af[ks], *(const bf16x8*)(Pb + 32 * ks), acc, 0, 0, 0);
#pragma unroll
        for (int reg = 0; reg < 4; ++reg) Es[(size_t)(256 + 4 * kq + reg) * 256 + 16 * nt + i16] = acc[reg];
    }
}
__device__ __forceinline__ void s5_item(const Ptrs& P, LAS unsigned char* ring, int bg, int wave) {
    const int b = bg / NGRP, g = bg % NGRP;
    float* Es = (float*)(P.ws + WS_RH) + (size_t)bg * NCH * 256;
    const bf16_t* U = (const bf16_t*)(P.ws + WS_RU);
    { int l_ = lane_id(); asm volatile("" : "+v"(l_)); ctx_states(P, bg, g, Es, wave, l_); }
    { const pg8::Gemm g1{U, (const bf16_t*)(P.ws + WS_PST), 256, 512, 256};
      pg8::gemm_phase<EpiE, SchedE, false, 0>(ring, g1, SchedE{bg, g}, EpiE{Es}, wave); }
    asm volatile("s_waitcnt vmcnt(0)" ::: "memory"); __syncthreads();
    { int t_ = wave * 64 + lane_id(); asm volatile("" : "+v"(t_)); scan(P, bg, g, Es, t_); }
    asm volatile("s_waitcnt vmcnt(0)" ::: "memory"); __syncthreads();
    { const pg8::Gemm g2{U, (const bf16_t*)(P.ws + WS_TQ), 512, 512, 512};
      og::SchedOne so; so.v.arow = bg * NCH; so.v.brow = g * 256; so.v.pm = 0; so.v.pn = 0;
      pg8::gemm_phase<EpiY, og::SchedOne, false, 0>(ring, g2, so, EpiY{&P, b, g}, wave); }
}
}
namespace p0 {
typedef float f32x4 __attribute__((ext_vector_type(4)));
typedef unsigned u32x2 __attribute__((ext_vector_type(2)));
__device__ __forceinline__ void mod_item(const Ptrs& P, int item, int vt) {
    const int ct = item % 24, ks = item / 24, col = ct * 256 + vt, k0 = ks * 64;
    const float* W = P.in[IN_ADAW] + (size_t)k0 * 6144 + col;
    float acc[5] = {0.f, 0.f, 0.f, 0.f, 0.f};
#pragma unroll 1
    for (int kb = 0; kb < 64; kb += 16) {
    float wv[16];
#pragma unroll
    for (int k = 0; k < 16; ++k) wv[k] = __builtin_nontemporal_load(W + (size_t)(kb + k) * 6144);
#pragma unroll
    for (int kk = 0; kk < 16; ++kk) {
        const int k = kb + kk; const float w = wv[kk];
#pragma unroll
        for (int r = 0; r < 5; ++r) { const float c = r < 4 ? P.in[IN_C][r * DM + k0 + k] : P.in[IN_CCTX][k0 + k]; acc[r] += c * __builtin_amdgcn_rcpf(1.f + __builtin_amdgcn_exp2f(-1.4426950408889634f * c)) * w; }
    }
    }
    float* mod = (float*)(P.ws + WS_MODFIN);
#pragma unroll
    for (int r = 0; r < 5; ++r) atomicAdd(mod + r * 6144 + col, acc[r] + (ks == 0 ? P.in[IN_ADAB][col] : 0.f));
}
__device__ __forceinline__ void biasup_item(const Ptrs& P, int item, int vt) {
    const int ct = item % 22, ks = item / 22, n = ct * 256 + vt, k0 = ks * 64;
    const float* W = P.in[IN_WUP] + (size_t)k0 * NIN + n;
    const float* mod = (const float*)(P.ws + WS_MODFIN) + 3072 + k0;
    float acc[4] = {0.f, 0.f, 0.f, 0.f};
#pragma unroll 1
    for (int kb = 0; kb < 64; kb += 16) {
    float wv[16];
#pragma unroll
    for (int k = 0; k < 16; ++k) wv[k] = __builtin_nontemporal_load(W + (size_t)(kb + k) * NIN);
#pragma unroll
    for (int kk = 0; kk < 16; ++kk) {
        const int k = kb + kk; const float w = wv[kk];
#pragma unroll
        for (int b = 0; b < 4; ++b) acc[b] += mod[b * 6144 + k] * w;
    }
    }
#pragma unroll
    for (int b = 0; b < 4; ++b) atomicAdd((float*)(P.ws + WS_BIASUP) + b * NIN + n, acc[b]);
}
__device__ __forceinline__ void modulate_row(const Ptrs& P, int r, int lane) {
    const float* xr = r < MR ? P.in[IN_X] + (size_t)r * DM : P.in[IN_CTX] + (size_t)(r - MR) * DM;
    const float* mod = (const float*)(P.ws + WS_MODFIN) + (r < MR ? r / SEQL : 4) * 6144;
    f32x4 v[4]; float ss = 0.f;
#pragma unroll
    for (int j = 0; j < 4; ++j) { v[j] = __builtin_nontemporal_load((const f32x4*)(xr + 256 * j + 4 * lane)); ss += (v[j][0] * v[j][0] + v[j][1] * v[j][1]) + (v[j][2] * v[j][2] + v[j][3] * v[j][3]); }
    const float rstd = __builtin_amdgcn_rsqf(wave_sum(ss) * (1.f / DM) + EPSN);
    bf16_t* H = (bf16_t*)(P.ws + WS_RH) + (size_t)r * DM;
#pragma unroll
    for (int j = 0; j < 4; ++j) { const int k = 256 * j + 4 * lane;
        const f32x4 w = *(const f32x4*)(P.in[IN_N1W] + k), sc = *(const f32x4*)(mod + 1024 + k), sh = *(const f32x4*)(mod + k);
        const f32x4 y = v[j] * rstd * w * (sc + 1.f) + sh;
        u32x2 o; o.x = pg8::cvt_pk_bf16(y[0], y[1]); o.y = pg8::cvt_pk_bf16(y[2], y[3]);
        *(u32x2*)(H + k) = o; }
}
}

#define XB_TMO      128
#define XB_XCNT(j)  (256  + 64 * (j))
#define XB_XSUB(j)  (1280 + 64 * (j))
#define XB_XGEN(j)  (2304 + 64 * (j))
#define XB_TOP      3328
#define XB_TOPGEN   3392
#define XCD_BAR_WORDS 3456
#define XB_SPIN_CAP (1u << 22)
constexpr int CW_BAR = 4096;

__device__ __forceinline__ unsigned xb_ld(unsigned* p)              { return __hip_atomic_load(p, __ATOMIC_RELAXED, __HIP_MEMORY_SCOPE_AGENT); }
__device__ __forceinline__ unsigned xb_add(unsigned* p, unsigned v) { return __hip_atomic_fetch_add(p, v, __ATOMIC_RELAXED, __HIP_MEMORY_SCOPE_AGENT); }
__device__ __forceinline__ unsigned xb_xcc_id() { return (unsigned)__builtin_amdgcn_s_getreg((3 << 11) | 20) & 0xFu; }
#define XB_SPIN(cond, bar) do { unsigned _sp = 0; while (cond) { __builtin_amdgcn_s_sleep(1); \
    if ((++_sp & 255u) == 0u) { if (xb_ld(&(bar)[XB_TMO])) break; if (_sp > XB_SPIN_CAP) { atomicAdd(&(bar)[XB_TMO], 1u); break; } } } } while (0)
struct XcdBarrier { unsigned* bar; unsigned x; volatile LAS unsigned* st; };
__device__ __forceinline__ XcdBarrier xcd_barrier_post(unsigned* bar, volatile LAS unsigned* st, int tid) {
    XcdBarrier b; b.bar = bar; b.x = xb_xcc_id(); b.st = st;
    if (tid == 0) (void)xb_add(&bar[XB_XCNT(b.x)], 1u);
    return b;
}
__device__ __forceinline__ void xcd_barrier_complete(unsigned* bar, unsigned x, unsigned& nloc, unsigned& nx) {
    const unsigned G = gridDim.x * gridDim.y * gridDim.z;
    unsigned sum, cnt, mine, sp = 0u;
    for (;;) {
        sum = 0u; cnt = 0u; mine = 0u;
#pragma unroll
        for (unsigned j = 0; j < 16; ++j) { const unsigned c = xb_ld(&bar[XB_XCNT(j)]); sum += c; cnt += (c > 0u) ? 1u : 0u; mine = (j == x) ? c : mine; }
        if (sum == G) break;
        __builtin_amdgcn_s_sleep(1);
        if ((++sp & 255u) == 0u) { if (xb_ld(&bar[XB_TMO])) break; if (sp > XB_SPIN_CAP) { atomicAdd(&bar[XB_TMO], 1u); break; } }
    }
    nloc = mine > 0u ? mine : 1u; nx = cnt > 0u ? cnt : 1u;
}
__device__ __forceinline__ void xcd_barrier(const XcdBarrier& b, int wave) {
    const int tid0 = wave * 64 + lane_id();
    asm volatile("s_waitcnt vmcnt(0)" ::: "memory");
    __syncthreads();
    if (tid0 == 0) {
        unsigned* bar = b.bar;
        __builtin_amdgcn_s_waitcnt(0);
        unsigned nloc = b.st[0], nx = b.st[1];
        if (nloc == 0u) { xcd_barrier_complete(bar, b.x, nloc, nx); b.st[0] = nloc; b.st[1] = nx; }
        const unsigned old = xb_add(&bar[XB_XSUB(b.x)], 1u);
        const unsigned gen = old / nloc;
        if (old + 1u == (gen + 1u) * nloc) {
            __builtin_amdgcn_fence(__ATOMIC_RELEASE, "agent");
            asm volatile("s_waitcnt vmcnt(0)" ::: "memory");
            const unsigned og = xb_add(&bar[XB_TOP], 1u);
            const unsigned tg = og / nx;
            if (og + 1u == (tg + 1u) * nx) xb_add(&bar[XB_TOPGEN], 1u);
            else XB_SPIN(xb_ld(&bar[XB_TOPGEN]) == tg, bar);
            __builtin_amdgcn_fence(__ATOMIC_ACQUIRE, "agent");
            xb_add(&bar[XB_XGEN(b.x)], 1u);
            asm volatile("s_waitcnt vmcnt(0)" ::: "memory");
        } else {
            XB_SPIN(xb_ld(&bar[XB_XGEN(b.x)]) == gen, bar);
            __builtin_amdgcn_fence(__ATOMIC_ACQUIRE, "agent");
            asm volatile("s_waitcnt vmcnt(0)" ::: "memory");
        }
    }
    __syncthreads();
}

#ifndef OPT_GEMM
#define OPT_GEMM 1
#endif
#ifndef OPT_P1
#define OPT_P1 1
#endif
#ifndef OPT_P3
#define OPT_P3 1
#endif
#ifndef OPT_P4
#define OPT_P4 1
#endif
#ifndef OPT_ATTN
#define OPT_ATTN 1
#endif
#ifndef OPT_S5
#define OPT_S5 1
#endif
#ifndef OPT_P0
#define OPT_P0 1
#endif
#ifndef REP_P1
#define REP_P1 0
#endif
#ifndef REP_P4
#define REP_P4 0
#endif
#ifndef REP_S5
#define REP_S5 0
#endif
#ifndef REP_ATTN
#define REP_ATTN 0
#endif
#ifndef REP_BAR
#define REP_BAR 0
#endif
#ifndef REP_P3
#define REP_P3 0
#endif
#ifndef REP_P0
#define REP_P0 0
#endif
#ifndef USE_COOP_LAUNCH
#define USE_COOP_LAUNCH 1
#endif
#ifndef OPT_P5
#define OPT_P5 1
#endif
constexpr int LDS_BYTES = 147456;
constexpr int LDS_MISC = LDS_BYTES - 512;
struct Args { Ptrs P; int ph_lo, ph_hi; };

__global__ void __launch_bounds__(512, 2) mega(Args a) {
    extern __shared__ __attribute__((aligned(16))) unsigned char lds[];
    const Ptrs& P = a.P;
    const int wave = __builtin_amdgcn_readfirstlane(threadIdx.x >> 6);
    const int lane = lane_id(), tid = wave * 64 + lane, half = tid >> 8, vt = tid & 255;
    const int G = gridDim.x, bx = blockIdx.x;
    if (tid < 128) ((LAS unsigned*)(lds + LDS_MISC))[tid] = 0u;
    __syncthreads();
    XcdBarrier bar = xcd_barrier_post((unsigned*)(P.ws + WS_CTL) + CW_BAR, (volatile LAS unsigned*)(lds + LDS_MISC) + 8, tid);
    char* lh = (char*)lds + half * NB_LDS;
    const int lo = a.ph_lo, hi = a.ph_hi;
#define IN(k) (lo <= (k) && (k) < hi)
#define SEAM(k) do { if (IN(k) && IN((k) + 1)) xcd_barrier(bar, wave); } while (0)
#define VB2(NV) for (int v_ = 2 * bx + half; v_ < (NV); v_ += 2 * G)

    LAS unsigned char* ring = (LAS unsigned char*)lds;
#if REP_P0
    {
    if (IN(0)) {
#if OPT_P0
        VB2(24 * 16) p0::mod_item(P, v_, vt);
#else
        VB2(120) nb_mod(P, v_ % 24, v_ / 24, vt);
#endif
        VB2(4) nb_rope(P, v_, vt);
        for (int i = bx * 512 + tid; i < MR + 512; i += G * 512) ((float*)(P.ws + WS_ROWSQ0))[i] = 0.f;
#if OPT_S5
        for (int it = bx; it < NGRP * 8; it += G) s5::build_tables(P, ring, it, tid);
#endif
#if OPT_GEMM
        og::p0_transposes(P, ring, bx * 8 + wave, G * 8, wave, lane);
#endif
    }
    xcd_barrier(bar, wave);
    if (IN(1)) {
#if OPT_P0
        for (int r = bx * 8 + wave; r < MT; r += G * 8) p0::modulate_row(P, r, lane);
#else
        VB2(88) nb_biasup(P, v_ % 22, v_ / 22, vt);
        VB2(MT / 4) nb_modulate(P, v_, vt);
#endif
    }
    xcd_barrier(bar, wave);
    for (int i = bx * 512 + tid; i < (int)((768 * 1024 - 512 * 1024) / 4); i += G * 512) ((float*)(P.ws + WS_MODFIN))[i] = 0.f;
    xcd_barrier(bar, wave);
    }
#endif
    if (IN(0)) {
#if OPT_P0
        VB2(24 * 16) p0::mod_item(P, v_, vt);
#else
        VB2(120) nb_mod(P, v_ % 24, v_ / 24, vt);
#endif
        VB2(4) nb_rope(P, v_, vt);
        for (int i = bx * 512 + tid; i < MR + 512; i += G * 512) ((float*)(P.ws + WS_ROWSQ0))[i] = 0.f;
#if OPT_S5
        for (int it = bx; it < NGRP * 8; it += G) s5::build_tables(P, ring, it, tid);
#endif
#if OPT_GEMM
        og::p0_transposes(P, ring, bx * 8 + wave, G * 8, wave, lane);
#endif
    }
    SEAM(0);
    if (IN(1)) {
#if OPT_P0
        for (int r = bx * 8 + wave; r < MT; r += G * 8) p0::modulate_row(P, r, lane);
#else
        VB2(88) nb_biasup(P, v_ % 22, v_ / 22, vt);
        VB2(MT / 4) nb_modulate(P, v_, vt);
#endif
    }
    SEAM(1);
    if (IN(2)) {
#if OPT_GEMM && OPT_P1
        { const pg8::Gemm g{(const bf16_t*)(P.ws + WS_RH), (const bf16_t*)(P.ws + WS_WIN), DM, DM, DM};
          for (int rep_ = 0; rep_ < 1 + REP_P1; ++rep_) pg8::gemm_phase<og::EpiIn, og::SchedIn, true, 0>(ring, g, og::SchedIn{G, bx}, og::EpiIn{&P}, wave); }
        {
            const int nshort = G - (1448 % G), first_short = 1448 % G;
            if (first_short == 0) { for (int v_ = 2 * bx + half; v_ < 22 * 16; v_ += 2 * G) p0::biasup_item(P, v_, vt); }
            else if (bx >= first_short) { for (int v_ = 2 * (bx - first_short) + half; v_ < 22 * 16; v_ += 2 * nshort) p0::biasup_item(P, v_, vt); }
        }
#else
        VB2((NIN / 64) * (MT / 64)) nb_inproj(P, v_ % (NIN / 64), v_ / (NIN / 64), vt, lh);
#endif
    }
#if REP_BAR
    for (int rb_ = 0; rb_ < 10; ++rb_) xcd_barrier(bar, wave);
#endif
    SEAM(2);
    if (IN(3)) {
#if OPT_GEMM
        og::build_convtab(P, bx * 512 + tid);
#endif
#if OPT_ATTN
#if REP_ATTN
        at::attn_phase(P, ring, G, bx, wave, (bf16_t*)(P.ws + WS_RH)); xcd_barrier(bar, wave);
#endif
        at::attn_phase(P, ring, G, bx, wave, (bf16_t*)(P.ws + WS_RQ));
#else
        if (wave < 4) for (int it = 4 * bx + wave; it < NB * NHEAD * SEQL; it += 4 * G) nb_attn(P, it, lane, (char*)lds + wave * 35328);
#endif
#if OPT_S5
        xcd_barrier(bar, wave);
        {
            const int nS = NB * NGRP;
            const pg8::Gemm gya{(const bf16_t*)(P.ws + WS_RQ), (const bf16_t*)(P.ws + WS_WBA), DM, DM, DM};
            if (G > nS) {
                if (bx < nS) { for (int rep_ = 0; rep_ < 1 + REP_S5; ++rep_) s5::s5_item(P, ring, bx, wave); }
                else pg8::gemm_phase<og::EpiBranch<0, 1024>, og::SchedMN, true, 0>(ring, gya, og::SchedMN{64, 4, G - nS, bx - nS}, og::EpiBranch<0, 1024>{&P}, wave);
            } else {
                for (int it = bx; it < nS; it += G) s5::s5_item(P, ring, it, wave);
                pg8::gemm_phase<og::EpiBranch<0, 1024>, og::SchedMN, true, 0>(ring, gya, og::SchedMN{64, 4, G, bx}, og::EpiBranch<0, 1024>{&P}, wave);
            }
        }
#else
        xcd_barrier(bar, wave);
        for (int it = 8 * bx + wave; it < NB * NGRP * 2; it += 8 * G) nb_s5(P, it, lane);
        xcd_barrier(bar, wave);
        VB2(MR * S5W / 256) nb_s5fin(P, v_, vt);
#endif
    }
    SEAM(3);
    if (IN(4)) {
#if OPT_GEMM && OPT_P3
        { const pg8::Gemm g{(const bf16_t*)(P.ws + WS_HS), (const bf16_t*)(P.ws + WS_WGLU), S5W, S5W, S5W};
          for (int rep_ = 0; rep_ < 1 + REP_P3; ++rep_) pg8::gemm_phase<og::EpiGlu, og::SchedMN, true, 0>(ring, g, og::SchedMN{64, 2, G, bx}, og::EpiGlu{&P}, wave); }
#else
        VB2((S5W / 64) * (MR / 64)) nb_glu(P, v_ % (S5W / 64), v_ / (S5W / 64), vt, lh);
#endif
    }
    SEAM(4);
    if (IN(5)) {
#if OPT_GEMM && OPT_P3
        { const pg8::Gemm g{(const bf16_t*)(P.ws + WS_HS2), (const bf16_t*)(P.ws + WS_WBS), S5W, S5W, S5W};
          pg8::gemm_phase<og::EpiBranch<1, 0>, og::SchedMN, true, 0>(ring, g, og::SchedMN{64, 4, G, bx}, og::EpiBranch<1, 0>{&P}, wave); }
#else
        VB2((DM / 64) * (MR / 64)) nb_ys(P, v_ % (DM / 64), v_ / (DM / 64), vt, lh);
        xcd_barrier(bar, wave);
        VB2((DM / 64) * (MR / 64)) nb_ya(P, v_ % (DM / 64), v_ / (DM / 64), vt, lh);
#endif
    }
    SEAM(5);
    if (IN(6)) {
#if OPT_GEMM && OPT_P3
        { const pg8::Gemm g{(const bf16_t*)(P.ws + WS_MB), (const bf16_t*)(P.ws + WS_WOUT), DM, DM, DM};
          pg8::gemm_phase<og::EpiOut, og::SchedMN, true, 0>(ring, g, og::SchedMN{64, 4, G, bx}, og::EpiOut{&P}, wave); }
#else
        VB2((DM / 64) * (MR / 64)) nb_out(P, v_ % (DM / 64), v_ / (DM / 64), vt, lh);
#endif
    }
    SEAM(6);
    if (IN(7)) {
#if OPT_GEMM && OPT_P4
        { const pg8::Gemm g{(const bf16_t*)(P.ws + WS_X1B), (const bf16_t*)(P.ws + WS_WUP), DM, DM, DM};
          for (int rep_ = 0; rep_ < 1 + REP_P4; ++rep_) pg8::gemm_phase<og::EpiUp, og::SchedUp, true, 2>(ring, g, og::SchedUp{G, bx}, og::EpiUp{&P}, wave); }
#else
        VB2((DFF / 64) * (NB * 67)) nb_up(P, v_ % (DFF / 64), v_ / (DFF / 64), vt, lh);
#endif
    }
    SEAM(7);
    if (IN(8)) {
#if OPT_GEMM && OPT_P5
        { const pg8::Gemm g{(const bf16_t*)(P.ws + WS_ACT), (const bf16_t*)(P.ws + WS_WDOWN), DFF, DFF, DFF};
          pg8::gemm_phase<og::EpiDown, og::SchedMN, true, 0>(ring, g, og::SchedMN{64, 4, G, bx}, og::EpiDown{&P}, wave); }
#else
        VB2((DM / 64) * (MR / 64)) nb_down(P, v_ % (DM / 64), v_ / (DM / 64), vt, lh);
#endif
    }
#undef IN
#undef SEAM
#undef VB2
}

extern "C" void kernel_launch(void* const* d_in, const int* in_sizes, int n_in, void* d_out, int out_size, void* d_ws, size_t ws_size, hipStream_t stream) {
    static int grid = 0;
    if (grid == 0) {
        if (n_in != 34 || ws_size < WS_END) { fprintf(stderr, "kernel_launch: unexpected inputs (n_in %d, ws %zu)\n", n_in, ws_size); grid = -1; return; }
        int dev = 0, cus = 0, per_cu = 0;
        if (hipGetDevice(&dev) != hipSuccess || hipDeviceGetAttribute(&cus, hipDeviceAttributeMultiprocessorCount, dev) != hipSuccess) { grid = -1; return; }
        if (hipFuncSetAttribute((const void*)mega, hipFuncAttributeMaxDynamicSharedMemorySize, LDS_BYTES) != hipSuccess) { fprintf(stderr, "kernel_launch: hipFuncSetAttribute failed\n"); grid = -1; return; }
        if (hipOccupancyMaxActiveBlocksPerMultiprocessor(&per_cu, (const void*)mega, 512, LDS_BYTES) != hipSuccess || per_cu < 1) { fprintf(stderr, "kernel_launch: occupancy query says %d\n", per_cu); (void)hipGetLastError(); per_cu = 1; }
        grid = cus;
    }
    if (grid < 0) return;
    (void)hipMemsetAsync((char*)d_ws + WS_CTL, 0, 1 * MiB, stream);
    Args a{};
    for (int i = 0; i < 34; ++i) a.P.in[i] = (const float*)d_in[i];
    a.P.out = (float*)d_out; a.P.ws = (unsigned char*)d_ws;
    a.ph_lo = 0; a.ph_hi = 9;
#if USE_COOP_LAUNCH
    void* args[] = {&a};
    hipError_t e = hipLaunchCooperativeKernel((const void*)mega, dim3(grid), dim3(512), args, LDS_BYTES, stream);
    if (e != hipSuccess) fprintf(stderr, "kernel_launch: cooperative launch failed: %s (grid %d)\n", hipGetErrorString(e), grid);
#else
    hipLaunchKernelGGL(mega, dim3(grid), dim3(512), LDS_BYTES, stream, a);
    const hipError_t e = hipPeekAtLastError();
    if (e != hipSuccess) fprintf(stderr, "kernel_launch: launch failed: %s (grid %d)\n", hipGetErrorString(e), grid);
#endif
}
```

```cpp
#include <hip/hip_runtime.h>
#include <cstdint>
#include <cstdio>

constexpr int NB = 4, SEQL = 4096, NCTX = 256, DM = 1024, MR = NB * SEQL, MCX = NB * NCTX, MT = MR + MCX;
constexpr int NHEAD = 8, HDIM = 64, VDIM = 128, S5W = 512, NGRP = 32, NST = 64, DFF = 2816, NIN = 5632;
constexpr int KOFF = 1024, VOFF = 2048, UOFF = 3072, GOFF = 3584;
constexpr int NKEY = NCTX + SEQL, NKT = NKEY / 64, NCH = SEQL / 16 + NCTX / 16;
constexpr float EPSN = 1e-6f, LAM_INIT = 0.2f;
constexpr float C2 = 0.125f * 1.4426950408889634f;

typedef unsigned short bf16_t;
__host__ __device__ __forceinline__ float bf2f(bf16_t v) { union { unsigned u; float f; } x; x.u = ((unsigned)v) << 16; return x.f; }
__host__ __device__ __forceinline__ bf16_t f2bf(float f) { union { unsigned u; float f; } x; x.f = f; return (bf16_t)((x.u + 0x7fffu + ((x.u >> 16) & 1u)) >> 16); }

constexpr size_t MiB = 1u << 20;
#define PAD_ENTRY 8
#define PAD_ATT 1
#define PAD_WIN 11
#define PAD_YA 12
#define PAD_P3A 7
#define PAD_P3B 0
#define PAD_P3C 2
#define PAD_P4 12
#define PAD_P5 4
constexpr size_t WS_CTL = 0;
constexpr size_t WS_MODPART = 1 * MiB;
constexpr size_t WS_MODFIN = 512 * 1024;
constexpr size_t WS_BIASUP = 512 * 1024 + 128 * 1024;
constexpr size_t WS_ROPE = 2 * MiB + 256 * 1024;
constexpr size_t WS_A16 = WS_ROPE + 16384;
constexpr size_t WS_ROWSQ0 = 2 * MiB + 512 * 1024;
constexpr size_t WS_ROWSQ = WS_ROWSQ0 + 256;
constexpr size_t WS_CONVTAB = 4 * MiB;
constexpr size_t WS_BIASPART = 4 * MiB;
constexpr size_t WS_WIN = 6 * MiB;
constexpr size_t WS_WUP = 17 * MiB;
constexpr size_t WS_WDOWN = 28 * MiB;
constexpr size_t WS_WOUT = 34 * MiB;
constexpr size_t WS_WBA = 36 * MiB;
constexpr size_t WS_WBS = 38 * MiB;
constexpr size_t WS_WGLU = 39 * MiB;
constexpr size_t WS_TQ = 40 * MiB;
constexpr size_t WS_PST = 48 * MiB;
constexpr size_t WS_RH = 52 * MiB;
constexpr size_t WS_RQ = 86 * MiB;
constexpr size_t WS_RK = 118 * MiB;
constexpr size_t WS_RV = 152 * MiB;
constexpr size_t WS_RU = 186 * MiB;
constexpr size_t WS_HS = 221 * MiB;
constexpr size_t WS_END = 237 * MiB;
constexpr size_t WS_T = WS_RK;
constexpr size_t WS_MB = WS_RU;
constexpr size_t WS_X1R = WS_RQ;
constexpr size_t WS_X1B = WS_RH + 8192;
constexpr size_t WS_HS2 = WS_RH;
constexpr size_t WS_ACT = WS_RK;
constexpr size_t WS_YTF = WS_RH;
constexpr size_t WS_YTB = WS_RK;

__host__ __device__ __forceinline__ unsigned q_idx(int b, int t, int h, int m, int d) { return (unsigned)((b * SEQL + t) * 1024 + h * 128 + m * 64 + d); }
__host__ __device__ __forceinline__ unsigned k_idx(int b, int h, int m, int key, int d) {
    return (unsigned)((((((b * NHEAD + h) * 2 + m) * NKT + (key >> 6)) * 8 + (d >> 3)) * 64 + (key & 63)) * 8 + (d & 7));
}
__host__ __device__ __forceinline__ unsigned v_idx(int b, int h, int key, int d) {
    const int row = key & 63;
    return (unsigned)(((((b * NHEAD + h) * NKT + (key >> 6)) * 16 + (d >> 5) * 4 + (row >> 4)) * 16 + (row & 15)) * 32 + (d & 31));
}
__host__ __device__ __forceinline__ unsigned u_idx(int b, int g, int chunk, int sig, int c) { return (unsigned)((((b * NGRP + g) * NCH + chunk) * 512) + sig * 16 + c); }

struct Ptrs {
    const float* in[34];
    float* out;
    unsigned char* ws;
};
#define IN_X 0
#define IN_C 1
#define IN_CTX 2
#define IN_CCTX 3
#define IN_ADAW 4
#define IN_ADAB 5
#define IN_N1W 6
#define IN_WIN 7
#define IN_BGATE 8
#define IN_QNW 9
#define IN_KNW 10
#define IN_LQ1 11
#define IN_LK1 12
#define IN_LQ2 13
#define IN_LK2 14
#define IN_SUBLN 15
#define IN_ARE 16
#define IN_AIM 17
#define IN_LOGDT 18
#define IN_BRE 19
#define IN_BIM 20
#define IN_CRE 21
#define IN_CIM 22
#define IN_S5D 23
#define IN_GLUW 24
#define IN_GLUB 25
#define IN_WBS 26
#define IN_WBA 27
#define IN_WOUT 28
#define IN_N2W 29
#define IN_WUP 30
#define IN_CONVW 31
#define IN_CONVB 32
#define IN_WDOWN 33

template <int CTRL> __device__ __forceinline__ float dppmov(float x) { return __builtin_bit_cast(float, __builtin_amdgcn_mov_dpp(__builtin_bit_cast(int, x), CTRL, 0xf, 0xf, true)); }
__device__ __forceinline__ float row16_sum(float v) {
    v += dppmov<0xB1>(v); v += dppmov<0x4E>(v); v += dppmov<0x141>(v); v += dppmov<0x140>(v); return v; }
__device__ __forceinline__ float row16_max(float v) {
    v = fmaxf(v, dppmov<0xB1>(v)); v = fmaxf(v, dppmov<0x4E>(v)); v = fmaxf(v, dppmov<0x141>(v)); v = fmaxf(v, dppmov<0x140>(v)); return v; }
__device__ __forceinline__ float xor16_sum(float x) {
    const auto s = __builtin_amdgcn_permlane16_swap(__float_as_uint(x), __float_as_uint(x), false, false); return __uint_as_float(s[0]) + __uint_as_float(s[1]); }
__device__ __forceinline__ float xor32_sum(float x) {
    const auto s = __builtin_amdgcn_permlane32_swap(__float_as_uint(x), __float_as_uint(x), false, false); return __uint_as_float(s[0]) + __uint_as_float(s[1]); }
__device__ __forceinline__ float xor16_max(float x) { const auto s = __builtin_amdgcn_permlane16_swap(__float_as_uint(x), __float_as_uint(x), false, false); return fmaxf(__uint_as_float(s[0]), __uint_as_float(s[1])); }
__device__ __forceinline__ float xor32_max(float x) { const auto s = __builtin_amdgcn_permlane32_swap(__float_as_uint(x), __float_as_uint(x), false, false); return fmaxf(__uint_as_float(s[0]), __uint_as_float(s[1])); }
__device__ __forceinline__ float wave_sum(float v) { return xor32_sum(xor16_sum(row16_sum(v))); }
__device__ __forceinline__ float wave_max(float v) { return xor32_max(xor16_max(row16_max(v))); }
__device__ __forceinline__ float sigmoidf_(float x) { return 1.f / (1.f + __expf(-x)); }
__device__ __forceinline__ float siluf_(float x) { return x / (1.f + __expf(-x)); }
__device__ __forceinline__ float gelu_tanh(float x) { const float u = 0.7978845608028654f * (x + 0.044715f * x * x * x); return 0.5f * x * (1.f + tanhf(u)); }

#define LAS __attribute__((address_space(3)))
__device__ __forceinline__ int lane_id() { return (int)__builtin_amdgcn_mbcnt_hi(~0u, __builtin_amdgcn_mbcnt_lo(~0u, 0u)); }
constexpr int NB_AS = 0, NB_WS = 4160, NB_Z = 8256, NB_Z2 = 24896, NB_LDS = 41536;

__device__ void nb_mod(const Ptrs& P, int vbx, int vby, int vt) {
    const int col = vbx * 256 + vt, row = vby;
    const float* cv = row < 4 ? P.in[IN_C] + row * DM : P.in[IN_CCTX];
    const float* W = P.in[IN_ADAW];
    float acc = 0.f;
    for (int k = 0; k < DM; ++k) acc += siluf_(cv[k]) * W[(size_t)k * 6144 + col];
    ((float*)(P.ws + WS_MODFIN))[row * 6144 + col] = acc + P.in[IN_ADAB][col];
}
__device__ void nb_biasup(const Ptrs& P, int vbx, int vby, int vt) {
    const int n = vbx * 256 + vt, b = vby;
    const float* sh2 = (const float*)(P.ws + WS_MODFIN) + b * 6144 + 3072;
    const float* W = P.in[IN_WUP];
    float acc = 0.f;
    for (int k = 0; k < DM; ++k) acc += sh2[k] * W[(size_t)k * NIN + n];
    ((float*)(P.ws + WS_BIASUP))[b * NIN + n] = acc;
}
__device__ void nb_rope(const Ptrs& P, int vbx, int vt) {
    const int i = vbx * 256 + vt;
    const int pos = i >> 4, f = i & 15;
    const float inv = powf(10000.f, -(float)(2 * f) / 32.f);
    const float ang = (float)pos * inv;
    float* tab = (float*)(P.ws + WS_ROPE);
    tab[2 * i] = cosf(ang); tab[2 * i + 1] = sinf(ang);
}
__device__ void nb_modulate(const Ptrs& P, int vbx, int vt) {
    const int r = vbx * 4 + (vt >> 6), lane = vt & 63;
    const float* xr = r < MR ? P.in[IN_X] + (size_t)r * DM : P.in[IN_CTX] + (size_t)(r - MR) * DM;
    const float* mod = (const float*)(P.ws + WS_MODFIN) + (r < MR ? r / SEQL : 4) * 6144;
    const float* w = P.in[IN_N1W];
    float v[16]; float ss = 0.f;
#pragma unroll
    for (int j = 0; j < 16; ++j) { v[j] = xr[lane + 64 * j]; ss += v[j] * v[j]; }
    const float rstd = rsqrtf(wave_sum(ss) * (1.f / DM) + EPSN);
    bf16_t* H = (bf16_t*)(P.ws + WS_RH) + (size_t)r * DM;
#pragma unroll
    for (int j = 0; j < 16; ++j) { const int k = lane + 64 * j; H[k] = f2bf(v[j] * rstd * w[k] * (1.f + mod[1024 + k]) + mod[k]); }
}
__device__ void ntile(const bf16_t* A, int lda, long row0, long rowmax, const float* W, int ldw, int col0, int K, char* lh, int zoff, int tid) {
    float (*As)[65] = (float (*)[65])(lh + NB_AS);
    float (*Ws)[64] = (float (*)[64])(lh + NB_WS);
    float (*Z)[65] = (float (*)[65])(lh + zoff);
    const int tx = tid & 15, ty = tid >> 4;
    float acc[4][4];
#pragma unroll
    for (int i = 0; i < 4; ++i)
#pragma unroll
        for (int j = 0; j < 4; ++j) acc[i][j] = 0.f;
    for (int k0 = 0; k0 < K; k0 += 16) {
        {
            const int ar = tid >> 2, ak = (tid & 3) * 4;
            long gr = row0 + ar; gr = gr < 0 ? 0 : (gr > rowmax ? rowmax : gr);
            const bf16_t* ap = A + (size_t)gr * lda + k0 + ak;
#pragma unroll
            for (int q = 0; q < 4; ++q) As[ak + q][ar] = bf2f(ap[q]);
            const int wk = tid >> 4, wc = (tid & 15) * 4;
            const float4 wv = *(const float4*)(W + (size_t)(k0 + wk) * ldw + col0 + wc);
            Ws[wk][wc] = wv.x; Ws[wk][wc + 1] = wv.y; Ws[wk][wc + 2] = wv.z; Ws[wk][wc + 3] = wv.w;
        }
        __syncthreads();
#pragma unroll
        for (int kk = 0; kk < 16; ++kk) {
            float a[4], w[4];
#pragma unroll
            for (int i = 0; i < 4; ++i) a[i] = As[kk][ty * 4 + i];
#pragma unroll
            for (int j = 0; j < 4; ++j) w[j] = Ws[kk][tx * 4 + j];
#pragma unroll
            for (int i = 0; i < 4; ++i)
#pragma unroll
                for (int j = 0; j < 4; ++j) acc[i][j] += a[i] * w[j];
        }
        __syncthreads();
    }
#pragma unroll
    for (int i = 0; i < 4; ++i)
#pragma unroll
        for (int j = 0; j < 4; ++j) Z[ty * 4 + i][tx * 4 + j] = acc[i][j];
    __syncthreads();
}
__device__ void nb_inproj(const Ptrs& P, int vbx, int vby, int tid, char* lh) {
    float (*Z)[65] = (float (*)[65])(lh + NB_Z);
    const int c0 = vbx * 64; const long r0 = (long)vby * 64;
    ntile((const bf16_t*)(P.ws + WS_RH), DM, r0, MT - 1, P.in[IN_WIN], NIN, c0, DM, lh, NB_Z, tid);
    const int lr = tid >> 2, j0 = (tid & 3) * 16;
    const int r = (int)r0 + lr;
    const bool isctx = r >= MR;
    const int b = isctx ? (r - MR) / NCTX : r / SEQL, t = isctx ? (r - MR) % NCTX : r % SEQL;
    const int key = isctx ? t : NCTX + t, chunk = isctx ? 256 + (t >> 4) : (t >> 4), sig = t & 15;
    const float* zr = Z[lr];
    if (c0 < VOFF) {
        const bool isq = c0 < KOFF;
        if (!(isq && isctx)) {
            const float* w = isq ? P.in[IN_QNW] : P.in[IN_KNW];
            float ss = 0.f;
            for (int j = 0; j < 64; ++j) ss += zr[j] * zr[j];
            const float rs = rsqrtf(ss * (1.f / 64.f) + EPSN);
            const int cc = isq ? c0 : c0 - KOFF, h = cc / 128, m = (cc / 64) & 1;
            const float* tab = (const float*)(P.ws + WS_ROPE);
            for (int d = j0; d < j0 + 16; ++d) {
                float val = zr[d] * rs * w[d];
                if (!isctx) {
                    const int half = d >> 5, dd = d & 31, i = dd & 15, second = dd >> 4;
                    const int pd = second ? d - 16 : d + 16;
                    const float pv = zr[pd] * rs * w[pd];
                    const int pos = half == 0 ? (t >> 6) : (t & 63);
                    const float cs = tab[(pos * 16 + i) * 2], sn = tab[(pos * 16 + i) * 2 + 1];
                    val = second ? (val * cs + pv * sn) : (val * cs - pv * sn);
                }
                if (isq) ((bf16_t*)(P.ws + WS_RQ))[q_idx(b, t, h, m, d)] = f2bf(val * C2);
                else ((bf16_t*)(P.ws + WS_RK))[k_idx(b, h, m, key, d)] = f2bf(val);
            }
        }
    } else if (c0 < UOFF) {
        const int cc = c0 - VOFF, h = cc / 128, dbase = cc % 128;
        for (int j = j0; j < j0 + 16; ++j) ((bf16_t*)(P.ws + WS_RV))[v_idx(b, h, key, dbase + j)] = f2bf(zr[j]);
    } else if (c0 < GOFF) {
        for (int j = j0; j < j0 + 16; ++j) { const int cc = c0 - UOFF + j; ((bf16_t*)(P.ws + WS_RU))[u_idx(b, cc >> 4, chunk, sig, cc & 15)] = f2bf(zr[j]); }
    } else if (!isctx) {
        bf16_t* G = (bf16_t*)P.out;
        for (int j = j0; j < j0 + 16; ++j) { const int cc = c0 - GOFF + j; G[(size_t)r * 2048 + cc] = f2bf(sigmoidf_(zr[j] + P.in[IN_BGATE][cc])); }
    }
    __syncthreads();
}
__device__ void nb_attn(const Ptrs& P, int item, int lane, char* lw) {
    float* p0 = (float*)lw; float* p1 = p0 + NKEY; float* qs = p1 + NKEY;
    const int b = item / (NHEAD * SEQL), h = (item / SEQL) % NHEAD, t = item % SEQL;
    bf16_t* Q = (bf16_t*)(P.ws + WS_RQ); const bf16_t* K = (const bf16_t*)(P.ws + WS_RK); const bf16_t* V = (const bf16_t*)(P.ws + WS_RV);
    qs[lane] = bf2f(Q[q_idx(b, t, h, 0, lane)]); qs[64 + lane] = bf2f(Q[q_idx(b, t, h, 1, lane)]);
    const float lam = __expf(wave_sum(P.in[IN_LQ1][lane] * P.in[IN_LK1][lane])) - __expf(wave_sum(P.in[IN_LQ2][lane] * P.in[IN_LK2][lane])) + LAM_INIT;
    const float mshift = 8.f * 1.4426950408889634f * wave_max(fabsf(P.in[IN_QNW][lane])) * wave_max(fabsf(P.in[IN_KNW][lane]));
    __builtin_amdgcn_s_waitcnt(0xc07f); __builtin_amdgcn_wave_barrier();
    float l0 = 0.f, l1 = 0.f;
    for (int i = 0; i < NKT; ++i) {
        const int key = i * 64 + lane;
#pragma unroll
        for (int m = 0; m < 2; ++m) {
            float s = 0.f;
#pragma unroll
            for (int ch = 0; ch < 8; ++ch) {
                const uint4 kv = *(const uint4*)(K + k_idx(b, h, m, key, ch * 8));
                const unsigned w[4] = {kv.x, kv.y, kv.z, kv.w};
#pragma unroll
                for (int e = 0; e < 4; ++e) { s += qs[m * 64 + ch * 8 + 2 * e] * bf2f((bf16_t)(w[e] & 0xffff)) + qs[m * 64 + ch * 8 + 2 * e + 1] * bf2f((bf16_t)(w[e] >> 16)); }
            }
            const float p = exp2f(s - mshift);
            if (m == 0) { p0[key] = p; l0 += p; } else { p1[key] = p; l1 += p; }
        }
    }
    l0 = wave_sum(l0); l1 = wave_sum(l1);
    __builtin_amdgcn_s_waitcnt(0xc07f); __builtin_amdgcn_wave_barrier();
    const float i0 = 1.f / l0, i1 = lam / l1;
    float o0 = 0.f, o1 = 0.f;
    for (int key = 0; key < NKEY; ++key) {
        const float a = p0[key] * i0 - p1[key] * i1;
        o0 += a * bf2f(V[v_idx(b, h, key, lane)]); o1 += a * bf2f(V[v_idx(b, h, key, lane + 64)]);
    }
    const float rs = rsqrtf(wave_sum(o0 * o0 + o1 * o1) * (1.f / 128.f) + EPSN) * (1.f - LAM_INIT);
    bf16_t* On = Q;
    const size_t ob = ((size_t)(b * SEQL + t)) * 1024 + h * 128;
    On[ob + lane] = f2bf(o0 * rs * P.in[IN_SUBLN][lane]); On[ob + 64 + lane] = f2bf(o1 * rs * P.in[IN_SUBLN][64 + lane]);
    __builtin_amdgcn_s_waitcnt(0xc07f); __builtin_amdgcn_wave_barrier();
}
__device__ void nb_s5(const Ptrs& P, int item, int p) {
    const int d = item & 1, bg = item >> 1, b = bg / NGRP, g = bg % NGRP;
    const int gi = (d * NGRP + g) * NST + p;
    const float lre = fminf(P.in[IN_ARE][gi], -1e-4f), lim = P.in[IN_AIM][gi], dt = __expf(P.in[IN_LOGDT][d * NGRP + g]);
    const float mag = __expf(lre * dt); float sn, cs; sincosf(lim * dt, &sn, &cs);
    const float ar = mag * cs, ai = mag * sn;
    const float nr = ar - 1.f, ni = ai, den = lre * lre + lim * lim;
    const float fr = (nr * lre + ni * lim) / den, fi = (ni * lre - nr * lim) / den;
    float bre[16], bim[16], cre[16], cim[16];
#pragma unroll
    for (int c = 0; c < 16; ++c) {
        const float br = P.in[IN_BRE][(size_t)gi * 16 + c], bi = P.in[IN_BIM][(size_t)gi * 16 + c];
        bre[c] = fr * br - fi * bi; bim[c] = fr * bi + fi * br;
        cre[c] = P.in[IN_CRE][((size_t)(d * NGRP + g) * 16 + c) * NST + p]; cim[c] = P.in[IN_CIM][((size_t)(d * NGRP + g) * 16 + c) * NST + p];
    }
    const bf16_t* U = (const bf16_t*)(P.ws + WS_RU);
    float* yt = (float*)(P.ws + (d == 0 ? WS_YTF : WS_YTB)) + (size_t)(b * NGRP + g) * SEQL * 16;
    float sr = 0.f, si = 0.f;
    for (int step = 0; step < NKEY; ++step) {
        const bool isctx = step < NCTX;
        const int idx = isctx ? step : step - NCTX;
        const int t = d == 0 ? idx : (isctx ? NCTX - 1 - idx : SEQL - 1 - idx);
        const int chunk = isctx ? 256 + (t >> 4) : (t >> 4);
        const bf16_t* up = U + u_idx(b, g, chunk, t & 15, 0);
        float bur = 0.f, bui = 0.f;
#pragma unroll
        for (int c = 0; c < 16; ++c) { const float u = bf2f(up[c]); bur += bre[c] * u; bui += bim[c] * u; }
        const float nsr = ar * sr - ai * si + bur, nsi = ar * si + ai * sr + bui;
        sr = nsr; si = nsi;
        if (!isctx) {
            float mine = 0.f;
#pragma unroll
            for (int c = 0; c < 16; ++c) { const float v = wave_sum(cre[c] * sr - cim[c] * si); if (p == c) mine = v; }
            if (p < 16) yt[(size_t)t * 16 + p] = mine;
        }
    }
}
__device__ void nb_s5fin(const Ptrs& P, int vbx, int vt) {
    const size_t i = (size_t)vbx * 256 + vt;
    const int ch = (int)(i % 512); const size_t bt = i / 512; const int b = (int)(bt / SEQL), t = (int)(bt % SEQL), g = ch >> 4, c = ch & 15;
    const float u = bf2f(((const bf16_t*)(P.ws + WS_RU))[u_idx(b, g, t >> 4, t & 15, c)]);
    const size_t yi = ((size_t)(b * NGRP + g) * SEQL + t) * 16 + c;
    const float y = P.in[IN_S5D][ch] * u + ((const float*)(P.ws + WS_YTF))[yi] + ((const float*)(P.ws + WS_YTB))[yi];
    ((bf16_t*)(P.ws + WS_HS))[i] = f2bf(gelu_tanh(y));
}
__device__ void nb_glu(const Ptrs& P, int vbx, int vby, int tid, char* lh) {
    float (*Z)[65] = (float (*)[65])(lh + NB_Z);
    const int c0 = vbx * 64; const long r0 = (long)vby * 64;
    const bf16_t* Hs = (const bf16_t*)(P.ws + WS_HS);
    ntile(Hs, S5W, r0, MR - 1, P.in[IN_GLUW], S5W, c0, S5W, lh, NB_Z, tid);
    const int lr = tid >> 2, j0 = (tid & 3) * 16; const size_t r = r0 + lr;
    for (int j = j0; j < j0 + 16; ++j) { const int c = c0 + j; ((bf16_t*)(P.ws + WS_HS2))[r * S5W + c] = f2bf(bf2f(Hs[r * S5W + c]) * sigmoidf_(Z[lr][j] + P.in[IN_GLUB][c])); }
    __syncthreads();
}
__device__ void nb_ys(const Ptrs& P, int vbx, int vby, int tid, char* lh) {
    float (*Z)[65] = (float (*)[65])(lh + NB_Z);
    const int c0 = vbx * 64; const long r0 = (long)vby * 64;
    ntile((const bf16_t*)(P.ws + WS_HS2), S5W, r0, MR - 1, P.in[IN_WBS], DM, c0, S5W, lh, NB_Z, tid);
    const int lr = tid >> 2, j0 = (tid & 3) * 16; const size_t r = r0 + lr;
    const bf16_t* G = (const bf16_t*)P.out;
    for (int j = j0; j < j0 + 16; ++j) { const int c = c0 + j; ((float*)(P.ws + WS_T))[r * DM + c] = bf2f(G[r * 2048 + c]) * Z[lr][j]; }
    __syncthreads();
}
__device__ void nb_ya(const Ptrs& P, int vbx, int vby, int tid, char* lh) {
    float (*Z)[65] = (float (*)[65])(lh + NB_Z);
    const int c0 = vbx * 64; const long r0 = (long)vby * 64;
    ntile((const bf16_t*)(P.ws + WS_RQ), DM, r0, MR - 1, P.in[IN_WBA], DM, c0, DM, lh, NB_Z, tid);
    const int lr = tid >> 2, j0 = (tid & 3) * 16; const size_t r = r0 + lr;
    const bf16_t* G = (const bf16_t*)P.out;
    for (int j = j0; j < j0 + 16; ++j) { const int c = c0 + j; ((bf16_t*)(P.ws + WS_MB))[r * DM + c] = f2bf(((const float*)(P.ws + WS_T))[r * DM + c] + bf2f(G[r * 2048 + 1024 + c]) * Z[lr][j]); }
    __syncthreads();
}
__device__ void nb_out(const Ptrs& P, int vbx, int vby, int tid, char* lh) {
    float (*Z)[65] = (float (*)[65])(lh + NB_Z);
    const int c0 = vbx * 64; const long r0 = (long)vby * 64;
    ntile((const bf16_t*)(P.ws + WS_MB), DM, r0, MR - 1, P.in[IN_WOUT], DM, c0, DM, lh, NB_Z, tid);
    const int lr = tid >> 2, j0 = (tid & 3) * 16; const size_t r = r0 + lr; const int b = (int)(r / SEQL);
    const float* mod = (const float*)(P.ws + WS_MODFIN) + b * 6144;
    float ss = 0.f;
    for (int j = j0; j < j0 + 16; ++j) {
        const int c = c0 + j;
        const float x1 = P.in[IN_X][r * DM + c] + mod[2048 + c] * Z[lr][j];
        P.out[r * DM + c] = x1;
        ((bf16_t*)(P.ws + WS_X1B))[r * DM + c] = f2bf(x1 * P.in[IN_N2W][c] * (1.f + mod[4096 + c]));
        ss += x1 * x1;
    }
    ss += __shfl_xor(ss, 1); ss += __shfl_xor(ss, 2);
    if ((tid & 3) == 0) atomicAdd((float*)(P.ws + WS_ROWSQ) + r, ss);
    __syncthreads();
}
__device__ void nb_up(const Ptrs& P, int vbx, int vby, int tid, char* lh) {
    float (*Za)[65] = (float (*)[65])(lh + NB_Z);
    float (*Zg)[65] = (float (*)[65])(lh + NB_Z2);
    const int c0 = vbx * 64;
    const int b = vby / 67, ti = vby % 67;
    const long r0 = (long)b * SEQL + 62 * ti - 1;
    const bf16_t* A = (const bf16_t*)(P.ws + WS_X1B);
    ntile(A, DM, r0, MR - 1, P.in[IN_WUP], NIN, c0, DM, lh, NB_Z, tid);
    ntile(A, DM, r0, MR - 1, P.in[IN_WUP], NIN, DFF + c0, DM, lh, NB_Z2, tid);
    const int lr = tid >> 2, j0 = (tid & 3) * 16;
    {
        const int tok = 62 * ti + lr - 1; const bool valid = tok >= 0 && tok < SEQL;
        float rstd = 0.f;
        if (valid) { const size_t r = (size_t)b * SEQL + tok; rstd = rsqrtf(((const float*)(P.ws + WS_ROWSQ))[r] * (1.f / DM) + EPSN); }
        const float* bu = (const float*)(P.ws + WS_BIASUP) + b * NIN;
        for (int j = j0; j < j0 + 16; ++j) { Za[lr][j] = valid ? rstd * Za[lr][j] + bu[c0 + j] : 0.f; Zg[lr][j] = valid ? rstd * Zg[lr][j] + bu[DFF + c0 + j] : 0.f; }
    }
    __syncthreads();
    const int tok = 62 * ti + lr - 1;
    if (lr >= 1 && lr <= 62 && tok < SEQL) {
        const float* cw = P.in[IN_CONVW]; const float* cb = P.in[IN_CONVB];
        const size_t r = (size_t)b * SEQL + tok;
        for (int j = j0; j < j0 + 16; ++j) {
            const int ca = c0 + j, cg = DFF + c0 + j;
            const float ya = cb[ca] + cw[ca] * Za[lr - 1][j] + cw[NIN + ca] * Za[lr][j] + cw[2 * NIN + ca] * Za[lr + 1][j];
            const float yg = cb[cg] + cw[cg] * Zg[lr - 1][j] + cw[NIN + cg] * Zg[lr][j] + cw[2 * NIN + cg] * Zg[lr + 1][j];
            ((bf16_t*)(P.ws + WS_ACT))[r * DFF + ca] = f2bf(siluf_(yg) * ya);
        }
    }
    __syncthreads();
}
__device__ void nb_down(const Ptrs& P, int vbx, int vby, int tid, char* lh) {
    float (*Z)[65] = (float (*)[65])(lh + NB_Z);
    const int c0 = vbx * 64; const long r0 = (long)vby * 64;
    ntile((const bf16_t*)(P.ws + WS_ACT), DFF, r0, MR - 1, P.in[IN_WDOWN], DM, c0, DFF, lh, NB_Z, tid);
    const int lr = tid >> 2, j0 = (tid & 3) * 16; const size_t r = r0 + lr; const int b = (int)(r / SEQL);
    const float* mod = (const float*)(P.ws + WS_MODFIN) + b * 6144;
    for (int j = j0; j < j0 + 16; ++j) { const int c = c0 + j; P.out[r * DM + c] = P.out[r * DM + c] + mod[5120 + c] * Z[lr][j]; }
    __syncthreads();
}
namespace pg8 {
typedef short bf16x8 __attribute__((ext_vector_type(8)));
typedef float f32x4 __attribute__((ext_vector_type(4)));
typedef unsigned u32x4 __attribute__((ext_vector_type(4)));
typedef unsigned u32x2 __attribute__((ext_vector_type(2)));
constexpr int BM = 256, BK = 64, HALF = 128, HTB = HALF * BK * 2, STAGE_BYTES = 8 * HTB;
__host__ __device__ __forceinline__ int lds_byte(int r, int c) { const int st = (r >> 4) * 2 + (c >> 5), rr = r & 15, cc = c & 31, ob = rr * 64 + cc * 2; return st * 1024 + (ob ^ (((ob >> 9) & 1) << 5)); }
__host__ __device__ __forceinline__ void stage_rc(int b, int& R, int& C) { const int st = b / 1024, sb = b % 1024, swz = sb ^ (((sb >> 9) & 1) << 5); R = (st >> 1) * 16 + swz / 64; C = (st & 1) * 32 + (swz % 64) / 2; }
__host__ __device__ __forceinline__ int perm32(int rho) { const int n = rho >> 4, i = rho & 15; return 8 * (i >> 2) + 4 * n + (i & 3); }
struct Unit { int arow, brow, pm, pn; };
struct Gemm { const bf16_t* A; const bf16_t* Bt; int K, lda, ldb; };
typedef float f32x2c __attribute__((ext_vector_type(2))); typedef __bf16 bf16x2c __attribute__((ext_vector_type(2)));
__device__ __forceinline__ unsigned cvt_pk_bf16(float lo, float hi) { const f32x2c v = {lo, hi}; const bf16x2c b = __builtin_convertvector(v, bf16x2c); return __builtin_bit_cast(unsigned, b); }

template <class Epi, class Sched, bool ALIGN_EPI, int SHR, int APERM = 0>
__device__ __forceinline__ void gemm_phase(LAS unsigned char* lds, const Gemm g, const Sched& S, const Epi& E, int wave) {
    int tid_ = wave * 64 + lane_id(); asm volatile("" : "+v"(tid_));
    const int tid = tid_, wid = __builtin_amdgcn_readfirstlane(tid >> 6), lane = tid & 63, wr = wid >> 2, wc = wid & 3, fr = lane & 15, fq = lane >> 4;
    int nt_ = g.K / BK; asm volatile("" : "+s"(nt_)); const int nt = nt_;
    unsigned voffA[2], voffB[2];
#pragma unroll
    for (int i = 0; i < 2; ++i) { int R, C; stage_rc(tid * 16 + i * 8192, R, C); const int Rb = Epi::PERM ? ((R & ~31) + perm32(R & 31)) : R;
        const int Ra = APERM ? (R & ~63) + 4 * (R & 15) + ((R >> 4) & 3) : R;
        voffA[i] = (unsigned)((Ra - SHR * (R >> 6)) * g.lda + C) * 2u; voffB[i] = (unsigned)(Rb * g.ldb + C) * 2u; }
    const size_t kstep = (size_t)(BK * 2);
    const size_t hA = (size_t)(HALF - 2 * SHR) * g.lda * 2, hB = (size_t)HALF * g.ldb * 2;
    const unsigned ldsw = (unsigned)wid * 1024u;
    const int aoff = lds_byte(wr * 64 + fr, fq * 8), boff = lds_byte(wc * 32 + fr, fq * 8);
#define PG8_SA(b, h) (((b) * 2 + (h)) * HTB)
#define PG8_SB(b, h) ((4 + (b) * 2 + (h)) * HTB)
#define PG8_STAGE(bufoff, gbase, voff) do { _Pragma("unroll") for (int _i = 0; _i < 2; ++_i) \
        __builtin_amdgcn_global_load_lds((const unsigned*)((const char*)(gbase) + (voff)[_i]), (LAS unsigned*)(lds + (bufoff) + ldsw + _i * 8192), 16, 0, 0); } while (0)
#define PG8_LDA(dst, b, h) do { _Pragma("unroll") for (int m = 0; m < 4; ++m) _Pragma("unroll") for (int k = 0; k < 2; ++k) dst[m][k] = *(const LAS bf16x8*)(lds + PG8_SA(b, h) + aoff + m * 2048 + k * 1024); } while (0)
#define PG8_LDB(dst, b, h) do { _Pragma("unroll") for (int n = 0; n < 2; ++n) _Pragma("unroll") for (int k = 0; k < 2; ++k) dst[n][k] = *(const LAS bf16x8*)(lds + PG8_SB(b, h) + boff + n * 2048 + k * 1024); } while (0)
#define PG8_MMA(ai, bj, At, Bt) do { __builtin_amdgcn_s_setprio(1); _Pragma("unroll") for (int m = 0; m < 4; ++m) _Pragma("unroll") for (int n = 0; n < 2; ++n) _Pragma("unroll") for (int k = 0; k < 2; ++k) \
        acc[ai][bj][m][n] = __builtin_amdgcn_mfma_f32_16x16x32_bf16(Bt[n][k], At[m][k], acc[ai][bj][m][n], 0, 0, 0); __builtin_amdgcn_s_setprio(0); } while (0)
#define PG8_WAIT_V(n) asm volatile("s_waitcnt vmcnt(" #n ")" ::: "memory")
#define PG8_WAIT_L(n) asm volatile("s_waitcnt lgkmcnt(" #n ")" ::: "memory")
#define PG8_BAR __builtin_amdgcn_s_barrier()
#define PG8_SCHED __builtin_amdgcn_sched_barrier(0)
    Unit cur, nxt; int ui = 0;
    if (!S.next(0, cur)) return;
    f32x4 acc[2][2][4][2];
#pragma unroll
    for (int a = 0; a < 2; ++a)
#pragma unroll
        for (int b = 0; b < 2; ++b)
#pragma unroll
            for (int m = 0; m < 4; ++m)
#pragma unroll
                for (int n = 0; n < 2; ++n) acc[a][b][m][n] = (f32x4){0.f, 0.f, 0.f, 0.f};
    bf16x8 At[4][2], B0[2][2], B1[2][2];
    const char* cA = (const char*)g.A + (long)cur.arow * g.lda * 2; const char* cB = (const char*)g.Bt + (long)cur.brow * g.ldb * 2;
    PG8_STAGE(PG8_SB(0, 0), cB, voffB); PG8_STAGE(PG8_SB(0, 1), cB + hB, voffB); PG8_STAGE(PG8_SA(0, 0), cA, voffA); PG8_STAGE(PG8_SA(0, 1), cA + hA, voffA);
    if (wr == 1) PG8_BAR;
    PG8_WAIT_V(2); PG8_BAR;
    PG8_STAGE(PG8_SB(1, 0), cB + kstep, voffB); PG8_STAGE(PG8_SA(1, 0), cA + kstep, voffA); PG8_STAGE(PG8_SB(1, 1), cB + hB + kstep, voffB);
    PG8_WAIT_V(6); PG8_BAR;
    for (;;) {
        const bool has_next = S.next(ui + 1, nxt);
        const char* nA = has_next ? (const char*)g.A + (long)nxt.arow * g.lda * 2 : cA; const char* nB = has_next ? (const char*)g.Bt + (long)nxt.brow * g.ldb * 2 : cB;
#pragma unroll 1
        for (int t = 0; t < nt; t += 2) {
            asm volatile("" : "+v"(voffA[0]), "+v"(voffA[1]), "+v"(voffB[0]), "+v"(voffB[1]));
            const bool last = (t == nt - 2);
            const char* a1 = cA + (size_t)(t + 1) * kstep;
            const char* a2 = last ? nA : cA + (size_t)(t + 2) * kstep; const char* b2 = last ? nB : cB + (size_t)(t + 2) * kstep;
            const char* a3 = a2 + kstep; const char* b3 = b2 + kstep;
            asm volatile("" : "+s"(a3), "+s"(b3));
            PG8_LDB(B0, 0, 0); PG8_LDB(B1, 0, 1); PG8_SCHED; PG8_LDA(At, 0, 0); PG8_STAGE(PG8_SA(1, 1), a1 + hA, voffA);
            PG8_WAIT_V(8); PG8_WAIT_L(0); PG8_BAR; PG8_MMA(0, 0, At, B0); PG8_MMA(0, 1, At, B1); PG8_BAR; PG8_SCHED;
            PG8_LDA(At, 0, 1); PG8_STAGE(PG8_SB(0, 0), b2, voffB); PG8_STAGE(PG8_SB(0, 1), b2 + hB, voffB); PG8_STAGE(PG8_SA(0, 0), a2, voffA);
            PG8_WAIT_V(8); PG8_WAIT_L(0); PG8_BAR; PG8_MMA(1, 0, At, B0); PG8_MMA(1, 1, At, B1); PG8_BAR; PG8_SCHED;
            PG8_LDB(B0, 1, 0); PG8_LDB(B1, 1, 1); PG8_SCHED; PG8_LDA(At, 1, 0); PG8_STAGE(PG8_SA(0, 1), a2 + hA, voffA);
            PG8_WAIT_V(8); PG8_WAIT_L(0); PG8_BAR; PG8_MMA(0, 0, At, B0); PG8_MMA(0, 1, At, B1); PG8_BAR; PG8_SCHED;
            PG8_LDA(At, 1, 1); PG8_STAGE(PG8_SB(1, 0), b3, voffB); PG8_STAGE(PG8_SB(1, 1), b3 + hB, voffB); PG8_STAGE(PG8_SA(1, 0), a3, voffA);
            PG8_WAIT_V(8); PG8_WAIT_L(0); PG8_BAR; PG8_MMA(1, 0, At, B0); PG8_MMA(1, 1, At, B1); PG8_BAR; PG8_SCHED;
        }
        if constexpr (ALIGN_EPI) { if (wr == 0) PG8_BAR; }
        { int fr_ = fr, fq_ = fq, wr_ = wr, wc_ = wc; asm volatile("" : "+v"(fr_), "+v"(fq_), "+s"(wr_), "+s"(wc_));
          E(acc, cur, wr_, wc_, fr_, fq_); }
        if (!has_next) break;
#pragma unroll
        for (int a = 0; a < 2; ++a)
#pragma unroll
            for (int b = 0; b < 2; ++b)
#pragma unroll
                for (int m = 0; m < 4; ++m)
#pragma unroll
                    for (int n = 0; n < 2; ++n) acc[a][b][m][n] = (f32x4){0.f, 0.f, 0.f, 0.f};
        cur = nxt; cA = nA; cB = nB; ++ui;
        if constexpr (ALIGN_EPI) { if (wr == 1) PG8_BAR; }
    }
    PG8_WAIT_V(0);
    if constexpr (!ALIGN_EPI) { if (wr == 0) PG8_BAR; }
    PG8_BAR;
#undef PG8_SA
#undef PG8_SB
#undef PG8_STAGE
#undef PG8_LDA
#undef PG8_LDB
#undef PG8_MMA
#undef PG8_WAIT_V
#undef PG8_WAIT_L
#undef PG8_BAR
#undef PG8_SCHED
}
}
namespace og {
using pg8::Unit; using pg8::f32x4; using pg8::u32x4; using pg8::u32x2; using pg8::cvt_pk_bf16;
__device__ __forceinline__ void grid2d(int L, int nM, int nN, int& pm, int& pn) {
    const int nwg = nM * nN; int wgid = L;
    { const int q = nwg / 8, r = nwg % 8, xcd = wgid % 8, off = wgid / 8; wgid = (xcd < r ? xcd * (q + 1) : r * (q + 1) + (xcd - r) * q) + off; }
    const int nig = 8 * nN, gid = wgid / nig, fm = gid * 8, gsz = (nM - fm) < 8 ? (nM - fm) : 8;
    pm = fm + ((wgid % nig) % gsz); pn = (wgid % nig) / gsz;
}
struct SchedMN { int nM, nN, G, c;
    __device__ __forceinline__ bool next(int i, Unit& u) const { const int L = i * G + c; if (L >= nM * nN) return false; grid2d(L, nM, nN, u.pm, u.pn); u.arow = 256 * u.pm; u.brow = 256 * u.pn; return true; } };
struct SchedIn { int G, c;
    __device__ __forceinline__ bool next(int i, Unit& u) const { const int L = i * G + c;
        if (L < 1408) { grid2d(L, 64, 22, u.pm, u.pn); } else if (L < 1448) { const int lc = L - 1408; u.pm = 64 + lc / 10; u.pn = 4 + lc % 10; } else return false;
        u.arow = 256 * u.pm; u.brow = 256 * u.pn; return true; } };
struct SchedUp { int G, c;
    __device__ __forceinline__ bool next(int i, Unit& u) const { const int L = i * G + c; if (L >= 68 * 22) return false; grid2d(L, 68, 22, u.pm, u.pn);
        u.arow = (u.pm / 17) * SEQL + 248 * (u.pm % 17) - 1; u.brow = 256 * u.pn; return true; } };
struct SchedOne { Unit v; __device__ __forceinline__ bool next(int i, Unit& u) const { if (i) return false; u = v; return true; } };

__device__ __forceinline__ u32x4 pack8(const f32x4 a, const f32x4 b) { u32x4 w; w.x = cvt_pk_bf16(a[0], a[1]); w.y = cvt_pk_bf16(a[2], a[3]); w.z = cvt_pk_bf16(b[0], b[1]); w.w = cvt_pk_bf16(b[2], b[3]); return w; }
__device__ __forceinline__ u32x2 pack4(const f32x4 a) { u32x2 w; w.x = cvt_pk_bf16(a[0], a[1]); w.y = cvt_pk_bf16(a[2], a[3]); return w; }
__device__ __forceinline__ u32x4 ld_nt(const u32x4* p) { return __builtin_nontemporal_load(p); }
__device__ __forceinline__ f32x4 ld_nt(const f32x4* p) { return __builtin_nontemporal_load(p); }
__device__ __forceinline__ f32x4 unpk_lo(const u32x4 w) { return (f32x4){__uint_as_float(w.x << 16), __uint_as_float(w.x & 0xffff0000u), __uint_as_float(w.y << 16), __uint_as_float(w.y & 0xffff0000u)}; }
__device__ __forceinline__ f32x4 unpk_hi(const u32x4 w) { return (f32x4){__uint_as_float(w.z << 16), __uint_as_float(w.z & 0xffff0000u), __uint_as_float(w.w << 16), __uint_as_float(w.w & 0xffff0000u)}; }
__device__ __forceinline__ float sigf(float x) { return __builtin_amdgcn_rcpf(1.f + __builtin_amdgcn_exp2f(-1.4426950408889634f * x)); }
__device__ __forceinline__ f32x4 sig4(const f32x4 x) { return (f32x4){sigf(x[0]), sigf(x[1]), sigf(x[2]), sigf(x[3])}; }

struct EpiIn {
    static constexpr bool PERM = true;
    const Ptrs* Pp;
    __device__ __forceinline__ void operator()(const f32x4 (&acc)[2][2][4][2], const Unit& u, int wr, int wc, int fr, int fq) const {
        const Ptrs& P = *Pp;
        const bool isctx = u.pm >= 64; const int pn = u.pn;
        if (pn < 8) {
            const bool isq = pn < 4;
            const float* w = isq ? P.in[IN_QNW] : P.in[IN_KNW];
            f32x4 wv[2][2];
#pragma unroll
            for (int bj = 0; bj < 2; ++bj)
#pragma unroll
                for (int n = 0; n < 2; ++n) wv[bj][n] = *(const f32x4*)(w + 32 * bj + 16 * n + 4 * fq);
            const int h = (pn & 3) * 2 + (wc >> 1), mm = wc & 1;
            const float* tab = (const float*)(P.ws + WS_ROPE);
#pragma unroll
            for (int ai = 0; ai < 2; ++ai)
#pragma unroll
                for (int m = 0; m < 4; ++m) {
                    const int r = 256 * u.pm + 128 * ai + 64 * wr + 16 * m + fr;
                    const int b = isctx ? (r - MR) / NCTX : r / SEQL, t = isctx ? (r - MR) % NCTX : r % SEQL, key = isctx ? t : NCTX + t;
                    float ss = 0.f;
#pragma unroll
                    for (int bj = 0; bj < 2; ++bj)
#pragma unroll
                        for (int n = 0; n < 2; ++n) { const f32x4 x = acc[ai][bj][m][n]; ss += (x[0] * x[0] + x[1] * x[1]) + (x[2] * x[2] + x[3] * x[3]); }
                    ss = xor32_sum(xor16_sum(ss));
                    const float rs = __builtin_amdgcn_rsqf(ss * (1.f / 64.f) + EPSN);
#pragma unroll
                    for (int bj = 0; bj < 2; ++bj) {
                        f32x4 x1 = acc[ai][bj][m][0] * rs * wv[bj][0], x2 = acc[ai][bj][m][1] * rs * wv[bj][1];
                        if (!isctx) {
                            const int pos = bj == 0 ? (t >> 6) : (t & 63);
                            const f32x4 t0 = *(const f32x4*)(tab + (pos * 16 + 4 * fq) * 2), t1 = *(const f32x4*)(tab + (pos * 16 + 4 * fq) * 2 + 4);
                            const f32x4 cs = (f32x4){t0[0], t0[2], t1[0], t1[2]}, sn = (f32x4){t0[1], t0[3], t1[1], t1[3]};
                            const f32x4 o1 = x1 * cs - x2 * sn, o2 = x2 * cs + x1 * sn;
                            x1 = o1; x2 = o2;
                        }
                        if (isq) {
                            bf16_t* q = (bf16_t*)(P.ws + WS_RQ);
                            *(u32x2*)(q + q_idx(b, t, h, mm, 32 * bj + 4 * fq)) = pack4(x1 * C2);
                            *(u32x2*)(q + q_idx(b, t, h, mm, 32 * bj + 16 + 4 * fq)) = pack4(x2 * C2);
                        } else {
                            bf16_t* k = (bf16_t*)(P.ws + WS_RK);
                            *(u32x2*)(k + k_idx(b, h, mm, key, 32 * bj + 4 * fq)) = pack4(x1);
                            *(u32x2*)(k + k_idx(b, h, mm, key, 32 * bj + 16 + 4 * fq)) = pack4(x2);
                        }
                    }
                }
        } else if (pn < 12) {
#pragma unroll
            for (int ai = 0; ai < 2; ++ai)
#pragma unroll
                for (int m = 0; m < 4; ++m) {
                    const int r = 256 * u.pm + 128 * ai + 64 * wr + 16 * m + fr;
                    const int b = isctx ? (r - MR) / NCTX : r / SEQL, t = isctx ? (r - MR) % NCTX : r % SEQL, key = isctx ? t : NCTX + t;
#pragma unroll
                    for (int bj = 0; bj < 2; ++bj)
                        *(u32x4*)((bf16_t*)(P.ws + WS_RV) + v_idx(b, 2 * (pn - 8) + bj, key, 32 * wc + 8 * fq)) = pack8(acc[ai][bj][m][0], acc[ai][bj][m][1]);
                }
        } else if (pn < 14) {
#pragma unroll
            for (int ai = 0; ai < 2; ++ai)
#pragma unroll
                for (int m = 0; m < 4; ++m) {
                    const int r = 256 * u.pm + 128 * ai + 64 * wr + 16 * m + fr;
                    const int b = isctx ? (r - MR) / NCTX : r / SEQL, t = isctx ? (r - MR) % NCTX : r % SEQL;
                    const int chunk = isctx ? 256 + (t >> 4) : (t >> 4), sig = t & 15;
#pragma unroll
                    for (int bj = 0; bj < 2; ++bj) { const int c = 256 * (pn - 12) + 128 * bj + 32 * wc + 8 * fq;
                        *(u32x4*)((bf16_t*)(P.ws + WS_RU) + u_idx(b, c >> 4, chunk, sig, c & 15)) = pack8(acc[ai][bj][m][0], acc[ai][bj][m][1]); }
                }
        } else if (!isctx) {
#pragma unroll
            for (int bj = 0; bj < 2; ++bj) {
                const int c = 256 * (pn - 14) + 128 * bj + 32 * wc + 8 * fq;
                const f32x4 b0 = *(const f32x4*)(P.in[IN_BGATE] + c), b1 = *(const f32x4*)(P.in[IN_BGATE] + c + 4);
#pragma unroll
                for (int ai = 0; ai < 2; ++ai)
#pragma unroll
                    for (int m = 0; m < 4; ++m) {
                        const int r = 256 * u.pm + 128 * ai + 64 * wr + 16 * m + fr;
                        *(u32x4*)((bf16_t*)P.out + (size_t)r * 2048 + c) = pack8(sig4(acc[ai][bj][m][0] + b0), sig4(acc[ai][bj][m][1] + b1));
                    }
            }
        }
    }
};
struct EpiGlu {
    static constexpr bool PERM = true;
    const Ptrs* Pp;
    __device__ __forceinline__ void operator()(const f32x4 (&acc)[2][2][4][2], const Unit& u, int wr, int wc, int fr, int fq) const {
        const Ptrs& P = *Pp;
#pragma unroll
        for (int bj = 0; bj < 2; ++bj) {
            const int c = 256 * u.pn + 128 * bj + 32 * wc + 8 * fq;
            const f32x4 b0 = *(const f32x4*)(P.in[IN_GLUB] + c), b1 = *(const f32x4*)(P.in[IN_GLUB] + c + 4);
#pragma unroll
            for (int ai = 0; ai < 2; ++ai)
#pragma unroll
                for (int m = 0; m < 4; ++m) {
                    const size_t r = 256 * u.pm + 128 * ai + 64 * wr + 16 * m + fr;
                    const u32x4 hs = *(const u32x4*)((const bf16_t*)(P.ws + WS_HS) + r * S5W + c);
                    *(u32x4*)((bf16_t*)(P.ws + WS_HS2) + r * S5W + c) = pack8(unpk_lo(hs) * sig4(acc[ai][bj][m][0] + b0), unpk_hi(hs) * sig4(acc[ai][bj][m][1] + b1));
                }
        }
    }
};
template <int STEP, int GO> struct EpiBranch {
    static constexpr bool PERM = true;
    const Ptrs* Pp;
    __device__ __forceinline__ void operator()(const f32x4 (&acc)[2][2][4][2], const Unit& u, int wr, int wc, int fr, int fq) const {
        const Ptrs& P = *Pp;
#pragma unroll
        for (int ai = 0; ai < 2; ++ai)
#pragma unroll
            for (int m = 0; m < 4; ++m) {
                const size_t r = 256 * u.pm + 128 * ai + 64 * wr + 16 * m + fr;
#pragma unroll
                for (int bj = 0; bj < 2; ++bj) {
                    const int c = 256 * u.pn + 128 * bj + 32 * wc + 8 * fq;
                    const u32x4 gt = *(const u32x4*)((const bf16_t*)P.out + r * 2048 + GO + c);
                    bf16_t* T = (bf16_t*)(P.ws + WS_T) + r * DM + c;
                    if (STEP == 0) { *(u32x4*)T = pack8(unpk_lo(gt) * acc[ai][bj][m][0], unpk_hi(gt) * acc[ai][bj][m][1]); }
                    else { const u32x4 tt = *(const u32x4*)T;
                        *(u32x4*)((bf16_t*)(P.ws + WS_MB) + r * DM + c) = pack8(unpk_lo(tt) + unpk_lo(gt) * acc[ai][bj][m][0], unpk_hi(tt) + unpk_hi(gt) * acc[ai][bj][m][1]); }
                }
            }
    }
};
struct EpiOut {
    static constexpr bool PERM = true;
    const Ptrs* Pp;
    __device__ __forceinline__ void operator()(const f32x4 (&acc)[2][2][4][2], const Unit& u, int wr, int wc, int fr, int fq) const {
        const Ptrs& P = *Pp;
        const int b = u.pm / 16;
        const float* mod = (const float*)(P.ws + WS_MODFIN) + b * 6144;
        f32x4 ga[2][2], sw[2][2];
#pragma unroll
        for (int bj = 0; bj < 2; ++bj)
#pragma unroll
            for (int n = 0; n < 2; ++n) { const int c = 256 * u.pn + 128 * bj + 32 * wc + 8 * fq + 4 * n;
                ga[bj][n] = *(const f32x4*)(mod + 2048 + c); sw[bj][n] = *(const f32x4*)(P.in[IN_N2W] + c) * (*(const f32x4*)(mod + 4096 + c) + 1.f); }
        float ssg[8];
#pragma unroll
        for (int ai = 0; ai < 2; ++ai)
#pragma unroll
            for (int m = 0; m < 4; ++m) {
                const size_t r = 256 * u.pm + 128 * ai + 64 * wr + 16 * m + fr;
                float ss = 0.f;
#pragma unroll
                for (int bj = 0; bj < 2; ++bj) {
                    const int c = 256 * u.pn + 128 * bj + 32 * wc + 8 * fq;
                    const f32x4 x0 = ld_nt((const f32x4*)(P.in[IN_X] + r * DM + c)) + ga[bj][0] * acc[ai][bj][m][0], x1 = ld_nt((const f32x4*)(P.in[IN_X] + r * DM + c + 4)) + ga[bj][1] * acc[ai][bj][m][1];
                    *(u32x4*)((bf16_t*)(P.ws + WS_X1R) + r * DM + c) = pack8(x0, x1);
                    *(u32x4*)((bf16_t*)(P.ws + WS_X1B) + r * DM + c) = pack8(x0 * sw[bj][0], x1 * sw[bj][1]);
                    ss += (x0[0] * x0[0] + x0[1] * x0[1]) + (x0[2] * x0[2] + x0[3] * x0[3]) + (x1[0] * x1[0] + x1[1] * x1[1]) + (x1[2] * x1[2] + x1[3] * x1[3]);
                }
                ssg[ai * 4 + m] = xor32_sum(xor16_sum(ss));
            }
        { const float v0 = fq == 0 ? ssg[0] : fq == 1 ? ssg[1] : fq == 2 ? ssg[2] : ssg[3], v1 = fq == 0 ? ssg[4] : fq == 1 ? ssg[5] : fq == 2 ? ssg[6] : ssg[7];
          float* rq = (float*)(P.ws + WS_ROWSQ) + 256 * u.pm + 64 * wr + 16 * fq + fr;
          atomicAdd(rq, v0); atomicAdd(rq + 128, v1); }
    }
};
struct EpiDown {
    static constexpr bool PERM = true;
    const Ptrs* Pp;
    __device__ __forceinline__ void operator()(const f32x4 (&acc)[2][2][4][2], const Unit& u, int wr, int wc, int fr, int fq) const {
        const Ptrs& P = *Pp;
        const float* mod = (const float*)(P.ws + WS_MODFIN) + (u.pm / 16) * 6144 + 5120;
#pragma unroll
        for (int bj = 0; bj < 2; ++bj) {
            const int c = 256 * u.pn + 128 * bj + 32 * wc + 8 * fq;
            const f32x4 g0 = *(const f32x4*)(mod + c), g1 = *(const f32x4*)(mod + c + 4);
#pragma unroll
            for (int ai = 0; ai < 2; ++ai)
#pragma unroll
                for (int m = 0; m < 4; ++m) {
                    const size_t e = (size_t)(256 * u.pm + 128 * ai + 64 * wr + 16 * m + fr) * DM + c;
                    const u32x4 xr = ld_nt((const u32x4*)((const bf16_t*)(P.ws + WS_X1R) + e));
                    float* o = P.out + e;
                    __builtin_nontemporal_store(unpk_lo(xr) + g0 * acc[ai][bj][m][0], (f32x4*)o); __builtin_nontemporal_store(unpk_hi(xr) + g1 * acc[ai][bj][m][1], (f32x4*)(o + 4));
                }
        }
    }
};
__device__ __forceinline__ float dpp_ror1(float v) { return __int_as_float(__builtin_amdgcn_mov_dpp(__float_as_int(v), 0x121, 0xf, 0xf, true)); }
__device__ __forceinline__ float dpp_rol1(float v) { return __int_as_float(__builtin_amdgcn_mov_dpp(__float_as_int(v), 0x12f, 0xf, 0xf, true)); }
__device__ __forceinline__ float dpp_shr1_zero(float v) { return __int_as_float(__builtin_amdgcn_mov_dpp(__float_as_int(v), 0x111, 0xf, 0xf, true)); }
__device__ __forceinline__ float dpp_shl1_zero(float v) { return __int_as_float(__builtin_amdgcn_mov_dpp(__float_as_int(v), 0x101, 0xf, 0xf, true)); }
__device__ __forceinline__ float dpp_shr1_keep(float old, float v) { return __int_as_float(__builtin_amdgcn_update_dpp(__float_as_int(old), __float_as_int(v), 0x111, 0xf, 0xf, false)); }
__device__ __forceinline__ float dpp_shl1_keep(float old, float v) { return __int_as_float(__builtin_amdgcn_update_dpp(__float_as_int(old), __float_as_int(v), 0x101, 0xf, 0xf, false)); }
struct EpiUp {
    static constexpr bool PERM = true;
    const Ptrs* Pp;
    __device__ __forceinline__ void operator()(const f32x4 (&acc)[2][2][4][2], const Unit& u, int wr_, int wc_, int fr_, int fq_) const {
        const Ptrs& P = *Pp;
        const int wr = wr_, wc = wc_, fr = fr_, fq = fq_;
        const int b = u.pm / 17, ti = u.pm % 17;
        const float* rq = (const float*)(P.ws + WS_ROWSQ) + (size_t)b * SEQL + 248 * ti + 62 * wr + 4 * fr - 1;
        const f32x4* ct = (const f32x4*)(P.ws + WS_CONVTAB) + (size_t)((((b * 22 + u.pn) * 4 + wc) * 4 + fq) * 20);
        const int ca0 = 128 * u.pn + 32 * wc + 8 * fq;
        float rstd[2][4]; bool valid[2][4];
#pragma unroll
        for (int ai = 0; ai < 2; ++ai)
#pragma unroll
            for (int m = 0; m < 4; ++m) {
                const int tok = 248 * ti + 62 * (2 * ai + wr) + 4 * fr + m - 1;
                valid[ai][m] = tok >= 0 && tok < SEQL;
                rstd[ai][m] = __builtin_amdgcn_rsqf(rq[124 * ai + m] * (1.f / DM) + EPSN);
            }
        bf16_t* ACT = (bf16_t*)(P.ws + WS_ACT);
#pragma unroll
        for (int ai = 0; ai < 2; ++ai) {
            float ya[4][2][4];
#pragma unroll
            for (int bj = 0; bj < 2; ++bj)
#pragma unroll
                for (int n = 0; n < 2; ++n) {
                    const f32x4 w0 = ct[(bj * 2 + n) * 5 + 0], w1 = ct[(bj * 2 + n) * 5 + 1], w2 = ct[(bj * 2 + n) * 5 + 2], bb = ct[(bj * 2 + n) * 5 + 3], bv = ct[(bj * 2 + n) * 5 + 4];
#pragma unroll
                    for (int j = 0; j < 4; ++j) {
                        float x[4], up[4], dn[4];
#pragma unroll
                        for (int m = 0; m < 4; ++m) { const float v = acc[ai][bj][m][n][j] * rstd[ai][m] + bv[j]; x[m] = valid[ai][m] ? v : 0.f; }
                        up[0] = dpp_shr1_zero(x[3]);
                        dn[3] = dpp_shl1_zero(x[0]);
#pragma unroll
                        for (int m = 1; m < 4; ++m) up[m] = x[m - 1];
#pragma unroll
                        for (int m = 0; m < 3; ++m) dn[m] = x[m + 1];
#pragma unroll
                        for (int m = 0; m < 4; ++m) {
                            const float y = bb[j] + w0[j] * up[m] + w1[j] * x[m] + w2[j] * dn[m];
                            if (bj == 0) ya[m][n][j] = y; else ya[m][n][j] = y * __builtin_amdgcn_rcpf(1.f + __builtin_amdgcn_exp2f(-1.4426950408889634f * y)) * ya[m][n][j];
                        }
                        asm volatile("" : "+v"(ya[0][n][j]), "+v"(ya[1][n][j]), "+v"(ya[2][n][j]), "+v"(ya[3][n][j]));
                        __builtin_amdgcn_sched_barrier(0);
                    }
                    asm volatile("" ::: "memory");
                }
#pragma unroll
            for (int m = 0; m < 4; ++m) {
                const int w = 4 * fr + m, tok = 248 * ti + 62 * (2 * ai + wr) + w - 1;
                u32x4 o; o.x = cvt_pk_bf16(ya[m][0][0], ya[m][0][1]); o.y = cvt_pk_bf16(ya[m][0][2], ya[m][0][3]); o.z = cvt_pk_bf16(ya[m][1][0], ya[m][1][1]); o.w = cvt_pk_bf16(ya[m][1][2], ya[m][1][3]);
                if (w >= 1 && w <= 62 && tok < SEQL) *(u32x4*)(ACT + ((size_t)b * SEQL + tok) * DFF + ca0) = o;
                __builtin_amdgcn_sched_barrier(0);
            }
        }
    }
};

__device__ __forceinline__ unsigned f2bf_u(float f) { unsigned u = __float_as_uint(f); return (u + 0x7fffu + ((u >> 16) & 1u)) >> 16; }
__device__ __forceinline__ unsigned pk2(float lo, float hi) { return f2bf_u(lo) | (f2bf_u(hi) << 16); }
template <class F>
__device__ __forceinline__ void transpose_item(const float* W, int K, int N, bf16_t* WT, LAS float* scr, int item, int lane, F srccol) {
    const int nblk = N / 32, kb = item / nblk, nb = item % nblk, k0 = 64 * kb, n0 = 32 * nb;
    const int col = srccol(n0 + (lane & 31));
    float v_[32];
#pragma unroll
    for (int i = 0; i < 32; ++i) v_[i] = __builtin_nontemporal_load(W + (size_t)(k0 + 2 * i + (lane >> 5)) * N + col);
#pragma unroll
    for (int i = 0; i < 32; ++i) scr[(2 * i + (lane >> 5)) * 33 + (lane & 31)] = v_[i];
    asm volatile("s_waitcnt lgkmcnt(0)" ::: "memory");
    const int c = lane & 7;
#pragma unroll
    for (int j = 0; j < 4; ++j) { const int n = (lane >> 3) + 8 * j; const LAS float* s = scr + (8 * c) * 33 + n;
        u32x4 o; o.x = cvt_pk_bf16(s[0 * 33], s[1 * 33]); o.y = cvt_pk_bf16(s[2 * 33], s[3 * 33]); o.z = cvt_pk_bf16(s[4 * 33], s[5 * 33]); o.w = cvt_pk_bf16(s[6 * 33], s[7 * 33]);
        *(u32x4*)(WT + (size_t)(n0 + n) * K + k0 + 8 * c) = o; }
    asm volatile("s_waitcnt lgkmcnt(0)" ::: "memory");
}
__device__ __forceinline__ void build_convtab(const Ptrs& P, int gtid) {
    if (gtid >= 1408 * 80) return;
    const int e = gtid % 80, entry = gtid / 80, bj = e / 40, n = (e / 20) & 1, k = (e >> 2) % 5, j = e & 3;
    const int fq = entry & 3, wc = (entry >> 2) & 3, pn = (entry >> 4) % 22, b = entry / 352;
    const int col = bj * DFF + 128 * pn + 32 * wc + 8 * fq + 4 * n + j;
    const float v = k < 3 ? P.in[IN_CONVW][k * NIN + col] : (k == 3 ? P.in[IN_CONVB][col] : ((const float*)(P.ws + WS_BIASUP))[b * NIN + col]);
    ((float*)(P.ws + WS_CONVTAB))[gtid] = v;
}
struct ColId { __device__ __forceinline__ int operator()(int n) const { return n; } };
struct ColIn { __device__ __forceinline__ int operator()(int n) const {
        if (n >= 2048) return n; const int s = n & 255, bj = s >> 7, wc = (s >> 5) & 3, fq = (s >> 3) & 3, nn = (s >> 2) & 1, j = s & 3; return (n & ~255) + 64 * wc + 32 * bj + 16 * nn + 4 * fq + j; } };
struct ColUp { __device__ __forceinline__ int operator()(int n) const { const int pn = n >> 8, s = n & 255; return s < 128 ? 128 * pn + s : DFF + 128 * pn + (s - 128); } };
constexpr int I_IN = 16 * 176, I_UP = 16 * 176, I_DN = 44 * 32, I_OUT = 16 * 32, I_BA = 16 * 32, I_BS = 8 * 32, I_GLU = 8 * 16;
constexpr int NTR_ITEMS = I_IN + I_UP + I_DN + I_OUT + I_BA + I_BS + I_GLU;
__device__ __forceinline__ void transpose_setA(const Ptrs& P, LAS float* scr, int r, int lane) {
    if (r < I_IN) { transpose_item(P.in[IN_WIN], DM, NIN, (bf16_t*)(P.ws + WS_WIN), scr, r, lane, ColIn()); return; } r -= I_IN;
    transpose_item(P.in[IN_GLUW], S5W, S5W, (bf16_t*)(P.ws + WS_WGLU), scr, r, lane, ColId());
}
__device__ __forceinline__ void transpose_setB(const Ptrs& P, LAS float* scr, int r, int lane) {
    if (r < I_OUT) { transpose_item(P.in[IN_WOUT], DM, DM, (bf16_t*)(P.ws + WS_WOUT), scr, r, lane, ColId()); return; } r -= I_OUT;
    if (r < I_BA) { transpose_item(P.in[IN_WBA], DM, DM, (bf16_t*)(P.ws + WS_WBA), scr, r, lane, ColId()); return; } r -= I_BA;
    transpose_item(P.in[IN_WBS], S5W, DM, (bf16_t*)(P.ws + WS_WBS), scr, r, lane, ColId());
}
__device__ __forceinline__ void transpose_setC(const Ptrs& P, LAS float* scr, int r, int lane) {
    if (r < I_UP) { transpose_item(P.in[IN_WUP], DM, NIN, (bf16_t*)(P.ws + WS_WUP), scr, r, lane, ColUp()); return; } r -= I_UP;
    transpose_item(P.in[IN_WDOWN], DFF, DM, (bf16_t*)(P.ws + WS_WDOWN), scr, r, lane, ColId());
}
constexpr int NTR_A = I_IN + I_GLU, NTR_B = I_OUT + I_BA + I_BS, NTR_C = I_UP + I_DN;
__device__ __forceinline__ void tr_in_load(const Ptrs& P, int item, int lane, float (&v_)[32]) {
    const int nblk = NIN / 32, kb = item / nblk, nb = item % nblk, k0 = 64 * kb, n0 = 32 * nb;
    const int col = ColIn()(n0 + (lane & 31));
    const float* W = P.in[IN_WIN];
#pragma unroll
    for (int i = 0; i < 32; ++i) v_[i] = __builtin_nontemporal_load(W + (size_t)(k0 + 2 * i + (lane >> 5)) * NIN + col);
}
__device__ __forceinline__ void tr_in_finish(const Ptrs& P, LAS float* scr, int item, int lane, const float (&v_)[32]) {
    const int nblk = NIN / 32, kb = item / nblk, nb = item % nblk, k0 = 64 * kb, n0 = 32 * nb;
    bf16_t* WT = (bf16_t*)(P.ws + WS_WIN);
#pragma unroll
    for (int i = 0; i < 32; ++i) scr[(2 * i + (lane >> 5)) * 33 + (lane & 31)] = v_[i];
    asm volatile("s_waitcnt lgkmcnt(0)" ::: "memory");
    const int c = lane & 7;
#pragma unroll
    for (int j = 0; j < 4; ++j) { const int n = (lane >> 3) + 8 * j; const LAS float* s = scr + (8 * c) * 33 + n;
        u32x4 o; o.x = cvt_pk_bf16(s[0 * 33], s[1 * 33]); o.y = cvt_pk_bf16(s[2 * 33], s[3 * 33]); o.z = cvt_pk_bf16(s[4 * 33], s[5 * 33]); o.w = cvt_pk_bf16(s[6 * 33], s[7 * 33]);
        *(u32x4*)(WT + (size_t)(n0 + n) * DM + k0 + 8 * c) = o; }
    asm volatile("s_waitcnt lgkmcnt(0)" ::: "memory");
}
__device__ __forceinline__ void transposes_A(const Ptrs& P, LAS unsigned char* lds, int gw, int NGW, int wave, int lane, int first = 0) {
    LAS float* scr = (LAS float*)(lds + wave * 8704);
    for (int it = gw + first * NGW; it < NTR_A; it += NGW) transpose_setA(P, scr, it, lane);
}
__device__ __forceinline__ void transposes_B(const Ptrs& P, LAS unsigned char* lds, int gw, int NGW, int wave, int lane) {
    LAS float* scr = (LAS float*)(lds + wave * 8704);
    for (int it = gw; it < NTR_B; it += NGW) transpose_setB(P, scr, it, lane);
}
__device__ __forceinline__ void transposes_C(const Ptrs& P, LAS unsigned char* lds, int gw, int NGW, int wave, int lane) {
    LAS float* scr = (LAS float*)(lds + wave * 8704);
    for (int it = gw; it < NTR_C; it += NGW) transpose_setC(P, scr, it, lane);
}
}
#ifndef PROBE_MFMA
#define PROBE_MFMA 0
#endif
#ifndef PROBE_EXP
#define PROBE_EXP 0
#endif
#ifndef PROBE_LDS
#define PROBE_LDS 0
#endif
namespace at {
typedef float f32x16 __attribute__((ext_vector_type(16)));
typedef short bf16x8 __attribute__((ext_vector_type(8)));
typedef short s16x4 __attribute__((ext_vector_type(4)));
typedef unsigned u32x4 __attribute__((ext_vector_type(4)));
typedef float f32x4v __attribute__((ext_vector_type(4)));
constexpr int SLOT = 32768, XOFF = 65536, WSF = 131072;
__device__ __forceinline__ int crow(int r, int hi) { return (r & 3) + 8 * (r >> 2) + 4 * hi; }
typedef float f32x2_t __attribute__((ext_vector_type(2))); typedef __bf16 bf16x2_t __attribute__((ext_vector_type(2)));
__device__ __forceinline__ unsigned cvtpk(float lo, float hi) { f32x2_t v = {lo, hi}; bf16x2_t b = __builtin_convertvector(v, bf16x2_t); return __builtin_bit_cast(unsigned, b); }
__device__ __forceinline__ s16x4 vtr(const LAS unsigned char* p) { return __builtin_bit_cast(s16x4, __builtin_amdgcn_ds_read_tr16_b64_v4i16((LAS s16x4*)p)); }
#define AT_WAITBAR(N) asm volatile("s_waitcnt vmcnt(" #N ") lgkmcnt(0)\n\ts_barrier" ::: "memory")

struct Srcs { const char* k0; const char* k1; const char* v; unsigned lo; };
__device__ __forceinline__ void glds16(const char* sbase, unsigned voff, unsigned lds_dst) { unsigned keep;
    asm volatile("s_mov_b32 %0, m0\n\ts_mov_b32 m0, %3\n\ts_nop 0\n\tglobal_load_lds_dwordx4 %1, %2\n\ts_mov_b32 m0, %0" : "=&s"(keep) : "v"(voff), "s"(sbase), "s"(lds_dst) : "memory"); }
__device__ __forceinline__ void dma_piece(unsigned lds0, const Srcs& s, int t, int slot, int wid, int pc) {
    const unsigned d = (unsigned)__builtin_amdgcn_readfirstlane((int)(lds0 + slot * SLOT + wid * 1024));
    if (pc == 0) glds16(s.k0 + (size_t)t * 8192, s.lo, d);
    else if (pc == 1) glds16(s.k1 + (size_t)t * 8192, s.lo, d + 8192);
    else if (pc == 2) glds16(s.v + (size_t)t * 16384, s.lo, d + 16384 + wid * 1024);
    else glds16(s.v + (size_t)t * 16384 + 1024, s.lo, d + 16384 + wid * 1024 + 1024);
}
__device__ __forceinline__ void dma_tile(unsigned lds0, const Srcs& s, int t, int slot, int wid) {
#pragma unroll
    for (int pc = 0; pc < 4; ++pc) dma_piece(lds0, s, t, slot, wid, pc);
}
__device__ __forceinline__ Srcs unit_srcs(const Ptrs& P, int unit, int wid, int lane) {
    const int b = unit / (NHEAD * 32), h = (unit / 32) % NHEAD;
    Srcs s;
    s.k0 = (const char*)((const bf16_t*)(P.ws + WS_RK) + k_idx(b, h, 0, 0, 0)) + wid * 1024;
    s.k1 = (const char*)((const bf16_t*)(P.ws + WS_RK) + k_idx(b, h, 1, 0, 0)) + wid * 1024;
    s.v = (const char*)((const bf16_t*)(P.ws + WS_RV) + v_idx(b, h, 0, 0)) + wid * 2048;
    s.lo = (unsigned)lane * 16u;
    return s;
}
__device__ __forceinline__ void attn_unit(const Ptrs& P, LAS unsigned char* lds, int unit, int next_unit, bool first, float lam, float mshift, int wid, bf16_t* Obase) {
    int lane_ = lane_id(); asm volatile("" : "+v"(lane_));
    const int lane = lane_, r32 = lane & 31, hi = lane >> 5;
    const int mp = wid >> 2, wq = wid & 3;
    const int b = unit / (NHEAD * 32), h = (unit / 32) % NHEAD, q0 = (unit % 32) * 128;
    const Srcs S = unit_srcs(P, unit, wid, lane);
    const unsigned lds0 = (unsigned)(uintptr_t)lds;
    if (first) { dma_tile(lds0, S, 0, 0, wid); dma_tile(lds0, S, 1, 1, wid); }
    bf16_t* Qg = (bf16_t*)(P.ws + WS_RQ);
    bf16x8 qr[4];
#pragma unroll
    for (int d0 = 0; d0 < 4; ++d0) qr[d0] = *(const bf16x8*)(Qg + q_idx(b, q0 + wq * 32 + r32, h, mp, d0 * 16 + hi * 8));
    const f32x16 zero16 = (f32x16){0.f, 0.f, 0.f, 0.f, 0.f, 0.f, 0.f, 0.f, 0.f, 0.f, 0.f, 0.f, 0.f, 0.f, 0.f, 0.f};
    f32x16 o[4];
#pragma unroll
    for (int d0 = 0; d0 < 4; ++d0) o[d0] = zero16;
    float s0 = 0.f, s1 = 0.f;
    const int koff = mp * 8192 + hi * 1024 + r32 * 16;
    const int voff = 16384 + ((lane >> 4) & 1) * 32 + (lane & 3) * 8 + (4 * hi + ((lane & 15) >> 2)) * 64;
#define AT_SB() __builtin_amdgcn_sched_barrier(0)
#define AT_VF(src, k4) (bf16x8){src[2 * (k4)][0], src[2 * (k4)][1], src[2 * (k4)][2], src[2 * (k4)][3], src[2 * (k4) + 1][0], src[2 * (k4) + 1][1], src[2 * (k4) + 1][2], src[2 * (k4) + 1][3]}
#define AT_VT(vs_, d0, j) vtr(vs_ + (d0) * 4096 + ((j) >> 1) * 1024 + ((j) & 1) * 512)
#define AT_PACK() do { _Pragma("unroll") for (int q = 0; q < 4; ++q) { pw[0][q] = cvtpk(p0[2 * q], p0[2 * q + 1]); pw[1][q] = cvtpk(p0[8 + 2 * q], p0[8 + 2 * q + 1]); pw[2][q] = cvtpk(p1[2 * q], p1[2 * q + 1]); pw[3][q] = cvtpk(p1[8 + 2 * q], p1[8 + 2 * q + 1]); } } while (0)
    AT_WAITBAR(4);
    if (2 < NKT) dma_tile(lds0, S, 2, 2, wid);
    f32x16 p0, p1; u32x4 pw[4];
    {
        const LAS unsigned char* ks = lds + koff;
        bf16x8 kf[8];
#pragma unroll
        for (int i = 0; i < 8; ++i) kf[i] = *(const LAS bf16x8*)(ks + (i >> 1) * 2048 + (i & 1) * 512);
#pragma unroll
        for (int d0 = 0; d0 < 4; ++d0) {
            p0 = __builtin_amdgcn_mfma_f32_32x32x16_bf16(kf[2 * d0], qr[d0], d0 == 0 ? zero16 : p0, 0, 0, 0);
            p1 = __builtin_amdgcn_mfma_f32_32x32x16_bf16(kf[2 * d0 + 1], qr[d0], d0 == 0 ? zero16 : p1, 0, 0, 0);
        }
#pragma unroll
        for (int r = 0; r < 16; ++r) { p0[r] = __builtin_amdgcn_exp2f(p0[r]); p1[r] = __builtin_amdgcn_exp2f(p1[r]); s0 += p0[r]; s1 += p1[r]; }
    }
    for (int t = 0; t < NKT; ++t) {
        const bool more = t + 1 < NKT;
        if (t + 2 < NKT) { AT_WAITBAR(4); } else { AT_WAITBAR(0); }
        const bool pf = t + 3 < NKT;
        const LAS unsigned char* ks = lds + ((t + 1) & 3) * SLOT + koff;
        const LAS unsigned char* vs = lds + (t & 3) * SLOT + voff;
        bf16x8 kf[8]; s16x4 va[8], vb[8];
        if (more) {
#pragma unroll
            for (int i = 0; i < 8; ++i) kf[i] = *(const LAS bf16x8*)(ks + (i >> 1) * 2048 + (i & 1) * 512);
        }
#pragma unroll
        for (int j = 0; j < 8; ++j) va[j] = AT_VT(vs, 0, j);
        AT_SB();
        AT_PACK();
        AT_SB();
        if (more) {
#pragma unroll
            for (int i = 0; i < 8; ++i) {
                if ((i & 1) == 0) p0 = __builtin_amdgcn_mfma_f32_32x32x16_bf16(kf[i], qr[i >> 1], i < 2 ? zero16 : p0, 0, 0, 0);
                else p1 = __builtin_amdgcn_mfma_f32_32x32x16_bf16(kf[i], qr[i >> 1], i < 2 ? zero16 : p1, 0, 0, 0);
                vb[i] = AT_VT(vs, 1, i);
                if ((i & 1) && pf) dma_piece(lds0, S, t + 3, (t + 3) & 3, wid, i >> 1);
                AT_SB();
            }
        } else {
#pragma unroll
            for (int j = 0; j < 8; ++j) vb[j] = AT_VT(vs, 1, j);
            AT_SB();
        }
#pragma unroll
        for (int i = 0; i < 16; ++i) {
            const int d0 = i >> 2, k4 = i & 3;
            if ((d0 & 1) == 0) o[d0] = __builtin_amdgcn_mfma_f32_32x32x16_bf16(__builtin_bit_cast(bf16x8, pw[k4]), AT_VF(va, k4), o[d0], 0, 0, 0);
            else o[d0] = __builtin_amdgcn_mfma_f32_32x32x16_bf16(__builtin_bit_cast(bf16x8, pw[k4]), AT_VF(vb, k4), o[d0], 0, 0, 0);
            if (more) {
                const int r = 2 * (i & 7);
                if (i < 8) { p0[r] = __builtin_amdgcn_exp2f(p0[r]); p0[r + 1] = __builtin_amdgcn_exp2f(p0[r + 1]); s0 += p0[r]; s1 += p0[r + 1]; }
                else { p1[r] = __builtin_amdgcn_exp2f(p1[r]); p1[r + 1] = __builtin_amdgcn_exp2f(p1[r + 1]); s0 += p1[r]; s1 += p1[r + 1]; }
            }
            if (i >= 4 && i < 8) { va[2 * (i - 4)] = AT_VT(vs, 2, 2 * (i - 4)); va[2 * (i - 4) + 1] = AT_VT(vs, 2, 2 * (i - 4) + 1); }
            if (i >= 8 && i < 12) { vb[2 * (i - 8)] = AT_VT(vs, 3, 2 * (i - 8)); vb[2 * (i - 8) + 1] = AT_VT(vs, 3, 2 * (i - 8) + 1); }
            AT_SB();
        }
    }
    float l_reg = s0 + s1;
#undef AT_VF
#undef AT_VT
#undef AT_PACK
#undef AT_SB
    AT_WAITBAR(0);
    if (next_unit >= 0) { const Srcs N = unit_srcs(P, next_unit, wid, lane); dma_tile(lds0, N, 0, 0, wid); dma_tile(lds0, N, 1, 1, wid); }
    l_reg = xor32_sum(l_reg);
    LAS float* wsf = (LAS float*)(lds + WSF) + wid * 64;
    if (hi == 0) wsf[r32] = (mp == 0 ? 1.f : lam) / l_reg;
    asm volatile("s_waitcnt lgkmcnt(0)" ::: "memory");
    float fac[16];
#pragma unroll
    for (int r = 0; r < 16; ++r) fac[r] = wsf[crow(r, hi)];
    LAS f32x4v* X = (LAS f32x4v*)(lds + XOFF) + wq * 1024;
    if (mp == 1) {
#pragma unroll
        for (int d0 = 0; d0 < 4; ++d0)
#pragma unroll
            for (int q = 0; q < 4; ++q) X[(d0 * 4 + q) * 64 + lane] = (f32x4v){o[d0][4 * q] * fac[4 * q], o[d0][4 * q + 1] * fac[4 * q + 1], o[d0][4 * q + 2] * fac[4 * q + 2], o[d0][4 * q + 3] * fac[4 * q + 3]};
    }
    AT_WAITBAR(4);
    if (mp == 0) {
        float ss[16];
#pragma unroll
        for (int r = 0; r < 16; ++r) ss[r] = 0.f;
#pragma unroll
        for (int d0 = 0; d0 < 4; ++d0)
#pragma unroll
            for (int q = 0; q < 4; ++q) { const f32x4v xv = X[(d0 * 4 + q) * 64 + lane];
#pragma unroll
                for (int j = 0; j < 4; ++j) { const int r = 4 * q + j; const float v = o[d0][r] * fac[r] - xv[j]; o[d0][r] = v; ss[r] += v * v; } }
#pragma unroll
        for (int r = 0; r < 16; ++r) {
            float s = ss[r];
            s = xor16_sum(row16_sum(s));
            ss[r] = __builtin_amdgcn_rsqf(s * (1.f / 128.f) + EPSN) * (1.f - LAM_INIT);
        }
        asm volatile("s_waitcnt lgkmcnt(0)" ::: "memory");
        LAS bf16_t* stg = (LAS bf16_t*)(lds + XOFF + wq * 16384);
#pragma unroll
        for (int d0 = 0; d0 < 4; ++d0) {
            const float sw = P.in[IN_SUBLN][d0 * 32 + r32];
#pragma unroll
            for (int r = 0; r < 16; r += 2) { const unsigned pk = cvtpk(o[d0][r] * ss[r] * sw, o[d0][r + 1] * ss[r + 1] * sw);
                stg[crow(r, hi) * 128 + d0 * 32 + r32] = (bf16_t)(pk & 0xffffu); stg[crow(r + 1, hi) * 128 + d0 * 32 + r32] = (bf16_t)(pk >> 16); }
        }
        asm volatile("s_waitcnt lgkmcnt(0)" ::: "memory");
        bf16_t* On = Obase + ((size_t)(b * SEQL + q0 + wq * 32)) * 1024 + h * 128;
#pragma unroll
        for (int i = 0; i < 8; ++i) { const int row = i * 4 + (lane >> 4), ch = lane & 15;
            const u32x4 v = *(const LAS u32x4*)(stg + row * 128 + ch * 8);
            *(u32x4*)(On + (size_t)row * 1024 + ch * 8) = v; }
    }
}
#undef AT_WAITBAR
__device__ __forceinline__ void attn_phase(const Ptrs& P, LAS unsigned char* lds, int G, int bx, int wave, bf16_t* Obase) {
    const int lane = lane_id();
    asm volatile(".rept %0\n\ts_nop 0\n\t.endr" :: "i"(PAD_ATT));
    const float lam = __expf(wave_sum(P.in[IN_LQ1][lane] * P.in[IN_LK1][lane])) - __expf(wave_sum(P.in[IN_LQ2][lane] * P.in[IN_LK2][lane])) + LAM_INIT;
    const float mshift = 8.f * 1.4426950408889634f * wave_max(fabsf(P.in[IN_QNW][lane])) * wave_max(fabsf(P.in[IN_KNW][lane]));
    const int vcu = (G % 8 == 0) ? (bx % 8) * (G / 8) + bx / 8 : bx;
    const int NU = NB * NHEAD * 32;
    bool first = true;
    for (int u = vcu; u < NU; u += G) { attn_unit(P, lds, u, u + G < NU ? u + G : -1, first, lam, mshift, wave, Obase); first = false; }
    asm volatile("s_waitcnt vmcnt(0) lgkmcnt(0)" ::: "memory");
    __syncthreads();
}
}
namespace s5 {
using pg8::Unit; using pg8::f32x4; using pg8::u32x4;
typedef float f2 __attribute__((ext_vector_type(2)));
__device__ __forceinline__ f2 cmul(f2 a, f2 b) { return (f2){a.x * b.x - a.y * b.y, a.x * b.y + a.y * b.x}; }

template <int NDL>
__device__ __forceinline__ void stage2(const LAS f2* apow, const LAS f2* BB, const LAS f2* CC, LAS float* Mt, int d, int c, int cp) {
    float acc[NDL];
#pragma unroll
    for (int j = 0; j < NDL; ++j) acc[j] = 0.f;
#pragma unroll 2
    for (int p = 0; p < 64; ++p) {
        const f2 z = cmul(CC[(d * 64 + p) * 16 + c], BB[(d * 64 + p) * 16 + cp]);
        const LAS f2* ap = apow + (d * 64 + p) * 17;
#pragma unroll
        for (int j = 0; j < NDL; ++j) { const f2 a = ap[j]; acc[j] += z.x * a.x - z.y * a.y; }
    }
#pragma unroll
    for (int j = 0; j < NDL; ++j) Mt[((d * 16 + j) * 16 + c) * 16 + cp] = acc[j];
}
__device__ void build_tables(const Ptrs& P, LAS unsigned char* lds, int item, int tid) {
    const int g = item >> 3, qt = item & 7;
    LAS f2* apow = (LAS f2*)lds;
    LAS f2* BB = (LAS f2*)(lds + 17408);
    LAS f2* CC = (LAS f2*)(lds + 33792);
    LAS float* Mt = (LAS float*)(lds + 50176);
    {
        const int dp = tid & 127, cq = tid >> 7, d = dp >> 6, p = dp & 63, gi = (d * NGRP + g) * NST + p;
        const float lre = fminf(P.in[IN_ARE][gi], -1e-4f), lim = P.in[IN_AIM][gi], dt = __expf(P.in[IN_LOGDT][d * NGRP + g]);
        f2 a1; { const float mag = __expf(lre * dt); float sn, cs; sincosf(lim * dt, &sn, &cs); a1 = (f2){mag * cs, mag * sn}; }
        if (cq == 0) { f2 pw = (f2){1.f, 0.f};
            for (int n = 0; n <= 16; ++n) { apow[(d * 64 + p) * 17 + n] = pw; if (n == 16 && qt == 0) ((f2*)(P.ws + WS_A16))[(g * 2 + d) * 64 + p] = pw; pw = cmul(pw, a1); } }
        const float nr = a1.x - 1.f, ni = a1.y, den = lre * lre + lim * lim;
        const f2 fz = (f2){(nr * lre + ni * lim) / den, (ni * lre - nr * lim) / den};
#pragma unroll
        for (int cc = 0; cc < 4; ++cc) { const int c = 4 * cq + cc;
            BB[(d * 64 + p) * 16 + c] = cmul(fz, (f2){P.in[IN_BRE][(size_t)gi * 16 + c], P.in[IN_BIM][(size_t)gi * 16 + c]});
            CC[(d * 64 + p) * 16 + c] = (f2){P.in[IN_CRE][((size_t)(d * NGRP + g) * 16 + c) * NST + p], P.in[IN_CIM][((size_t)(d * NGRP + g) * 16 + c) * NST + p]};
        }
    }
    __syncthreads();
    {
        const int d = tid >> 8, c = (tid >> 4) & 15, cp = tid & 15;
        const int ndl = d == 0 ? 2 * qt + 2 : 16 - 2 * qt;
        switch (ndl >> 1) {
            case 1: stage2<2>(apow, BB, CC, Mt, d, c, cp); break;  case 2: stage2<4>(apow, BB, CC, Mt, d, c, cp); break;
            case 3: stage2<6>(apow, BB, CC, Mt, d, c, cp); break;  case 4: stage2<8>(apow, BB, CC, Mt, d, c, cp); break;
            case 5: stage2<10>(apow, BB, CC, Mt, d, c, cp); break; case 6: stage2<12>(apow, BB, CC, Mt, d, c, cp); break;
            case 7: stage2<14>(apow, BB, CC, Mt, d, c, cp); break; default: stage2<16>(apow, BB, CC, Mt, d, c, cp); break;
        }
    }
    __syncthreads();
    bf16_t* TQ = (bf16_t*)(P.ws + WS_TQ) + (size_t)g * 256 * 512;
    for (int e = tid; e < 32 * 64; e += 512) {
        const int row = qt * 32 + (e >> 6), K0 = (e & 63) * 8, tau = row >> 4, c = row & 15;
        float v[8];
        if (K0 < 256) { const int sg = K0 >> 4, cp0 = K0 & 15;
            const LAS float* m0p = tau > sg ? Mt + ((0 * 16 + (tau - sg)) * 16 + c) * 16 + cp0 : (tau < sg ? Mt + ((1 * 16 + (sg - tau)) * 16 + c) * 16 + cp0 : Mt + (0 * 16 * 16 + c) * 16 + cp0);
#pragma unroll
            for (int j = 0; j < 8; ++j) v[j] = m0p[j];
            if (tau == sg) { const LAS float* m1p = Mt + ((1 * 16) * 16 + c) * 16 + cp0;
#pragma unroll
                for (int j = 0; j < 8; ++j) v[j] += m1p[j]; }
        } else { const int r0 = K0 - 256, d = r0 >> 7, ri = (r0 >> 6) & 1, p0 = r0 & 63;
#pragma unroll
            for (int j = 0; j < 8; ++j) { const int p = p0 + j;
                const f2 t = cmul(CC[(d * 64 + p) * 16 + c], apow[(d * 64 + p) * 17 + (d == 0 ? tau + 1 : 16 - tau)]);
                v[j] = ri == 0 ? t.x : -t.y; } }
        u32x4 o; o.x = pg8::cvt_pk_bf16(v[0], v[1]); o.y = pg8::cvt_pk_bf16(v[2], v[3]); o.z = pg8::cvt_pk_bf16(v[4], v[5]); o.w = pg8::cvt_pk_bf16(v[6], v[7]);
        *(u32x4*)(TQ + (size_t)row * 512 + K0) = o;
    }
    bf16_t* PS = (bf16_t*)(P.ws + WS_PST) + (size_t)g * 256 * 256;
    for (int e = tid; e < 32 * 32; e += 512) {
        const int r = qt * 32 + (e >> 5), K0 = (e & 31) * 8, sg = K0 >> 4, cp0 = K0 & 15, d = r >> 7, ri = (r >> 6) & 1, p = r & 63;
        const f2 ap = apow[(d * 64 + p) * 17 + (d == 0 ? 15 - sg : sg)];
        float v[8];
#pragma unroll
        for (int j = 0; j < 8; ++j) { const f2 t = cmul(ap, BB[(d * 64 + p) * 16 + cp0 + j]); v[j] = ri == 0 ? t.x : t.y; }
        u32x4 o; o.x = pg8::cvt_pk_bf16(v[0], v[1]); o.y = pg8::cvt_pk_bf16(v[2], v[3]); o.z = pg8::cvt_pk_bf16(v[4], v[5]); o.w = pg8::cvt_pk_bf16(v[6], v[7]);
        *(u32x4*)(PS + (size_t)r * 256 + K0) = o;
    }
    __syncthreads();
}

struct SchedE { int bg, g; __device__ __forceinline__ bool next(int i, Unit& u) const { if (i >= 1) return false; u.arow = bg * NCH; u.brow = g * 256; u.pm = 0; u.pn = 0; return true; } };
struct EpiE {
    static constexpr bool PERM = true;
    float* Es;
    __device__ __forceinline__ void operator()(const f32x4 (&acc)[2][2][4][2], const Unit& u, int wr, int wc, int fr, int fq) const {
#pragma unroll
        for (int ai = 0; ai < 2; ++ai)
#pragma unroll
            for (int m = 0; m < 4; ++m) {
                const int j = 256 * u.pm + 128 * ai + 64 * wr + 16 * m + fr;
                if (j < NCH) {
#pragma unroll
                    for (int bj = 0; bj < 2; ++bj) { float* e = Es + (size_t)j * 256 + 128 * bj + 32 * wc + 8 * fq; *(f32x4*)e = acc[ai][bj][m][0]; *(f32x4*)(e + 4) = acc[ai][bj][m][1]; }
                }
            }
    }
};
struct EpiY {
    static constexpr bool PERM = true;
    const Ptrs* Pp; int b, g;
    __device__ __forceinline__ void operator()(const f32x4 (&acc)[2][2][4][2], const Unit& u, int wr, int wc, int fr, int fq) const {
        const Ptrs& P = *Pp;
        const int c0 = 8 * (fq & 1);
        const f32x4 d0 = *(const f32x4*)(P.in[IN_S5D] + g * 16 + c0), d1 = *(const f32x4*)(P.in[IN_S5D] + g * 16 + c0 + 4);
#pragma unroll
        for (int ai = 0; ai < 2; ++ai)
#pragma unroll
            for (int m = 0; m < 4; ++m) {
                const int j = 128 * ai + 64 * wr + 16 * m + fr;
#pragma unroll
                for (int bj = 0; bj < 2; ++bj) {
                    const int tau = 8 * bj + 2 * wc + (fq >> 1);
                    const u32x4 uu = *(const u32x4*)((const bf16_t*)(P.ws + WS_RU) + u_idx(b, g, j, tau, c0));
                    f32x4 y0 = acc[ai][bj][m][0] + d0 * og::unpk_lo(uu), y1 = acc[ai][bj][m][1] + d1 * og::unpk_hi(uu);
#pragma unroll
                    for (int q = 0; q < 4; ++q) {
                        const float a = y0[q], bb = y1[q];
                        y0[q] = a * __builtin_amdgcn_rcpf(1.f + __builtin_amdgcn_exp2f(a * __builtin_fmaf(a * a, -0.10294324f, -2.3022082f)));
                        y1[q] = bb * __builtin_amdgcn_rcpf(1.f + __builtin_amdgcn_exp2f(bb * __builtin_fmaf(bb * bb, -0.10294324f, -2.3022082f)));
                    }
                    *(u32x4*)((bf16_t*)(P.ws + WS_HS) + ((size_t)(b * SEQL + 16 * j + tau)) * S5W + g * 16 + c0) = og::pack8(y0, y1);
                }
            }
    }
};
__device__ __forceinline__ void scan(const Ptrs& P, int bg, int g, const float* Es, int tid) {
    if (tid >= 128) return;
    const int d = tid >> 6, p = tid & 63;
    const f2 a16 = ((const f2*)(P.ws + WS_A16))[(g * 2 + d) * 64 + p];
    const float ar = a16.x, ai = a16.y;
    const float* er = Es + d * 128 + p;
    float sr = 0.f, si = 0.f;
    {   float cx[16], cy[16];
#pragma unroll
        for (int k = 0; k < 16; ++k) { const int j = d == 0 ? 256 + k : 271 - k; cx[k] = er[(size_t)j * 256]; cy[k] = er[(size_t)j * 256 + 64]; }
#pragma unroll
        for (int k = 0; k < 16; ++k) { const float nr = ar * sr - ai * si + cx[k], ni = ar * si + ai * sr + cy[k]; sr = nr; si = ni; } }
    const long estep = d == 0 ? 256 : -256;
    const long ustep = d == 0 ? 512 : -512;
    const float* e = er + (size_t)(d == 0 ? 0 : 255) * 256;
    bf16_t* u = (bf16_t*)(P.ws + WS_RU) + (size_t)bg * NCH * 512 + 256 + d * 128 + p + (size_t)(d == 0 ? 0 : 255) * 512;
    float xa[16], ya[16], xb[16], yb[16];
#pragma unroll
    for (int k = 0; k < 16; ++k) { xa[k] = e[k * estep]; ya[k] = e[k * estep + 64]; }
#define S5_STEP(X, Y) do { const unsigned pk = pg8::cvt_pk_bf16(sr, si); u[0] = (bf16_t)(pk & 0xffffu); u[64] = (bf16_t)(pk >> 16); u += ustep; \
        const float nr = __builtin_fmaf(ar, sr, __builtin_fmaf(-ai, si, X)), ni = __builtin_fmaf(ar, si, __builtin_fmaf(ai, sr, Y)); sr = nr; si = ni; \
        asm volatile("" : "+v"(sr), "+v"(si)); } while (0)
#pragma unroll 1
    for (int k0 = 0; k0 < 256; k0 += 32) {
        e += 16 * estep;
#pragma unroll
        for (int k = 0; k < 16; ++k) { xb[k] = e[k * estep]; yb[k] = e[k * estep + 64]; }
#pragma unroll
        for (int k = 0; k < 16; ++k) S5_STEP(xa[k], ya[k]);
        e += 16 * estep;
        if (k0 + 32 < 256) {
#pragma unroll
            for (int k = 0; k < 16; ++k) { xa[k] = e[k * estep]; ya[k] = e[k * estep + 64]; }
        }
#pragma unroll
        for (int k = 0; k < 16; ++k) S5_STEP(xb[k], yb[k]);
    }
#undef S5_STEP
}
__device__ __forceinline__ void ctx_states(const Ptrs& P, int bg, int g, float* Es, int wave, int lane) {
    typedef short bf16x8 __attribute__((ext_vector_type(8)));
    const int i16 = lane & 15, kq = lane >> 4;
    const bf16_t* Ua = (const bf16_t*)(P.ws + WS_RU) + ((size_t)bg * NCH + 256 + i16) * 512 + 8 * kq;
    bf16x8 af[8];
#pragma unroll
    for (int ks = 0; ks < 8; ++ks) af[ks] = *(const bf16x8*)(Ua + 32 * ks);
#pragma unroll
    for (int q = 0; q < 2; ++q) {
        const int nt = 2 * wave + q;
        const bf16_t* Pb = (const bf16_t*)(P.ws + WS_PST) + ((size_t)g * 256 + 16 * nt + i16) * 256 + 8 * kq;
        f32x4 acc = (f32x4){0.f, 0.f, 0.f, 0.f};
#pragma unroll
        for (int ks = 0; ks < 8; ++ks) acc = __builtin_amdgcn_mfma_f32_16x16x32_bf16(af[ks], *(const bf16x8*)(Pb + 32 * ks), acc, 0, 0, 0);
#pragma unroll
        for (int reg = 0; reg < 4; ++reg) Es[(size_t)(256 + 4 * kq + reg) * 256 + 16 * nt + i16] = acc[reg];
    }
}
__device__ __forceinline__ void s5_item(const Ptrs& P, LAS unsigned char* ring, int bg, int wave) {
    const int b = bg / NGRP, g = bg % NGRP;
    float* Es = (float*)(P.ws + WS_RH) + (size_t)bg * NCH * 256;
    const bf16_t* U = (const bf16_t*)(P.ws + WS_RU);
    { int l_ = lane_id(); asm volatile("" : "+v"(l_)); ctx_states(P, bg, g, Es, wave, l_); }
    { const pg8::Gemm g1{U, (const bf16_t*)(P.ws + WS_PST), 256, 512, 256};
      pg8::gemm_phase<EpiE, SchedE, false, 0>(ring, g1, SchedE{bg, g}, EpiE{Es}, wave); }
    asm volatile("s_waitcnt vmcnt(0)" ::: "memory"); __syncthreads();
    { int t_ = wave * 64 + lane_id(); asm volatile("" : "+v"(t_)); scan(P, bg, g, Es, t_); }
    asm volatile("s_waitcnt vmcnt(0)" ::: "memory"); __syncthreads();
    { const pg8::Gemm g2{U, (const bf16_t*)(P.ws + WS_TQ), 512, 512, 512};
      og::SchedOne so; so.v.arow = bg * NCH; so.v.brow = g * 256; so.v.pm = 0; so.v.pn = 0;
      pg8::gemm_phase<EpiY, og::SchedOne, false, 0>(ring, g2, so, EpiY{&P, b, g}, wave); }
}
}
namespace p0 {
typedef float f32x4 __attribute__((ext_vector_type(4)));
typedef unsigned u32x2 __attribute__((ext_vector_type(2)));
__device__ __forceinline__ void mod_item(const Ptrs& P, LAS unsigned char* lds, int item, int half, int vt) {
    const int ct = item % 24, ks = item / 24, col = ct * 256 + vt, k0 = ks * 64;
    const float* W = P.in[IN_ADAW] + (size_t)k0 * 6144 + col;
    LAS float* sl = (LAS float*)(lds + 90112 + half * 2048);
    for (int e = vt; e < 320; e += 256) { const int r = e >> 6, k = e & 63; const float c = r < 4 ? P.in[IN_C][r * DM + k0 + k] : P.in[IN_CCTX][k0 + k];
        sl[e] = c * __builtin_amdgcn_rcpf(1.f + __builtin_amdgcn_exp2f(-1.4426950408889634f * c)); }
    __syncthreads();
    float acc[5] = {0.f, 0.f, 0.f, 0.f, 0.f};
#pragma unroll 1
    for (int kb = 0; kb < 64; kb += 16) {
    float wv[16];
#pragma unroll
    for (int k = 0; k < 16; ++k) wv[k] = __builtin_nontemporal_load(W + (size_t)(kb + k) * 6144);
#pragma unroll
    for (int kk = 0; kk < 16; ++kk) {
        const float w = wv[kk];
#pragma unroll
        for (int r = 0; r < 5; ++r) acc[r] += sl[r * 64 + kb + kk] * w;
    }
    }
    float* mod = (float*)(P.ws + WS_MODFIN);
#pragma unroll
    for (int r = 0; r < 5; ++r) atomicAdd(mod + r * 6144 + col, acc[r] + (ks == 0 ? P.in[IN_ADAB][col] : 0.f));
    __syncthreads();
}
__device__ __forceinline__ void biasup_item(const Ptrs& P, int item, int vt) {
    const int ct = item % 22, ks = item / 22, n = ct * 256 + vt, k0 = ks * 64;
    const float* W = P.in[IN_WUP] + (size_t)k0 * NIN + n;
    const float* mod = (const float*)(P.ws + WS_MODFIN) + 3072 + k0;
    float acc[4] = {0.f, 0.f, 0.f, 0.f};
#pragma unroll 1
    for (int kb = 0; kb < 64; kb += 16) {
    float wv[16];
#pragma unroll
    for (int k = 0; k < 16; ++k) wv[k] = __builtin_nontemporal_load(W + (size_t)(kb + k) * NIN);
#pragma unroll
    for (int kk = 0; kk < 16; ++kk) {
        const int k = kb + kk; const float w = wv[kk];
#pragma unroll
        for (int b = 0; b < 4; ++b) acc[b] += mod[b * 6144 + k] * w;
    }
    }
#pragma unroll
    for (int b = 0; b < 4; ++b) atomicAdd((float*)(P.ws + WS_BIASUP) + b * NIN + n, acc[b]);
}
__device__ __forceinline__ void modulate_row(const Ptrs& P, int r, int lane) {
    const float* xr = r < MR ? P.in[IN_X] + (size_t)r * DM : P.in[IN_CTX] + (size_t)(r - MR) * DM;
    const float* mod = (const float*)(P.ws + WS_MODFIN) + (r < MR ? r / SEQL : 4) * 6144;
    f32x4 v[4]; float ss = 0.f;
#pragma unroll
    for (int j = 0; j < 4; ++j) { v[j] = __builtin_nontemporal_load((const f32x4*)(xr + 256 * j + 4 * lane)); ss += (v[j][0] * v[j][0] + v[j][1] * v[j][1]) + (v[j][2] * v[j][2] + v[j][3] * v[j][3]); }
    const float rstd = __builtin_amdgcn_rsqf(wave_sum(ss) * (1.f / DM) + EPSN);
    bf16_t* H = (bf16_t*)(P.ws + WS_RH) + (size_t)r * DM;
#pragma unroll
    for (int j = 0; j < 4; ++j) { const int k = 256 * j + 4 * lane;
        const f32x4 w = *(const f32x4*)(P.in[IN_N1W] + k), sc = *(const f32x4*)(mod + 1024 + k), sh = *(const f32x4*)(mod + k);
        const f32x4 y = v[j] * rstd * w * (sc + 1.f) + sh;
        u32x2 o; o.x = pg8::cvt_pk_bf16(y[0], y[1]); o.y = pg8::cvt_pk_bf16(y[2], y[3]);
        *(u32x2*)(H + k) = o; }
}
__device__ __forceinline__ void modulate_rows(const Ptrs& P, int gw, int NGW, int lane) {
    const int per = (MT + NGW - 1) / NGW;
    int r = gw * per; const int rend = r + per < MT ? r + per : MT;
    if (r >= rend) return;
    f32x4 A[4], B[4], v[4], nv[4]; int curb = -1;
    { const float* xr = r < MR ? P.in[IN_X] + (size_t)r * DM : P.in[IN_CTX] + (size_t)(r - MR) * DM;
#pragma unroll
      for (int j = 0; j < 4; ++j) v[j] = __builtin_nontemporal_load((const f32x4*)(xr + 256 * j + 4 * lane)); }
#pragma unroll 1
    for (; r < rend; ++r) {
        if (r + 1 < rend) { const int rn = r + 1; const float* xr = rn < MR ? P.in[IN_X] + (size_t)rn * DM : P.in[IN_CTX] + (size_t)(rn - MR) * DM;
#pragma unroll
            for (int j = 0; j < 4; ++j) nv[j] = __builtin_nontemporal_load((const f32x4*)(xr + 256 * j + 4 * lane)); }
        const int b = r < MR ? r / SEQL : 4;
        if (b != curb) { curb = b; const float* mod = (const float*)(P.ws + WS_MODFIN) + b * 6144;
#pragma unroll
            for (int j = 0; j < 4; ++j) { const int k = 256 * j + 4 * lane; A[j] = *(const f32x4*)(P.in[IN_N1W] + k) * (*(const f32x4*)(mod + 1024 + k) + 1.f); B[j] = *(const f32x4*)(mod + k); } }
        float ss = 0.f;
#pragma unroll
        for (int j = 0; j < 4; ++j) ss += (v[j][0] * v[j][0] + v[j][1] * v[j][1]) + (v[j][2] * v[j][2] + v[j][3] * v[j][3]);
        const float rstd = __builtin_amdgcn_rsqf(wave_sum(ss) * (1.f / DM) + EPSN);
        bf16_t* H = (bf16_t*)(P.ws + WS_RH) + (size_t)r * DM;
#pragma unroll
        for (int j = 0; j < 4; ++j) { const int k = 256 * j + 4 * lane;
            const f32x4 y = v[j] * rstd * A[j] + B[j];
            u32x2 o; o.x = pg8::cvt_pk_bf16(y[0], y[1]); o.y = pg8::cvt_pk_bf16(y[2], y[3]);
            *(u32x2*)(H + k) = o; }
#pragma unroll
        for (int j = 0; j < 4; ++j) v[j] = nv[j];
    }
}
}

#define XB_TMO      128
#define XB_XCNT(j)  (256  + 64 * (j))
#define XB_XSUB(j)  (1280 + 64 * (j))
#define XB_XGEN(j)  (2304 + 64 * (j))
#define XB_TOP      3328
#define XB_TOPGEN   3392
#define XCD_BAR_WORDS 3456
#define XB_SPIN_CAP (1u << 22)
constexpr int CW_BAR = 4096;

__device__ __forceinline__ unsigned xb_ld(unsigned* p)              { return __hip_atomic_load(p, __ATOMIC_RELAXED, __HIP_MEMORY_SCOPE_AGENT); }
__device__ __forceinline__ unsigned xb_add(unsigned* p, unsigned v) { return __hip_atomic_fetch_add(p, v, __ATOMIC_RELAXED, __HIP_MEMORY_SCOPE_AGENT); }
__device__ __forceinline__ unsigned xb_xcc_id() { return (unsigned)__builtin_amdgcn_s_getreg((3 << 11) | 20) & 0xFu; }
#define XB_SPIN(cond, bar) do { unsigned _sp = 0; while (cond) { __builtin_amdgcn_s_sleep(1); \
    if ((++_sp & 255u) == 0u) { if (xb_ld(&(bar)[XB_TMO])) break; if (_sp > XB_SPIN_CAP) { atomicAdd(&(bar)[XB_TMO], 1u); break; } } } } while (0)
struct XcdBarrier { unsigned* bar; unsigned x; volatile LAS unsigned* st; };
__device__ __forceinline__ XcdBarrier xcd_barrier_post(unsigned* bar, volatile LAS unsigned* st, int tid) {
    XcdBarrier b; b.bar = bar; b.x = xb_xcc_id(); b.st = st;
    if (tid == 0) (void)xb_add(&bar[XB_XCNT(b.x)], 1u);
    return b;
}
__device__ __forceinline__ void xcd_barrier_complete(unsigned* bar, unsigned x, unsigned& nloc, unsigned& nx) {
    const unsigned G = gridDim.x * gridDim.y * gridDim.z;
    unsigned sum, cnt, mine, sp = 0u;
    for (;;) {
        sum = 0u; cnt = 0u; mine = 0u;
#pragma unroll
        for (unsigned j = 0; j < 16; ++j) { const unsigned c = xb_ld(&bar[XB_XCNT(j)]); sum += c; cnt += (c > 0u) ? 1u : 0u; mine = (j == x) ? c : mine; }
        if (sum == G) break;
        __builtin_amdgcn_s_sleep(1);
        if ((++sp & 255u) == 0u) { if (xb_ld(&bar[XB_TMO])) break; if (sp > XB_SPIN_CAP) { atomicAdd(&bar[XB_TMO], 1u); break; } }
    }
    nloc = mine > 0u ? mine : 1u; nx = cnt > 0u ? cnt : 1u;
}
__device__ __forceinline__ void xcd_barrier(const XcdBarrier& b, int wave) {
    const int tid0 = wave * 64 + lane_id();
    asm volatile("s_waitcnt vmcnt(0)" ::: "memory");
    __syncthreads();
    if (tid0 == 0) {
        unsigned* bar = b.bar;
        __builtin_amdgcn_s_waitcnt(0);
        unsigned nloc = b.st[0], nx = b.st[1];
        if (nloc == 0u) { xcd_barrier_complete(bar, b.x, nloc, nx); b.st[0] = nloc; b.st[1] = nx; }
        const unsigned old = xb_add(&bar[XB_XSUB(b.x)], 1u);
        const unsigned gen = old / nloc;
        if (old + 1u == (gen + 1u) * nloc) {
            __builtin_amdgcn_fence(__ATOMIC_RELEASE, "agent");
            asm volatile("s_waitcnt vmcnt(0)" ::: "memory");
            const unsigned og = xb_add(&bar[XB_TOP], 1u);
            const unsigned tg = og / nx;
            if (og + 1u == (tg + 1u) * nx) xb_add(&bar[XB_TOPGEN], 1u);
            else XB_SPIN(xb_ld(&bar[XB_TOPGEN]) == tg, bar);
            xb_add(&bar[XB_XGEN(b.x)], 1u);
            __builtin_amdgcn_fence(__ATOMIC_ACQUIRE, "agent");
            asm volatile("s_waitcnt vmcnt(0)" ::: "memory");
        } else {
            XB_SPIN(xb_ld(&bar[XB_XGEN(b.x)]) == gen, bar);
            __builtin_amdgcn_fence(__ATOMIC_ACQUIRE, "agent");
            asm volatile("s_waitcnt vmcnt(0)" ::: "memory");
        }
    }
    __syncthreads();
}

#ifndef OPT_GEMM
#define OPT_GEMM 1
#endif
#ifndef OPT_P1
#define OPT_P1 1
#endif
#ifndef OPT_P3
#define OPT_P3 1
#endif
#ifndef OPT_P4
#define OPT_P4 1
#endif
#ifndef OPT_ATTN
#define OPT_ATTN 1
#endif
#ifndef OPT_S5
#define OPT_S5 1
#endif
#ifndef OPT_P0
#define OPT_P0 1
#endif
#ifndef REP_P1
#define REP_P1 0
#endif
#ifndef REP_P4
#define REP_P4 0
#endif
#ifndef REP_S5
#define REP_S5 0
#endif
#ifndef REP_ATTN
#define REP_ATTN 0
#endif
#ifndef REP_BAR
#define REP_BAR 0
#endif
#ifndef REP_P3
#define REP_P3 0
#endif
#ifndef REP_P0
#define REP_P0 0
#endif
#ifndef USE_COOP_LAUNCH
#define USE_COOP_LAUNCH 1
#endif
#ifndef OPT_P5
#define OPT_P5 1
#endif
constexpr int LDS_BYTES = 147456;
constexpr int LDS_MISC = LDS_BYTES - 512;
struct Args { Ptrs P; int ph_lo, ph_hi; };

#define PADNOPS(n) asm volatile(".rept %0\n\ts_nop 0\n\t.endr" :: "i"(n))
__global__ void __launch_bounds__(512, 2) mega(Args a) {
    extern __shared__ __attribute__((aligned(16))) unsigned char lds[];
    const Ptrs& P = a.P;
    PADNOPS(PAD_ENTRY);
    const int wave = __builtin_amdgcn_readfirstlane(threadIdx.x >> 6);
    const int lane = lane_id(), tid = wave * 64 + lane, half = tid >> 8, vt = tid & 255;
    const int G = gridDim.x, bx = blockIdx.x;
    if (tid < 128) ((LAS unsigned*)(lds + LDS_MISC))[tid] = 0u;
    __syncthreads();
    XcdBarrier bar = xcd_barrier_post((unsigned*)(P.ws + WS_CTL) + CW_BAR, (volatile LAS unsigned*)(lds + LDS_MISC) + 8, tid);
    char* lh = (char*)lds + half * NB_LDS;
    const int lo = a.ph_lo, hi = a.ph_hi;
#define IN(k) (lo <= (k) && (k) < hi)
#define SEAM(k) do { if (IN(k) && IN((k) + 1)) xcd_barrier(bar, wave); } while (0)
#define VB2(NV) for (int v_ = 2 * bx + half; v_ < (NV); v_ += 2 * G)

    LAS unsigned char* ring = (LAS unsigned char*)lds;
#if REP_P0
    {
    if (IN(0)) {
#if OPT_P0
        VB2(24 * 16) p0::mod_item(P, ring, v_, half, vt);
#else
        VB2(120) nb_mod(P, v_ % 24, v_ / 24, vt);
#endif
        VB2(4) nb_rope(P, v_, vt);
        for (int i = bx * 512 + tid; i < MR + 512; i += G * 512) ((float*)(P.ws + WS_ROWSQ0))[i] = 0.f;
#if OPT_S5
        for (int it = bx; it < NGRP * 8; it += G) s5::build_tables(P, ring, it, tid);
#endif
#if OPT_GEMM
        og::transposes_A(P, ring, bx * 8 + wave, G * 8, wave, lane);
#endif
    }
    xcd_barrier(bar, wave);
    if (IN(1)) {
#if OPT_P0
        for (int r = bx * 8 + wave; r < MT; r += G * 8) p0::modulate_row(P, r, lane);
#else
        VB2(88) nb_biasup(P, v_ % 22, v_ / 22, vt);
        VB2(MT / 4) nb_modulate(P, v_, vt);
#endif
    }
    xcd_barrier(bar, wave);
    for (int i = bx * 512 + tid; i < (int)((768 * 1024 - 512 * 1024) / 4); i += G * 512) ((float*)(P.ws + WS_MODFIN))[i] = 0.f;
    xcd_barrier(bar, wave);
    }
#endif
    if (IN(0)) {
#if OPT_P0
        VB2(24 * 16) p0::mod_item(P, ring, v_, half, vt);
#else
        VB2(120) nb_mod(P, v_ % 24, v_ / 24, vt);
#endif
        VB2(4) nb_rope(P, v_, vt);
        for (int i = bx * 512 + tid; i < MR + 512; i += G * 512) ((float*)(P.ws + WS_ROWSQ0))[i] = 0.f;
#if OPT_S5 && OPT_GEMM
        {
            float trv[32]; const int it0 = bx * 8 + wave; const bool pre = it0 < og::I_IN;
            if (pre) og::tr_in_load(P, it0, lane, trv);
            for (int it = bx; it < NGRP * 8; it += G) s5::build_tables(P, ring, it, tid);
            if (pre) og::tr_in_finish(P, (LAS float*)(ring + wave * 8704), it0, lane, trv);
            og::transposes_A(P, ring, bx * 8 + wave, G * 8, wave, lane, pre ? 1 : 0);
        }
#else
#if OPT_S5
        for (int it = bx; it < NGRP * 8; it += G) s5::build_tables(P, ring, it, tid);
#endif
#if OPT_GEMM
        og::transposes_A(P, ring, bx * 8 + wave, G * 8, wave, lane);
#endif
#endif
    }
    SEAM(0);
    if (IN(1)) {
#if OPT_P0
        p0::modulate_rows(P, bx * 8 + wave, G * 8, lane);
#else
        VB2(88) nb_biasup(P, v_ % 22, v_ / 22, vt);
        VB2(MT / 4) nb_modulate(P, v_, vt);
#endif
    }
    SEAM(1);
    if (IN(2)) {
#if OPT_GEMM && OPT_P1
        { const pg8::Gemm g{(const bf16_t*)(P.ws + WS_RH), (const bf16_t*)(P.ws + WS_WIN), DM, DM, DM};
          for (int rep_ = 0; rep_ < 1 + REP_P1; ++rep_) pg8::gemm_phase<og::EpiIn, og::SchedIn, true, 0>(ring, g, og::SchedIn{G, bx}, og::EpiIn{&P}, wave); }
        {
            const int nshort = G - (1448 % G), first_short = 1448 % G;
            if (first_short == 0) { for (int v_ = 2 * bx + half; v_ < 22 * 16; v_ += 2 * G) p0::biasup_item(P, v_, vt); }
            else if (bx >= first_short) { for (int v_ = 2 * (bx - first_short) + half; v_ < 22 * 16; v_ += 2 * nshort) p0::biasup_item(P, v_, vt); }
            if (first_short == 0) og::transposes_B(P, ring, bx * 8 + wave, G * 8, wave, lane);
            else if (bx >= first_short) og::transposes_B(P, ring, (bx - first_short) * 8 + wave, nshort * 8, wave, lane);
        }
#else
        VB2((NIN / 64) * (MT / 64)) nb_inproj(P, v_ % (NIN / 64), v_ / (NIN / 64), vt, lh);
#endif
    }
#if REP_BAR
    for (int rb_ = 0; rb_ < 10; ++rb_) xcd_barrier(bar, wave);
#endif
    SEAM(2);
    if (IN(3)) {
#if OPT_GEMM
        og::build_convtab(P, bx * 512 + tid);
#endif
#if OPT_ATTN
#if REP_ATTN
        at::attn_phase(P, ring, G, bx, wave, (bf16_t*)(P.ws + WS_RH)); xcd_barrier(bar, wave);
#endif
        at::attn_phase(P, ring, G, bx, wave, (bf16_t*)(P.ws + WS_RQ));
#else
        if (wave < 4) for (int it = 4 * bx + wave; it < NB * NHEAD * SEQL; it += 4 * G) nb_attn(P, it, lane, (char*)lds + wave * 35328);
#endif
#if OPT_S5
        xcd_barrier(bar, wave);
        PADNOPS(PAD_WIN);
        {
            const int nS = NB * NGRP;
            const pg8::Gemm gya{(const bf16_t*)(P.ws + WS_RQ), (const bf16_t*)(P.ws + WS_WBA), DM, DM, DM};
            if (G > nS) {
                if (bx < nS) { for (int rep_ = 0; rep_ < 1 + REP_S5; ++rep_) s5::s5_item(P, ring, bx, wave); }
                else { PADNOPS(PAD_YA); pg8::gemm_phase<og::EpiBranch<0, 1024>, og::SchedMN, true, 0>(ring, gya, og::SchedMN{64, 4, G - nS, bx - nS}, og::EpiBranch<0, 1024>{&P}, wave); }
            } else {
                for (int it = bx; it < nS; it += G) s5::s5_item(P, ring, it, wave);
                pg8::gemm_phase<og::EpiBranch<0, 1024>, og::SchedMN, true, 0>(ring, gya, og::SchedMN{64, 4, G, bx}, og::EpiBranch<0, 1024>{&P}, wave);
            }
        }
#else
        xcd_barrier(bar, wave);
        for (int it = 8 * bx + wave; it < NB * NGRP * 2; it += 8 * G) nb_s5(P, it, lane);
        xcd_barrier(bar, wave);
        VB2(MR * S5W / 256) nb_s5fin(P, v_, vt);
#endif
    }
    SEAM(3);
    if (IN(4)) {
        PADNOPS(PAD_P3A);
#if OPT_GEMM && OPT_P3
        { const pg8::Gemm g{(const bf16_t*)(P.ws + WS_HS), (const bf16_t*)(P.ws + WS_WGLU), S5W, S5W, S5W};
          for (int rep_ = 0; rep_ < 1 + REP_P3; ++rep_) pg8::gemm_phase<og::EpiGlu, og::SchedMN, true, 0>(ring, g, og::SchedMN{64, 2, G, bx}, og::EpiGlu{&P}, wave);
          if (G > 128) { if (bx >= 128) og::transposes_C(P, ring, (bx - 128) * 8 + wave, (G - 128) * 8, wave, lane); }
          else og::transposes_C(P, ring, bx * 8 + wave, G * 8, wave, lane); }
#else
        VB2((S5W / 64) * (MR / 64)) nb_glu(P, v_ % (S5W / 64), v_ / (S5W / 64), vt, lh);
#endif
    }
    SEAM(4);
    if (IN(5)) {
        PADNOPS(PAD_P3B);
#if OPT_GEMM && OPT_P3
        { const pg8::Gemm g{(const bf16_t*)(P.ws + WS_HS2), (const bf16_t*)(P.ws + WS_WBS), S5W, S5W, S5W};
          pg8::gemm_phase<og::EpiBranch<1, 0>, og::SchedMN, true, 0>(ring, g, og::SchedMN{64, 4, G, bx}, og::EpiBranch<1, 0>{&P}, wave); }
#else
        VB2((DM / 64) * (MR / 64)) nb_ys(P, v_ % (DM / 64), v_ / (DM / 64), vt, lh);
        xcd_barrier(bar, wave);
        VB2((DM / 64) * (MR / 64)) nb_ya(P, v_ % (DM / 64), v_ / (DM / 64), vt, lh);
#endif
    }
    SEAM(5);
    if (IN(6)) {
        PADNOPS(PAD_P3C);
#if OPT_GEMM && OPT_P3
        { const pg8::Gemm g{(const bf16_t*)(P.ws + WS_MB), (const bf16_t*)(P.ws + WS_WOUT), DM, DM, DM};
          pg8::gemm_phase<og::EpiOut, og::SchedMN, true, 0>(ring, g, og::SchedMN{64, 4, G, bx}, og::EpiOut{&P}, wave); }
#else
        VB2((DM / 64) * (MR / 64)) nb_out(P, v_ % (DM / 64), v_ / (DM / 64), vt, lh);
#endif
    }
    SEAM(6);
    if (IN(7)) {
        PADNOPS(PAD_P4);
#if OPT_GEMM && OPT_P4
        { const pg8::Gemm g{(const bf16_t*)(P.ws + WS_X1B), (const bf16_t*)(P.ws + WS_WUP), DM, DM, DM};
          for (int rep_ = 0; rep_ < 1 + REP_P4; ++rep_) pg8::gemm_phase<og::EpiUp, og::SchedUp, true, 2, 1>(ring, g, og::SchedUp{G, bx}, og::EpiUp{&P}, wave); }
#else
        VB2((DFF / 64) * (NB * 67)) nb_up(P, v_ % (DFF / 64), v_ / (DFF / 64), vt, lh);
#endif
    }
    SEAM(7);
    if (IN(8)) {
        PADNOPS(PAD_P5);
#if OPT_GEMM && OPT_P5
        { const pg8::Gemm g{(const bf16_t*)(P.ws + WS_ACT), (const bf16_t*)(P.ws + WS_WDOWN), DFF, DFF, DFF};
          pg8::gemm_phase<og::EpiDown, og::SchedMN, true, 0>(ring, g, og::SchedMN{64, 4, G, bx}, og::EpiDown{&P}, wave); }
#else
        VB2((DM / 64) * (MR / 64)) nb_down(P, v_ % (DM / 64), v_ / (DM / 64), vt, lh);
#endif
    }
#undef IN
#undef SEAM
#undef VB2
}

extern "C" void kernel_launch(void* const* d_in, const int* in_sizes, int n_in, void* d_out, int out_size, void* d_ws, size_t ws_size, hipStream_t stream) {
    static int grid = 0;
    if (grid == 0) {
        if (n_in != 34 || ws_size < WS_END) { fprintf(stderr, "kernel_launch: unexpected inputs (n_in %d, ws %zu)\n", n_in, ws_size); grid = -1; return; }
        int dev = 0, cus = 0, per_cu = 0;
        if (hipGetDevice(&dev) != hipSuccess || hipDeviceGetAttribute(&cus, hipDeviceAttributeMultiprocessorCount, dev) != hipSuccess) { grid = -1; return; }
        if (hipFuncSetAttribute((const void*)mega, hipFuncAttributeMaxDynamicSharedMemorySize, LDS_BYTES) != hipSuccess) { fprintf(stderr, "kernel_launch: hipFuncSetAttribute failed\n"); grid = -1; return; }
        if (hipOccupancyMaxActiveBlocksPerMultiprocessor(&per_cu, (const void*)mega, 512, LDS_BYTES) != hipSuccess || per_cu < 1) { fprintf(stderr, "kernel_launch: occupancy query says %d\n", per_cu); (void)hipGetLastError(); per_cu = 1; }
        grid = cus;
    }
    if (grid < 0) return;
    (void)hipMemsetAsync((char*)d_ws + WS_CTL, 0, 1 * MiB, stream);
    Args a{};
    for (int i = 0; i < 34; ++i) a.P.in[i] = (const float*)d_in[i];
    a.P.out = (float*)d_out; a.P.ws = (unsigned char*)d_ws;
    a.ph_lo = 0; a.ph_hi = 9;
#if USE_COOP_LAUNCH
    void* args[] = {&a};
    hipError_t e = hipLaunchCooperativeKernel((const void*)mega, dim3(grid), dim3(512), args, LDS_BYTES, stream);
    if (e != hipSuccess) fprintf(stderr, "kernel_launch: cooperative launch failed: %s (grid %d)\n", hipGetErrorString(e), grid);
#else
    hipLaunchKernelGGL(mega, dim3(grid), dim3(512), LDS_BYTES, stream, a);
    const hipError_t e = hipPeekAtLastError();
    if (e != hipSuccess) fprintf(stderr, "kernel_launch: launch failed: %s (grid %d)\n", hipGetErrorString(e), grid);
#endif
}
```

```cpp
#include <hip/hip_runtime.h>
#include <cstdint>
#include <cstdio>

constexpr int NB = 4, SEQL = 4096, NCTX = 256, DM = 1024, MR = NB * SEQL, MCX = NB * NCTX, MT = MR + MCX;
constexpr int NHEAD = 8, HDIM = 64, VDIM = 128, S5W = 512, NGRP = 32, NST = 64, DFF = 2816, NIN = 5632;
constexpr int KOFF = 1024, VOFF = 2048, UOFF = 3072, GOFF = 3584;
constexpr int NKEY = NCTX + SEQL, NKT = NKEY / 64, NCH = SEQL / 16 + NCTX / 16;
constexpr float EPSN = 1e-6f, LAM_INIT = 0.2f;
constexpr float C2 = 0.125f * 1.4426950408889634f;

typedef unsigned short bf16_t;
__host__ __device__ __forceinline__ float bf2f(bf16_t v) { union { unsigned u; float f; } x; x.u = ((unsigned)v) << 16; return x.f; }
__host__ __device__ __forceinline__ bf16_t f2bf(float f) { union { unsigned u; float f; } x; x.f = f; return (bf16_t)((x.u + 0x7fffu + ((x.u >> 16) & 1u)) >> 16); }

constexpr size_t MiB = 1u << 20;
#define PAD_ENTRY 15
#define PAD_ATT 12
#define PAD_WIN 11
#define PAD_YA 12
#define PAD_P3A 8
#define PAD_P3B 2
#define PAD_P3C 4
#define PAD_P4 8
#define PAD_P5 12
constexpr size_t WS_CTL = 0;
constexpr size_t WS_MODPART = 1 * MiB;
constexpr size_t WS_MODFIN = 512 * 1024;
constexpr size_t WS_BIASUP = 512 * 1024 + 128 * 1024;
constexpr size_t WS_ROPE = 2 * MiB + 256 * 1024;
constexpr size_t WS_A16 = WS_ROPE + 16384;
constexpr size_t WS_ROWSQ0 = 2 * MiB + 512 * 1024;
constexpr size_t WS_ROWSQ = WS_ROWSQ0 + 256;
constexpr size_t WS_CONVTAB = 4 * MiB;
constexpr size_t WS_BIASPART = 4 * MiB;
constexpr size_t WS_WIN = 6 * MiB;
constexpr size_t WS_WUP = 17 * MiB;
constexpr size_t WS_WDOWN = 28 * MiB;
constexpr size_t WS_WOUT = 34 * MiB;
constexpr size_t WS_WBA = 36 * MiB;
constexpr size_t WS_WBS = 38 * MiB;
constexpr size_t WS_WGLU = 39 * MiB;
constexpr size_t WS_TQ = 40 * MiB;
constexpr size_t WS_PST = 48 * MiB;
constexpr size_t WS_RH = 52 * MiB;
constexpr size_t WS_RQ = 86 * MiB;
constexpr size_t WS_RK = 118 * MiB;
constexpr size_t WS_RV = 152 * MiB;
constexpr size_t WS_RU = 186 * MiB;
constexpr size_t WS_HS = 221 * MiB;
constexpr size_t WS_END = 237 * MiB;
constexpr size_t WS_T = WS_RK;
constexpr size_t WS_MB = WS_RU;
constexpr size_t WS_X1R = WS_RQ;
constexpr size_t WS_X1B = WS_RH + 8192;
constexpr size_t WS_HS2 = WS_RH;
constexpr size_t WS_ACT = WS_RK;
constexpr size_t WS_YTF = WS_RH;
constexpr size_t WS_YTB = WS_RK;

__host__ __device__ __forceinline__ unsigned q_idx(int b, int t, int h, int m, int d) { return (unsigned)((b * SEQL + t) * 1024 + h * 128 + m * 64 + d); }
__host__ __device__ __forceinline__ unsigned k_idx(int b, int h, int m, int key, int d) {
    return (unsigned)((((((b * NHEAD + h) * 2 + m) * NKT + (key >> 6)) * 8 + (d >> 3)) * 64 + (key & 63)) * 8 + (d & 7));
}
__host__ __device__ __forceinline__ unsigned v_idx(int b, int h, int key, int d) {
    const int row = key & 63;
    return (unsigned)(((((b * NHEAD + h) * NKT + (key >> 6)) * 16 + (d >> 5) * 4 + (row >> 4)) * 16 + (row & 15)) * 32 + (d & 31));
}
__host__ __device__ __forceinline__ unsigned u_idx(int b, int g, int chunk, int sig, int c) { return (unsigned)((((b * NGRP + g) * NCH + chunk) * 512) + sig * 16 + c); }

struct Ptrs {
    const float* in[34];
    float* out;
    unsigned char* ws;
};
#define IN_X 0
#define IN_C 1
#define IN_CTX 2
#define IN_CCTX 3
#define IN_ADAW 4
#define IN_ADAB 5
#define IN_N1W 6
#define IN_WIN 7
#define IN_BGATE 8
#define IN_QNW 9
#define IN_KNW 10
#define IN_LQ1 11
#define IN_LK1 12
#define IN_LQ2 13
#define IN_LK2 14
#define IN_SUBLN 15
#define IN_ARE 16
#define IN_AIM 17
#define IN_LOGDT 18
#define IN_BRE 19
#define IN_BIM 20
#define IN_CRE 21
#define IN_CIM 22
#define IN_S5D 23
#define IN_GLUW 24
#define IN_GLUB 25
#define IN_WBS 26
#define IN_WBA 27
#define IN_WOUT 28
#define IN_N2W 29
#define IN_WUP 30
#define IN_CONVW 31
#define IN_CONVB 32
#define IN_WDOWN 33

template <int CTRL> __device__ __forceinline__ float dppmov(float x) { return __builtin_bit_cast(float, __builtin_amdgcn_mov_dpp(__builtin_bit_cast(int, x), CTRL, 0xf, 0xf, true)); }
__device__ __forceinline__ float row16_sum(float v) {
    v += dppmov<0xB1>(v); v += dppmov<0x4E>(v); v += dppmov<0x141>(v); v += dppmov<0x140>(v); return v; }
__device__ __forceinline__ float row16_max(float v) {
    v = fmaxf(v, dppmov<0xB1>(v)); v = fmaxf(v, dppmov<0x4E>(v)); v = fmaxf(v, dppmov<0x141>(v)); v = fmaxf(v, dppmov<0x140>(v)); return v; }
__device__ __forceinline__ float xor16_sum(float x) {
    const auto s = __builtin_amdgcn_permlane16_swap(__float_as_uint(x), __float_as_uint(x), false, false); return __uint_as_float(s[0]) + __uint_as_float(s[1]); }
__device__ __forceinline__ float xor32_sum(float x) {
    const auto s = __builtin_amdgcn_permlane32_swap(__float_as_uint(x), __float_as_uint(x), false, false); return __uint_as_float(s[0]) + __uint_as_float(s[1]); }
__device__ __forceinline__ float xor16_max(float x) { const auto s = __builtin_amdgcn_permlane16_swap(__float_as_uint(x), __float_as_uint(x), false, false); return fmaxf(__uint_as_float(s[0]), __uint_as_float(s[1])); }
__device__ __forceinline__ float xor32_max(float x) { const auto s = __builtin_amdgcn_permlane32_swap(__float_as_uint(x), __float_as_uint(x), false, false); return fmaxf(__uint_as_float(s[0]), __uint_as_float(s[1])); }
__device__ __forceinline__ float wave_sum(float v) { return xor32_sum(xor16_sum(row16_sum(v))); }
__device__ __forceinline__ float wave_max(float v) { return xor32_max(xor16_max(row16_max(v))); }
__device__ __forceinline__ float sigmoidf_(float x) { return 1.f / (1.f + __expf(-x)); }
__device__ __forceinline__ float siluf_(float x) { return x / (1.f + __expf(-x)); }
__device__ __forceinline__ float gelu_tanh(float x) { const float u = 0.7978845608028654f * (x + 0.044715f * x * x * x); return 0.5f * x * (1.f + tanhf(u)); }

#define LAS __attribute__((address_space(3)))
__device__ __forceinline__ int lane_id() { return (int)__builtin_amdgcn_mbcnt_hi(~0u, __builtin_amdgcn_mbcnt_lo(~0u, 0u)); }
constexpr int NB_AS = 0, NB_WS = 4160, NB_Z = 8256, NB_Z2 = 24896, NB_LDS = 41536;

__device__ void nb_mod(const Ptrs& P, int vbx, int vby, int vt) {
    const int col = vbx * 256 + vt, row = vby;
    const float* cv = row < 4 ? P.in[IN_C] + row * DM : P.in[IN_CCTX];
    const float* W = P.in[IN_ADAW];
    float acc = 0.f;
    for (int k = 0; k < DM; ++k) acc += siluf_(cv[k]) * W[(size_t)k * 6144 + col];
    ((float*)(P.ws + WS_MODFIN))[row * 6144 + col] = acc + P.in[IN_ADAB][col];
}
__device__ void nb_biasup(const Ptrs& P, int vbx, int vby, int vt) {
    const int n = vbx * 256 + vt, b = vby;
    const float* sh2 = (const float*)(P.ws + WS_MODFIN) + b * 6144 + 3072;
    const float* W = P.in[IN_WUP];
    float acc = 0.f;
    for (int k = 0; k < DM; ++k) acc += sh2[k] * W[(size_t)k * NIN + n];
    ((float*)(P.ws + WS_BIASUP))[b * NIN + n] = acc;
}
__device__ void nb_rope(const Ptrs& P, int vbx, int vt) {
    const int i = vbx * 256 + vt;
    const int pos = i >> 4, f = i & 15;
    const float inv = powf(10000.f, -(float)(2 * f) / 32.f);
    const float ang = (float)pos * inv;
    float* tab = (float*)(P.ws + WS_ROPE);
    tab[2 * i] = cosf(ang); tab[2 * i + 1] = sinf(ang);
}
__device__ void nb_modulate(const Ptrs& P, int vbx, int vt) {
    const int r = vbx * 4 + (vt >> 6), lane = vt & 63;
    const float* xr = r < MR ? P.in[IN_X] + (size_t)r * DM : P.in[IN_CTX] + (size_t)(r - MR) * DM;
    const float* mod = (const float*)(P.ws + WS_MODFIN) + (r < MR ? r / SEQL : 4) * 6144;
    const float* w = P.in[IN_N1W];
    float v[16]; float ss = 0.f;
#pragma unroll
    for (int j = 0; j < 16; ++j) { v[j] = xr[lane + 64 * j]; ss += v[j] * v[j]; }
    const float rstd = rsqrtf(wave_sum(ss) * (1.f / DM) + EPSN);
    bf16_t* H = (bf16_t*)(P.ws + WS_RH) + (size_t)r * DM;
#pragma unroll
    for (int j = 0; j < 16; ++j) { const int k = lane + 64 * j; H[k] = f2bf(v[j] * rstd * w[k] * (1.f + mod[1024 + k]) + mod[k]); }
}
__device__ void ntile(const bf16_t* A, int lda, long row0, long rowmax, const float* W, int ldw, int col0, int K, char* lh, int zoff, int tid) {
    float (*As)[65] = (float (*)[65])(lh + NB_AS);
    float (*Ws)[64] = (float (*)[64])(lh + NB_WS);
    float (*Z)[65] = (float (*)[65])(lh + zoff);
    const int tx = tid & 15, ty = tid >> 4;
    float acc[4][4];
#pragma unroll
    for (int i = 0; i < 4; ++i)
#pragma unroll
        for (int j = 0; j < 4; ++j) acc[i][j] = 0.f;
    for (int k0 = 0; k0 < K; k0 += 16) {
        {
            const int ar = tid >> 2, ak = (tid & 3) * 4;
            long gr = row0 + ar; gr = gr < 0 ? 0 : (gr > rowmax ? rowmax : gr);
            const bf16_t* ap = A + (size_t)gr * lda + k0 + ak;
#pragma unroll
            for (int q = 0; q < 4; ++q) As[ak + q][ar] = bf2f(ap[q]);
            const int wk = tid >> 4, wc = (tid & 15) * 4;
            const float4 wv = *(const float4*)(W + (size_t)(k0 + wk) * ldw + col0 + wc);
            Ws[wk][wc] = wv.x; Ws[wk][wc + 1] = wv.y; Ws[wk][wc + 2] = wv.z; Ws[wk][wc + 3] = wv.w;
        }
        __syncthreads();
#pragma unroll
        for (int kk = 0; kk < 16; ++kk) {
            float a[4], w[4];
#pragma unroll
            for (int i = 0; i < 4; ++i) a[i] = As[kk][ty * 4 + i];
#pragma unroll
            for (int j = 0; j < 4; ++j) w[j] = Ws[kk][tx * 4 + j];
#pragma unroll
            for (int i = 0; i < 4; ++i)
#pragma unroll
                for (int j = 0; j < 4; ++j) acc[i][j] += a[i] * w[j];
        }
        __syncthreads();
    }
#pragma unroll
    for (int i = 0; i < 4; ++i)
#pragma unroll
        for (int j = 0; j < 4; ++j) Z[ty * 4 + i][tx * 4 + j] = acc[i][j];
    __syncthreads();
}
__device__ void nb_inproj(const Ptrs& P, int vbx, int vby, int tid, char* lh) {
    float (*Z)[65] = (float (*)[65])(lh + NB_Z);
    const int c0 = vbx * 64; const long r0 = (long)vby * 64;
    ntile((const bf16_t*)(P.ws + WS_RH), DM, r0, MT - 1, P.in[IN_WIN], NIN, c0, DM, lh, NB_Z, tid);
    const int lr = tid >> 2, j0 = (tid & 3) * 16;
    const int r = (int)r0 + lr;
    const bool isctx = r >= MR;
    const int b = isctx ? (r - MR) / NCTX : r / SEQL, t = isctx ? (r - MR) % NCTX : r % SEQL;
    const int key = isctx ? t : NCTX + t, chunk = isctx ? 256 + (t >> 4) : (t >> 4), sig = t & 15;
    const float* zr = Z[lr];
    if (c0 < VOFF) {
        const bool isq = c0 < KOFF;
        if (!(isq && isctx)) {
            const float* w = isq ? P.in[IN_QNW] : P.in[IN_KNW];
            float ss = 0.f;
            for (int j = 0; j < 64; ++j) ss += zr[j] * zr[j];
            const float rs = rsqrtf(ss * (1.f / 64.f) + EPSN);
            const int cc = isq ? c0 : c0 - KOFF, h = cc / 128, m = (cc / 64) & 1;
            const float* tab = (const float*)(P.ws + WS_ROPE);
            for (int d = j0; d < j0 + 16; ++d) {
                float val = zr[d] * rs * w[d];
                if (!isctx) {
                    const int half = d >> 5, dd = d & 31, i = dd & 15, second = dd >> 4;
                    const int pd = second ? d - 16 : d + 16;
                    const float pv = zr[pd] * rs * w[pd];
                    const int pos = half == 0 ? (t >> 6) : (t & 63);
                    const float cs = tab[(pos * 16 + i) * 2], sn = tab[(pos * 16 + i) * 2 + 1];
                    val = second ? (val * cs + pv * sn) : (val * cs - pv * sn);
                }
                if (isq) ((bf16_t*)(P.ws + WS_RQ))[q_idx(b, t, h, m, d)] = f2bf(val * C2);
                else ((bf16_t*)(P.ws + WS_RK))[k_idx(b, h, m, key, d)] = f2bf(val);
            }
        }
    } else if (c0 < UOFF) {
        const int cc = c0 - VOFF, h = cc / 128, dbase = cc % 128;
        for (int j = j0; j < j0 + 16; ++j) ((bf16_t*)(P.ws + WS_RV))[v_idx(b, h, key, dbase + j)] = f2bf(zr[j]);
    } else if (c0 < GOFF) {
        for (int j = j0; j < j0 + 16; ++j) { const int cc = c0 - UOFF + j; ((bf16_t*)(P.ws + WS_RU))[u_idx(b, cc >> 4, chunk, sig, cc & 15)] = f2bf(zr[j]); }
    } else if (!isctx) {
        bf16_t* G = (bf16_t*)P.out;
        for (int j = j0; j < j0 + 16; ++j) { const int cc = c0 - GOFF + j; G[(size_t)r * 2048 + cc] = f2bf(sigmoidf_(zr[j] + P.in[IN_BGATE][cc])); }
    }
    __syncthreads();
}
__device__ void nb_attn(const Ptrs& P, int item, int lane, char* lw) {
    float* p0 = (float*)lw; float* p1 = p0 + NKEY; float* qs = p1 + NKEY;
    const int b = item / (NHEAD * SEQL), h = (item / SEQL) % NHEAD, t = item % SEQL;
    bf16_t* Q = (bf16_t*)(P.ws + WS_RQ); const bf16_t* K = (const bf16_t*)(P.ws + WS_RK); const bf16_t* V = (const bf16_t*)(P.ws + WS_RV);
    qs[lane] = bf2f(Q[q_idx(b, t, h, 0, lane)]); qs[64 + lane] = bf2f(Q[q_idx(b, t, h, 1, lane)]);
    const float lam = __expf(wave_sum(P.in[IN_LQ1][lane] * P.in[IN_LK1][lane])) - __expf(wave_sum(P.in[IN_LQ2][lane] * P.in[IN_LK2][lane])) + LAM_INIT;
    const float mshift = 8.f * 1.4426950408889634f * wave_max(fabsf(P.in[IN_QNW][lane])) * wave_max(fabsf(P.in[IN_KNW][lane]));
    __builtin_amdgcn_s_waitcnt(0xc07f); __builtin_amdgcn_wave_barrier();
    float l0 = 0.f, l1 = 0.f;
    for (int i = 0; i < NKT; ++i) {
        const int key = i * 64 + lane;
#pragma unroll
        for (int m = 0; m < 2; ++m) {
            float s = 0.f;
#pragma unroll
            for (int ch = 0; ch < 8; ++ch) {
                const uint4 kv = *(const uint4*)(K + k_idx(b, h, m, key, ch * 8));
                const unsigned w[4] = {kv.x, kv.y, kv.z, kv.w};
#pragma unroll
                for (int e = 0; e < 4; ++e) { s += qs[m * 64 + ch * 8 + 2 * e] * bf2f((bf16_t)(w[e] & 0xffff)) + qs[m * 64 + ch * 8 + 2 * e + 1] * bf2f((bf16_t)(w[e] >> 16)); }
            }
            const float p = exp2f(s - mshift);
            if (m == 0) { p0[key] = p; l0 += p; } else { p1[key] = p; l1 += p; }
        }
    }
    l0 = wave_sum(l0); l1 = wave_sum(l1);
    __builtin_amdgcn_s_waitcnt(0xc07f); __builtin_amdgcn_wave_barrier();
    const float i0 = 1.f / l0, i1 = lam / l1;
    float o0 = 0.f, o1 = 0.f;
    for (int key = 0; key < NKEY; ++key) {
        const float a = p0[key] * i0 - p1[key] * i1;
        o0 += a * bf2f(V[v_idx(b, h, key, lane)]); o1 += a * bf2f(V[v_idx(b, h, key, lane + 64)]);
    }
    const float rs = rsqrtf(wave_sum(o0 * o0 + o1 * o1) * (1.f / 128.f) + EPSN) * (1.f - LAM_INIT);
    bf16_t* On = Q;
    const size_t ob = ((size_t)(b * SEQL + t)) * 1024 + h * 128;
    On[ob + lane] = f2bf(o0 * rs * P.in[IN_SUBLN][lane]); On[ob + 64 + lane] = f2bf(o1 * rs * P.in[IN_SUBLN][64 + lane]);
    __builtin_amdgcn_s_waitcnt(0xc07f); __builtin_amdgcn_wave_barrier();
}
__device__ void nb_s5(const Ptrs& P, int item, int p) {
    const int d = item & 1, bg = item >> 1, b = bg / NGRP, g = bg % NGRP;
    const int gi = (d * NGRP + g) * NST + p;
    const float lre = fminf(P.in[IN_ARE][gi], -1e-4f), lim = P.in[IN_AIM][gi], dt = __expf(P.in[IN_LOGDT][d * NGRP + g]);
    const float mag = __expf(lre * dt); float sn, cs; sincosf(lim * dt, &sn, &cs);
    const float ar = mag * cs, ai = mag * sn;
    const float nr = ar - 1.f, ni = ai, den = lre * lre + lim * lim;
    const float fr = (nr * lre + ni * lim) / den, fi = (ni * lre - nr * lim) / den;
    float bre[16], bim[16], cre[16], cim[16];
#pragma unroll
    for (int c = 0; c < 16; ++c) {
        const float br = P.in[IN_BRE][(size_t)gi * 16 + c], bi = P.in[IN_BIM][(size_t)gi * 16 + c];
        bre[c] = fr * br - fi * bi; bim[c] = fr * bi + fi * br;
        cre[c] = P.in[IN_CRE][((size_t)(d * NGRP + g) * 16 + c) * NST + p]; cim[c] = P.in[IN_CIM][((size_t)(d * NGRP + g) * 16 + c) * NST + p];
    }
    const bf16_t* U = (const bf16_t*)(P.ws + WS_RU);
    float* yt = (float*)(P.ws + (d == 0 ? WS_YTF : WS_YTB)) + (size_t)(b * NGRP + g) * SEQL * 16;
    float sr = 0.f, si = 0.f;
    for (int step = 0; step < NKEY; ++step) {
        const bool isctx = step < NCTX;
        const int idx = isctx ? step : step - NCTX;
        const int t = d == 0 ? idx : (isctx ? NCTX - 1 - idx : SEQL - 1 - idx);
        const int chunk = isctx ? 256 + (t >> 4) : (t >> 4);
        const bf16_t* up = U + u_idx(b, g, chunk, t & 15, 0);
        float bur = 0.f, bui = 0.f;
#pragma unroll
        for (int c = 0; c < 16; ++c) { const float u = bf2f(up[c]); bur += bre[c] * u; bui += bim[c] * u; }
        const float nsr = ar * sr - ai * si + bur, nsi = ar * si + ai * sr + bui;
        sr = nsr; si = nsi;
        if (!isctx) {
            float mine = 0.f;
#pragma unroll
            for (int c = 0; c < 16; ++c) { const float v = wave_sum(cre[c] * sr - cim[c] * si); if (p == c) mine = v; }
            if (p < 16) yt[(size_t)t * 16 + p] = mine;
        }
    }
}
__device__ void nb_s5fin(const Ptrs& P, int vbx, int vt) {
    const size_t i = (size_t)vbx * 256 + vt;
    const int ch = (int)(i % 512); const size_t bt = i / 512; const int b = (int)(bt / SEQL), t = (int)(bt % SEQL), g = ch >> 4, c = ch & 15;
    const float u = bf2f(((const bf16_t*)(P.ws + WS_RU))[u_idx(b, g, t >> 4, t & 15, c)]);
    const size_t yi = ((size_t)(b * NGRP + g) * SEQL + t) * 16 + c;
    const float y = P.in[IN_S5D][ch] * u + ((const float*)(P.ws + WS_YTF))[yi] + ((const float*)(P.ws + WS_YTB))[yi];
    ((bf16_t*)(P.ws + WS_HS))[i] = f2bf(gelu_tanh(y));
}
__device__ void nb_glu(const Ptrs& P, int vbx, int vby, int tid, char* lh) {
    float (*Z)[65] = (float (*)[65])(lh + NB_Z);
    const int c0 = vbx * 64; const long r0 = (long)vby * 64;
    const bf16_t* Hs = (const bf16_t*)(P.ws + WS_HS);
    ntile(Hs, S5W, r0, MR - 1, P.in[IN_GLUW], S5W, c0, S5W, lh, NB_Z, tid);
    const int lr = tid >> 2, j0 = (tid & 3) * 16; const size_t r = r0 + lr;
    for (int j = j0; j < j0 + 16; ++j) { const int c = c0 + j; ((bf16_t*)(P.ws + WS_HS2))[r * S5W + c] = f2bf(bf2f(Hs[r * S5W + c]) * sigmoidf_(Z[lr][j] + P.in[IN_GLUB][c])); }
    __syncthreads();
}
__device__ void nb_ys(const Ptrs& P, int vbx, int vby, int tid, char* lh) {
    float (*Z)[65] = (float (*)[65])(lh + NB_Z);
    const int c0 = vbx * 64; const long r0 = (long)vby * 64;
    ntile((const bf16_t*)(P.ws + WS_HS2), S5W, r0, MR - 1, P.in[IN_WBS], DM, c0, S5W, lh, NB_Z, tid);
    const int lr = tid >> 2, j0 = (tid & 3) * 16; const size_t r = r0 + lr;
    const bf16_t* G = (const bf16_t*)P.out;
    for (int j = j0; j < j0 + 16; ++j) { const int c = c0 + j; ((float*)(P.ws + WS_T))[r * DM + c] = bf2f(G[r * 2048 + c]) * Z[lr][j]; }
    __syncthreads();
}
__device__ void nb_ya(const Ptrs& P, int vbx, int vby, int tid, char* lh) {
    float (*Z)[65] = (float (*)[65])(lh + NB_Z);
    const int c0 = vbx * 64; const long r0 = (long)vby * 64;
    ntile((const bf16_t*)(P.ws + WS_RQ), DM, r0, MR - 1, P.in[IN_WBA], DM, c0, DM, lh, NB_Z, tid);
    const int lr = tid >> 2, j0 = (tid & 3) * 16; const size_t r = r0 + lr;
    const bf16_t* G = (const bf16_t*)P.out;
    for (int j = j0; j < j0 + 16; ++j) { const int c = c0 + j; ((bf16_t*)(P.ws + WS_MB))[r * DM + c] = f2bf(((const float*)(P.ws + WS_T))[r * DM + c] + bf2f(G[r * 2048 + 1024 + c]) * Z[lr][j]); }
    __syncthreads();
}
__device__ void nb_out(const Ptrs& P, int vbx, int vby, int tid, char* lh) {
    float (*Z)[65] = (float (*)[65])(lh + NB_Z);
    const int c0 = vbx * 64; const long r0 = (long)vby * 64;
    ntile((const bf16_t*)(P.ws + WS_MB), DM, r0, MR - 1, P.in[IN_WOUT], DM, c0, DM, lh, NB_Z, tid);
    const int lr = tid >> 2, j0 = (tid & 3) * 16; const size_t r = r0 + lr; const int b = (int)(r / SEQL);
    const float* mod = (const float*)(P.ws + WS_MODFIN) + b * 6144;
    float ss = 0.f;
    for (int j = j0; j < j0 + 16; ++j) {
        const int c = c0 + j;
        const float x1 = P.in[IN_X][r * DM + c] + mod[2048 + c] * Z[lr][j];
        P.out[r * DM + c] = x1;
        ((bf16_t*)(P.ws + WS_X1B))[r * DM + c] = f2bf(x1 * P.in[IN_N2W][c] * (1.f + mod[4096 + c]));
        ss += x1 * x1;
    }
    ss += __shfl_xor(ss, 1); ss += __shfl_xor(ss, 2);
    if ((tid & 3) == 0) atomicAdd((float*)(P.ws + WS_ROWSQ) + r, ss);
    __syncthreads();
}
__device__ void nb_up(const Ptrs& P, int vbx, int vby, int tid, char* lh) {
    float (*Za)[65] = (float (*)[65])(lh + NB_Z);
    float (*Zg)[65] = (float (*)[65])(lh + NB_Z2);
    const int c0 = vbx * 64;
    const int b = vby / 67, ti = vby % 67;
    const long r0 = (long)b * SEQL + 62 * ti - 1;
    const bf16_t* A = (const bf16_t*)(P.ws + WS_X1B);
    ntile(A, DM, r0, MR - 1, P.in[IN_WUP], NIN, c0, DM, lh, NB_Z, tid);
    ntile(A, DM, r0, MR - 1, P.in[IN_WUP], NIN, DFF + c0, DM, lh, NB_Z2, tid);
    const int lr = tid >> 2, j0 = (tid & 3) * 16;
    {
        const int tok = 62 * ti + lr - 1; const bool valid = tok >= 0 && tok < SEQL;
        float rstd = 0.f;
        if (valid) { const size_t r = (size_t)b * SEQL + tok; rstd = rsqrtf(((const float*)(P.ws + WS_ROWSQ))[r] * (1.f / DM) + EPSN); }
        const float* bu = (const float*)(P.ws + WS_BIASUP) + b * NIN;
        for (int j = j0; j < j0 + 16; ++j) { Za[lr][j] = valid ? rstd * Za[lr][j] + bu[c0 + j] : 0.f; Zg[lr][j] = valid ? rstd * Zg[lr][j] + bu[DFF + c0 + j] : 0.f; }
    }
    __syncthreads();
    const int tok = 62 * ti + lr - 1;
    if (lr >= 1 && lr <= 62 && tok < SEQL) {
        const float* cw = P.in[IN_CONVW]; const float* cb = P.in[IN_CONVB];
        const size_t r = (size_t)b * SEQL + tok;
        for (int j = j0; j < j0 + 16; ++j) {
            const int ca = c0 + j, cg = DFF + c0 + j;
            const float ya = cb[ca] + cw[ca] * Za[lr - 1][j] + cw[NIN + ca] * Za[lr][j] + cw[2 * NIN + ca] * Za[lr + 1][j];
            const float yg = cb[cg] + cw[cg] * Zg[lr - 1][j] + cw[NIN + cg] * Zg[lr][j] + cw[2 * NIN + cg] * Zg[lr + 1][j];
            ((bf16_t*)(P.ws + WS_ACT))[r * DFF + ca] = f2bf(siluf_(yg) * ya);
        }
    }
    __syncthreads();
}
__device__ void nb_down(const Ptrs& P, int vbx, int vby, int tid, char* lh) {
    float (*Z)[65] = (float (*)[65])(lh + NB_Z);
    const int c0 = vbx * 64; const long r0 = (long)vby * 64;
    ntile((const bf16_t*)(P.ws + WS_ACT), DFF, r0, MR - 1, P.in[IN_WDOWN], DM, c0, DFF, lh, NB_Z, tid);
    const int lr = tid >> 2, j0 = (tid & 3) * 16; const size_t r = r0 + lr; const int b = (int)(r / SEQL);
    const float* mod = (const float*)(P.ws + WS_MODFIN) + b * 6144;
    for (int j = j0; j < j0 + 16; ++j) { const int c = c0 + j; P.out[r * DM + c] = P.out[r * DM + c] + mod[5120 + c] * Z[lr][j]; }
    __syncthreads();
}
namespace pg8 {
typedef short bf16x8 __attribute__((ext_vector_type(8)));
typedef float f32x4 __attribute__((ext_vector_type(4)));
typedef unsigned u32x4 __attribute__((ext_vector_type(4)));
typedef unsigned u32x2 __attribute__((ext_vector_type(2)));
constexpr int BM = 256, BK = 64, HALF = 128, HTB = HALF * BK * 2, STAGE_BYTES = 8 * HTB;
__host__ __device__ __forceinline__ int lds_byte(int r, int c) { const int st = (r >> 4) * 2 + (c >> 5), rr = r & 15, cc = c & 31, ob = rr * 64 + cc * 2; return st * 1024 + (ob ^ (((ob >> 9) & 1) << 5)); }
__host__ __device__ __forceinline__ void stage_rc(int b, int& R, int& C) { const int st = b / 1024, sb = b % 1024, swz = sb ^ (((sb >> 9) & 1) << 5); R = (st >> 1) * 16 + swz / 64; C = (st & 1) * 32 + (swz % 64) / 2; }
__host__ __device__ __forceinline__ int perm32(int rho) { const int n = rho >> 4, i = rho & 15; return 8 * (i >> 2) + 4 * n + (i & 3); }
struct Unit { int arow, brow, pm, pn; };
struct Gemm { const bf16_t* A; const bf16_t* Bt; int K, lda, ldb; };
typedef float f32x2c __attribute__((ext_vector_type(2))); typedef __bf16 bf16x2c __attribute__((ext_vector_type(2)));
__device__ __forceinline__ unsigned cvt_pk_bf16(float lo, float hi) { const f32x2c v = {lo, hi}; const bf16x2c b = __builtin_convertvector(v, bf16x2c); return __builtin_bit_cast(unsigned, b); }

template <class Epi, class Sched, bool ALIGN_EPI, int SHR, int APERM = 0>
__device__ __forceinline__ void gemm_phase(LAS unsigned char* lds, const Gemm g, const Sched& S, const Epi& E, int wave) {
    int tid_ = wave * 64 + lane_id(); asm volatile("" : "+v"(tid_));
    const int tid = tid_, wid = __builtin_amdgcn_readfirstlane(tid >> 6), lane = tid & 63, wr = wid >> 2, wc = wid & 3, fr = lane & 15, fq = lane >> 4;
    int nt_ = g.K / BK; asm volatile("" : "+s"(nt_)); const int nt = nt_;
    unsigned voffA[2], voffB[2];
#pragma unroll
    for (int i = 0; i < 2; ++i) { int R, C; stage_rc(tid * 16 + i * 8192, R, C); const int Rb = Epi::PERM ? ((R & ~31) + perm32(R & 31)) : R;
        const int Ra = APERM ? (R & ~63) + 4 * (R & 15) + ((R >> 4) & 3) : R;
        voffA[i] = (unsigned)((Ra - SHR * (R >> 6)) * g.lda + C) * 2u; voffB[i] = (unsigned)(Rb * g.ldb + C) * 2u; }
    const size_t kstep = (size_t)(BK * 2);
    const size_t hA = (size_t)(HALF - 2 * SHR) * g.lda * 2, hB = (size_t)HALF * g.ldb * 2;
    const unsigned ldsw = (unsigned)wid * 1024u;
    const int aoff = lds_byte(wr * 64 + fr, fq * 8), boff = lds_byte(wc * 32 + fr, fq * 8);
#define PG8_SA(b, h) (((b) * 2 + (h)) * HTB)
#define PG8_SB(b, h) ((4 + (b) * 2 + (h)) * HTB)
#define PG8_STAGE(bufoff, gbase, voff) do { _Pragma("unroll") for (int _i = 0; _i < 2; ++_i) \
        __builtin_amdgcn_global_load_lds((const unsigned*)((const char*)(gbase) + (voff)[_i]), (LAS unsigned*)(lds + (bufoff) + ldsw + _i * 8192), 16, 0, 0); } while (0)
#define PG8_LDA(dst, b, h) do { _Pragma("unroll") for (int m = 0; m < 4; ++m) _Pragma("unroll") for (int k = 0; k < 2; ++k) dst[m][k] = *(const LAS bf16x8*)(lds + PG8_SA(b, h) + aoff + m * 2048 + k * 1024); } while (0)
#define PG8_LDB(dst, b, h) do { _Pragma("unroll") for (int n = 0; n < 2; ++n) _Pragma("unroll") for (int k = 0; k < 2; ++k) dst[n][k] = *(const LAS bf16x8*)(lds + PG8_SB(b, h) + boff + n * 2048 + k * 1024); } while (0)
#define PG8_MMA(ai, bj, At, Bt) do { __builtin_amdgcn_s_setprio(1); _Pragma("unroll") for (int m = 0; m < 4; ++m) _Pragma("unroll") for (int n = 0; n < 2; ++n) _Pragma("unroll") for (int k = 0; k < 2; ++k) \
        acc[ai][bj][m][n] = __builtin_amdgcn_mfma_f32_16x16x32_bf16(Bt[n][k], At[m][k], acc[ai][bj][m][n], 0, 0, 0); __builtin_amdgcn_s_setprio(0); } while (0)
#define PG8_WAIT_V(n) asm volatile("s_waitcnt vmcnt(" #n ")" ::: "memory")
#define PG8_WAIT_L(n) asm volatile("s_waitcnt lgkmcnt(" #n ")" ::: "memory")
#define PG8_BAR __builtin_amdgcn_s_barrier()
#define PG8_SCHED __builtin_amdgcn_sched_barrier(0)
    Unit cur, nxt; int ui = 0;
    if (!S.next(0, cur)) return;
    f32x4 acc[2][2][4][2];
#pragma unroll
    for (int a = 0; a < 2; ++a)
#pragma unroll
        for (int b = 0; b < 2; ++b)
#pragma unroll
            for (int m = 0; m < 4; ++m)
#pragma unroll
                for (int n = 0; n < 2; ++n) acc[a][b][m][n] = (f32x4){0.f, 0.f, 0.f, 0.f};
    bf16x8 At[4][2], B0[2][2], B1[2][2];
    const char* cA = (const char*)g.A + (long)cur.arow * g.lda * 2; const char* cB = (const char*)g.Bt + (long)cur.brow * g.ldb * 2;
    PG8_STAGE(PG8_SB(0, 0), cB, voffB); PG8_STAGE(PG8_SB(0, 1), cB + hB, voffB); PG8_STAGE(PG8_SA(0, 0), cA, voffA); PG8_STAGE(PG8_SA(0, 1), cA + hA, voffA);
    if (wr == 1) PG8_BAR;
    PG8_WAIT_V(2); PG8_BAR;
    PG8_STAGE(PG8_SB(1, 0), cB + kstep, voffB); PG8_STAGE(PG8_SA(1, 0), cA + kstep, voffA); PG8_STAGE(PG8_SB(1, 1), cB + hB + kstep, voffB);
    PG8_WAIT_V(6); PG8_BAR;
    for (;;) {
        const bool has_next = S.next(ui + 1, nxt);
        const char* nA = has_next ? (const char*)g.A + (long)nxt.arow * g.lda * 2 : cA; const char* nB = has_next ? (const char*)g.Bt + (long)nxt.brow * g.ldb * 2 : cB;
#pragma unroll 1
        for (int t = 0; t < nt; t += 2) {
            asm volatile("" : "+v"(voffA[0]), "+v"(voffA[1]), "+v"(voffB[0]), "+v"(voffB[1]));
            const bool last = (t == nt - 2);
            const char* a1 = cA + (size_t)(t + 1) * kstep;
            const char* a2 = last ? nA : cA + (size_t)(t + 2) * kstep; const char* b2 = last ? nB : cB + (size_t)(t + 2) * kstep;
            const char* a3 = a2 + kstep; const char* b3 = b2 + kstep;
            asm volatile("" : "+s"(a3), "+s"(b3));
            PG8_LDB(B0, 0, 0); PG8_LDB(B1, 0, 1); PG8_SCHED; PG8_LDA(At, 0, 0); PG8_STAGE(PG8_SA(1, 1), a1 + hA, voffA);
            PG8_WAIT_V(8); PG8_WAIT_L(0); PG8_BAR; PG8_MMA(0, 0, At, B0); PG8_MMA(0, 1, At, B1); PG8_BAR; PG8_SCHED;
            PG8_LDA(At, 0, 1); PG8_STAGE(PG8_SB(0, 0), b2, voffB); PG8_STAGE(PG8_SB(0, 1), b2 + hB, voffB); PG8_STAGE(PG8_SA(0, 0), a2, voffA);
            PG8_WAIT_V(8); PG8_WAIT_L(0); PG8_BAR; PG8_MMA(1, 0, At, B0); PG8_MMA(1, 1, At, B1); PG8_BAR; PG8_SCHED;
            PG8_LDB(B0, 1, 0); PG8_LDB(B1, 1, 1); PG8_SCHED; PG8_LDA(At, 1, 0); PG8_STAGE(PG8_SA(0, 1), a2 + hA, voffA);
            PG8_WAIT_V(8); PG8_WAIT_L(0); PG8_BAR; PG8_MMA(0, 0, At, B0); PG8_MMA(0, 1, At, B1); PG8_BAR; PG8_SCHED;
            PG8_LDA(At, 1, 1); PG8_STAGE(PG8_SB(1, 0), b3, voffB); PG8_STAGE(PG8_SB(1, 1), b3 + hB, voffB); PG8_STAGE(PG8_SA(1, 0), a3, voffA);
            PG8_WAIT_V(8); PG8_WAIT_L(0); PG8_BAR; PG8_MMA(1, 0, At, B0); PG8_MMA(1, 1, At, B1); PG8_BAR; PG8_SCHED;
        }
        if constexpr (ALIGN_EPI) { if (wr == 0) PG8_BAR; }
        { int fr_ = fr, fq_ = fq, wr_ = wr, wc_ = wc; asm volatile("" : "+v"(fr_), "+v"(fq_), "+s"(wr_), "+s"(wc_));
          E(acc, cur, wr_, wc_, fr_, fq_); }
        if (!has_next) break;
#pragma unroll
        for (int a = 0; a < 2; ++a)
#pragma unroll
            for (int b = 0; b < 2; ++b)
#pragma unroll
                for (int m = 0; m < 4; ++m)
#pragma unroll
                    for (int n = 0; n < 2; ++n) acc[a][b][m][n] = (f32x4){0.f, 0.f, 0.f, 0.f};
        cur = nxt; cA = nA; cB = nB; ++ui;
        if constexpr (ALIGN_EPI) { if (wr == 1) PG8_BAR; }
    }
    PG8_WAIT_V(0);
    if constexpr (!ALIGN_EPI) { if (wr == 0) PG8_BAR; }
    PG8_BAR;
#undef PG8_SA
#undef PG8_SB
#undef PG8_STAGE
#undef PG8_LDA
#undef PG8_LDB
#undef PG8_MMA
#undef PG8_WAIT_V
#undef PG8_WAIT_L
#undef PG8_BAR
#undef PG8_SCHED
}
}
namespace og {
using pg8::Unit; using pg8::f32x4; using pg8::u32x4; using pg8::u32x2; using pg8::cvt_pk_bf16;
__device__ __forceinline__ void grid2d(int L, int nM, int nN, int& pm, int& pn) {
    const int nwg = nM * nN; int wgid = L;
    { const int q = nwg / 8, r = nwg % 8, xcd = wgid % 8, off = wgid / 8; wgid = (xcd < r ? xcd * (q + 1) : r * (q + 1) + (xcd - r) * q) + off; }
    const int nig = 8 * nN, gid = wgid / nig, fm = gid * 8, gsz = (nM - fm) < 8 ? (nM - fm) : 8;
    pm = fm + ((wgid % nig) % gsz); pn = (wgid % nig) / gsz;
}
struct SchedMN { int nM, nN, G, c;
    __device__ __forceinline__ bool next(int i, Unit& u) const { const int L = i * G + c; if (L >= nM * nN) return false; grid2d(L, nM, nN, u.pm, u.pn); u.arow = 256 * u.pm; u.brow = 256 * u.pn; return true; } };
struct SchedIn { int G, c;
    __device__ __forceinline__ bool next(int i, Unit& u) const { const int L = i * G + c;
        if (L < 1408) { grid2d(L, 64, 22, u.pm, u.pn); } else if (L < 1448) { const int lc = L - 1408; u.pm = 64 + lc / 10; u.pn = 4 + lc % 10; } else return false;
        u.arow = 256 * u.pm; u.brow = 256 * u.pn; return true; } };
struct SchedUp { int G, c;
    __device__ __forceinline__ bool next(int i, Unit& u) const { const int L = i * G + c; if (L >= 68 * 22) return false; grid2d(L, 68, 22, u.pm, u.pn);
        u.arow = (u.pm / 17) * SEQL + 248 * (u.pm % 17) - 1; u.brow = 256 * u.pn; return true; } };
struct SchedOne { Unit v; __device__ __forceinline__ bool next(int i, Unit& u) const { if (i) return false; u = v; return true; } };

__device__ __forceinline__ u32x4 pack8(const f32x4 a, const f32x4 b) { u32x4 w; w.x = cvt_pk_bf16(a[0], a[1]); w.y = cvt_pk_bf16(a[2], a[3]); w.z = cvt_pk_bf16(b[0], b[1]); w.w = cvt_pk_bf16(b[2], b[3]); return w; }
__device__ __forceinline__ u32x2 pack4(const f32x4 a) { u32x2 w; w.x = cvt_pk_bf16(a[0], a[1]); w.y = cvt_pk_bf16(a[2], a[3]); return w; }
__device__ __forceinline__ u32x4 ld_nt(const u32x4* p) { return __builtin_nontemporal_load(p); }
__device__ __forceinline__ f32x4 ld_nt(const f32x4* p) { return __builtin_nontemporal_load(p); }
__device__ __forceinline__ f32x4 unpk_lo(const u32x4 w) { return (f32x4){__uint_as_float(w.x << 16), __uint_as_float(w.x & 0xffff0000u), __uint_as_float(w.y << 16), __uint_as_float(w.y & 0xffff0000u)}; }
__device__ __forceinline__ f32x4 unpk_hi(const u32x4 w) { return (f32x4){__uint_as_float(w.z << 16), __uint_as_float(w.z & 0xffff0000u), __uint_as_float(w.w << 16), __uint_as_float(w.w & 0xffff0000u)}; }
__device__ __forceinline__ float sigf(float x) { return __builtin_amdgcn_rcpf(1.f + __builtin_amdgcn_exp2f(-1.4426950408889634f * x)); }
__device__ __forceinline__ f32x4 sig4(const f32x4 x) { return (f32x4){sigf(x[0]), sigf(x[1]), sigf(x[2]), sigf(x[3])}; }

struct EpiIn {
    static constexpr bool PERM = true;
    const Ptrs* Pp;
    __device__ __forceinline__ void operator()(const f32x4 (&acc)[2][2][4][2], const Unit& u, int wr, int wc, int fr, int fq) const {
        const Ptrs& P = *Pp;
        const bool isctx = u.pm >= 64; const int pn = u.pn;
        if (pn < 8) {
            const bool isq = pn < 4;
            const float* w = isq ? P.in[IN_QNW] : P.in[IN_KNW];
            f32x4 wv[2][2];
#pragma unroll
            for (int bj = 0; bj < 2; ++bj)
#pragma unroll
                for (int n = 0; n < 2; ++n) wv[bj][n] = *(const f32x4*)(w + 32 * bj + 16 * n + 4 * fq);
            const int h = (pn & 3) * 2 + (wc >> 1), mm = wc & 1;
            const float* tab = (const float*)(P.ws + WS_ROPE);
#pragma unroll
            for (int ai = 0; ai < 2; ++ai)
#pragma unroll
                for (int m = 0; m < 4; ++m) {
                    const int r = 256 * u.pm + 128 * ai + 64 * wr + 16 * m + fr;
                    const int b = isctx ? (r - MR) / NCTX : r / SEQL, t = isctx ? (r - MR) % NCTX : r % SEQL, key = isctx ? t : NCTX + t;
                    float ss = 0.f;
#pragma unroll
                    for (int bj = 0; bj < 2; ++bj)
#pragma unroll
                        for (int n = 0; n < 2; ++n) { const f32x4 x = acc[ai][bj][m][n]; ss += (x[0] * x[0] + x[1] * x[1]) + (x[2] * x[2] + x[3] * x[3]); }
                    ss = xor32_sum(xor16_sum(ss));
                    const float rs = __builtin_amdgcn_rsqf(ss * (1.f / 64.f) + EPSN);
#pragma unroll
                    for (int bj = 0; bj < 2; ++bj) {
                        f32x4 x1 = acc[ai][bj][m][0] * rs * wv[bj][0], x2 = acc[ai][bj][m][1] * rs * wv[bj][1];
                        if (!isctx) {
                            const int pos = bj == 0 ? (t >> 6) : (t & 63);
                            const f32x4 t0 = *(const f32x4*)(tab + (pos * 16 + 4 * fq) * 2), t1 = *(const f32x4*)(tab + (pos * 16 + 4 * fq) * 2 + 4);
                            const f32x4 cs = (f32x4){t0[0], t0[2], t1[0], t1[2]}, sn = (f32x4){t0[1], t0[3], t1[1], t1[3]};
                            const f32x4 o1 = x1 * cs - x2 * sn, o2 = x2 * cs + x1 * sn;
                            x1 = o1; x2 = o2;
                        }
                        if (isq) {
                            bf16_t* q = (bf16_t*)(P.ws + WS_RQ);
                            *(u32x2*)(q + q_idx(b, t, h, mm, 32 * bj + 4 * fq)) = pack4(x1 * C2);
                            *(u32x2*)(q + q_idx(b, t, h, mm, 32 * bj + 16 + 4 * fq)) = pack4(x2 * C2);
                        } else {
                            bf16_t* k = (bf16_t*)(P.ws + WS_RK);
                            *(u32x2*)(k + k_idx(b, h, mm, key, 32 * bj + 4 * fq)) = pack4(x1);
                            *(u32x2*)(k + k_idx(b, h, mm, key, 32 * bj + 16 + 4 * fq)) = pack4(x2);
                        }
                    }
                }
        } else if (pn < 12) {
#pragma unroll
            for (int ai = 0; ai < 2; ++ai)
#pragma unroll
                for (int m = 0; m < 4; ++m) {
                    const int r = 256 * u.pm + 128 * ai + 64 * wr + 16 * m + fr;
                    const int b = isctx ? (r - MR) / NCTX : r / SEQL, t = isctx ? (r - MR) % NCTX : r % SEQL, key = isctx ? t : NCTX + t;
#pragma unroll
                    for (int bj = 0; bj < 2; ++bj)
                        *(u32x4*)((bf16_t*)(P.ws + WS_RV) + v_idx(b, 2 * (pn - 8) + bj, key, 32 * wc + 8 * fq)) = pack8(acc[ai][bj][m][0], acc[ai][bj][m][1]);
                }
        } else if (pn < 14) {
#pragma unroll
            for (int ai = 0; ai < 2; ++ai)
#pragma unroll
                for (int m = 0; m < 4; ++m) {
                    const int r = 256 * u.pm + 128 * ai + 64 * wr + 16 * m + fr;
                    const int b = isctx ? (r - MR) / NCTX : r / SEQL, t = isctx ? (r - MR) % NCTX : r % SEQL;
                    const int chunk = isctx ? 256 + (t >> 4) : (t >> 4), sig = t & 15;
#pragma unroll
                    for (int bj = 0; bj < 2; ++bj) { const int c = 256 * (pn - 12) + 128 * bj + 32 * wc + 8 * fq;
                        *(u32x4*)((bf16_t*)(P.ws + WS_RU) + u_idx(b, c >> 4, chunk, sig, c & 15)) = pack8(acc[ai][bj][m][0], acc[ai][bj][m][1]); }
                }
        } else if (!isctx) {
#pragma unroll
            for (int bj = 0; bj < 2; ++bj) {
                const int c = 256 * (pn - 14) + 128 * bj + 32 * wc + 8 * fq;
                const f32x4 b0 = *(const f32x4*)(P.in[IN_BGATE] + c), b1 = *(const f32x4*)(P.in[IN_BGATE] + c + 4);
#pragma unroll
                for (int ai = 0; ai < 2; ++ai)
#pragma unroll
                    for (int m = 0; m < 4; ++m) {
                        const int r = 256 * u.pm + 128 * ai + 64 * wr + 16 * m + fr;
                        *(u32x4*)((bf16_t*)P.out + (size_t)r * 2048 + c) = pack8(sig4(acc[ai][bj][m][0] + b0), sig4(acc[ai][bj][m][1] + b1));
                    }
            }
        }
    }
};
struct EpiGlu {
    static constexpr bool PERM = true;
    const Ptrs* Pp;
    __device__ __forceinline__ void operator()(const f32x4 (&acc)[2][2][4][2], const Unit& u, int wr, int wc, int fr, int fq) const {
        const Ptrs& P = *Pp;
#pragma unroll
        for (int bj = 0; bj < 2; ++bj) {
            const int c = 256 * u.pn + 128 * bj + 32 * wc + 8 * fq;
            const f32x4 b0 = *(const f32x4*)(P.in[IN_GLUB] + c), b1 = *(const f32x4*)(P.in[IN_GLUB] + c + 4);
#pragma unroll
            for (int ai = 0; ai < 2; ++ai)
#pragma unroll
                for (int m = 0; m < 4; ++m) {
                    const size_t r = 256 * u.pm + 128 * ai + 64 * wr + 16 * m + fr;
                    const u32x4 hs = *(const u32x4*)((const bf16_t*)(P.ws + WS_HS) + r * S5W + c);
                    *(u32x4*)((bf16_t*)(P.ws + WS_HS2) + r * S5W + c) = pack8(unpk_lo(hs) * sig4(acc[ai][bj][m][0] + b0), unpk_hi(hs) * sig4(acc[ai][bj][m][1] + b1));
                }
        }
    }
};
template <int STEP, int GO> struct EpiBranch {
    static constexpr bool PERM = true;
    const Ptrs* Pp;
    __device__ __forceinline__ void operator()(const f32x4 (&acc)[2][2][4][2], const Unit& u, int wr, int wc, int fr, int fq) const {
        const Ptrs& P = *Pp;
#pragma unroll
        for (int ai = 0; ai < 2; ++ai)
#pragma unroll
            for (int m = 0; m < 4; ++m) {
                const size_t r = 256 * u.pm + 128 * ai + 64 * wr + 16 * m + fr;
#pragma unroll
                for (int bj = 0; bj < 2; ++bj) {
                    const int c = 256 * u.pn + 128 * bj + 32 * wc + 8 * fq;
                    const u32x4 gt = *(const u32x4*)((const bf16_t*)P.out + r * 2048 + GO + c);
                    bf16_t* T = (bf16_t*)(P.ws + WS_T) + r * DM + c;
                    if (STEP == 0) { *(u32x4*)T = pack8(unpk_lo(gt) * acc[ai][bj][m][0], unpk_hi(gt) * acc[ai][bj][m][1]); }
                    else { const u32x4 tt = *(const u32x4*)T;
                        *(u32x4*)((bf16_t*)(P.ws + WS_MB) + r * DM + c) = pack8(unpk_lo(tt) + unpk_lo(gt) * acc[ai][bj][m][0], unpk_hi(tt) + unpk_hi(gt) * acc[ai][bj][m][1]); }
                }
            }
    }
};
struct EpiOut {
    static constexpr bool PERM = true;
    const Ptrs* Pp;
    __device__ __forceinline__ void operator()(const f32x4 (&acc)[2][2][4][2], const Unit& u, int wr, int wc, int fr, int fq) const {
        const Ptrs& P = *Pp;
        const int b = u.pm / 16;
        const float* mod = (const float*)(P.ws + WS_MODFIN) + b * 6144;
        f32x4 ga[2][2], sw[2][2];
#pragma unroll
        for (int bj = 0; bj < 2; ++bj)
#pragma unroll
            for (int n = 0; n < 2; ++n) { const int c = 256 * u.pn + 128 * bj + 32 * wc + 8 * fq + 4 * n;
                ga[bj][n] = *(const f32x4*)(mod + 2048 + c); sw[bj][n] = *(const f32x4*)(P.in[IN_N2W] + c) * (*(const f32x4*)(mod + 4096 + c) + 1.f); }
        float ssg[8];
#pragma unroll
        for (int ai = 0; ai < 2; ++ai)
#pragma unroll
            for (int m = 0; m < 4; ++m) {
                const size_t r = 256 * u.pm + 128 * ai + 64 * wr + 16 * m + fr;
                float ss = 0.f;
#pragma unroll
                for (int bj = 0; bj < 2; ++bj) {
                    const int c = 256 * u.pn + 128 * bj + 32 * wc + 8 * fq;
                    const f32x4 x0 = ld_nt((const f32x4*)(P.in[IN_X] + r * DM + c)) + ga[bj][0] * acc[ai][bj][m][0], x1 = ld_nt((const f32x4*)(P.in[IN_X] + r * DM + c + 4)) + ga[bj][1] * acc[ai][bj][m][1];
                    *(u32x4*)((bf16_t*)(P.ws + WS_X1R) + r * DM + c) = pack8(x0, x1);
                    *(u32x4*)((bf16_t*)(P.ws + WS_X1B) + r * DM + c) = pack8(x0 * sw[bj][0], x1 * sw[bj][1]);
                    ss += (x0[0] * x0[0] + x0[1] * x0[1]) + (x0[2] * x0[2] + x0[3] * x0[3]) + (x1[0] * x1[0] + x1[1] * x1[1]) + (x1[2] * x1[2] + x1[3] * x1[3]);
                }
                ssg[ai * 4 + m] = xor32_sum(xor16_sum(ss));
            }
        { const float v0 = fq == 0 ? ssg[0] : fq == 1 ? ssg[1] : fq == 2 ? ssg[2] : ssg[3], v1 = fq == 0 ? ssg[4] : fq == 1 ? ssg[5] : fq == 2 ? ssg[6] : ssg[7];
          float* rq = (float*)(P.ws + WS_ROWSQ) + 256 * u.pm + 64 * wr + 16 * fq + fr;
          atomicAdd(rq, v0); atomicAdd(rq + 128, v1); }
    }
};
struct EpiDown {
    static constexpr bool PERM = true;
    const Ptrs* Pp;
    __device__ __forceinline__ void operator()(const f32x4 (&acc)[2][2][4][2], const Unit& u, int wr, int wc, int fr, int fq) const {
        const Ptrs& P = *Pp;
        const float* mod = (const float*)(P.ws + WS_MODFIN) + (u.pm / 16) * 6144 + 5120;
#pragma unroll
        for (int bj = 0; bj < 2; ++bj) {
            const int c = 256 * u.pn + 128 * bj + 32 * wc + 8 * fq;
            const f32x4 g0 = *(const f32x4*)(mod + c), g1 = *(const f32x4*)(mod + c + 4);
#pragma unroll
            for (int ai = 0; ai < 2; ++ai)
#pragma unroll
                for (int m = 0; m < 4; ++m) {
                    const size_t e = (size_t)(256 * u.pm + 128 * ai + 64 * wr + 16 * m + fr) * DM + c;
                    const u32x4 xr = ld_nt((const u32x4*)((const bf16_t*)(P.ws + WS_X1R) + e));
                    float* o = P.out + e;
                    __builtin_nontemporal_store(unpk_lo(xr) + g0 * acc[ai][bj][m][0], (f32x4*)o); __builtin_nontemporal_store(unpk_hi(xr) + g1 * acc[ai][bj][m][1], (f32x4*)(o + 4));
                }
        }
    }
};
__device__ __forceinline__ float dpp_ror1(float v) { return __int_as_float(__builtin_amdgcn_mov_dpp(__float_as_int(v), 0x121, 0xf, 0xf, true)); }
__device__ __forceinline__ float dpp_rol1(float v) { return __int_as_float(__builtin_amdgcn_mov_dpp(__float_as_int(v), 0x12f, 0xf, 0xf, true)); }
__device__ __forceinline__ float dpp_shr1_zero(float v) { return __int_as_float(__builtin_amdgcn_mov_dpp(__float_as_int(v), 0x111, 0xf, 0xf, true)); }
__device__ __forceinline__ float dpp_shl1_zero(float v) { return __int_as_float(__builtin_amdgcn_mov_dpp(__float_as_int(v), 0x101, 0xf, 0xf, true)); }
__device__ __forceinline__ float dpp_shr1_keep(float old, float v) { return __int_as_float(__builtin_amdgcn_update_dpp(__float_as_int(old), __float_as_int(v), 0x111, 0xf, 0xf, false)); }
__device__ __forceinline__ float dpp_shl1_keep(float old, float v) { return __int_as_float(__builtin_amdgcn_update_dpp(__float_as_int(old), __float_as_int(v), 0x101, 0xf, 0xf, false)); }
struct EpiUp {
    static constexpr bool PERM = true;
    const Ptrs* Pp;
    __device__ __forceinline__ void operator()(const f32x4 (&acc)[2][2][4][2], const Unit& u, int wr_, int wc_, int fr_, int fq_) const {
        const Ptrs& P = *Pp;
        const int wr = wr_, wc = wc_, fr = fr_, fq = fq_;
        const int b = u.pm / 17, ti = u.pm % 17;
        const float* rq = (const float*)(P.ws + WS_ROWSQ) + (size_t)b * SEQL + 248 * ti + 62 * wr + 4 * fr - 1;
        const f32x4* ct = (const f32x4*)(P.ws + WS_CONVTAB) + (size_t)((((b * 22 + u.pn) * 4 + wc) * 4 + fq) * 20);
        const int ca0 = 128 * u.pn + 32 * wc + 8 * fq;
        float rstd[2][4]; bool valid[2][4];
#pragma unroll
        for (int ai = 0; ai < 2; ++ai)
#pragma unroll
            for (int m = 0; m < 4; ++m) {
                const int tok = 248 * ti + 62 * (2 * ai + wr) + 4 * fr + m - 1;
                valid[ai][m] = tok >= 0 && tok < SEQL;
                rstd[ai][m] = __builtin_amdgcn_rsqf(rq[124 * ai + m] * (1.f / DM) + EPSN);
            }
        bf16_t* ACT = (bf16_t*)(P.ws + WS_ACT);
#pragma unroll
        for (int ai = 0; ai < 2; ++ai) {
            float ya[4][2][4];
#pragma unroll
            for (int bj = 0; bj < 2; ++bj)
#pragma unroll
                for (int n = 0; n < 2; ++n) {
                    const f32x4 w0 = ct[(bj * 2 + n) * 5 + 0], w1 = ct[(bj * 2 + n) * 5 + 1], w2 = ct[(bj * 2 + n) * 5 + 2], bb = ct[(bj * 2 + n) * 5 + 3], bv = ct[(bj * 2 + n) * 5 + 4];
#pragma unroll
                    for (int j = 0; j < 4; ++j) {
                        float x[4], up[4], dn[4];
#pragma unroll
                        for (int m = 0; m < 4; ++m) { const float v = acc[ai][bj][m][n][j] * rstd[ai][m] + bv[j]; x[m] = valid[ai][m] ? v : 0.f; }
                        up[0] = dpp_shr1_zero(x[3]);
                        dn[3] = dpp_shl1_zero(x[0]);
#pragma unroll
                        for (int m = 1; m < 4; ++m) up[m] = x[m - 1];
#pragma unroll
                        for (int m = 0; m < 3; ++m) dn[m] = x[m + 1];
#pragma unroll
                        for (int m = 0; m < 4; ++m) {
                            const float y = bb[j] + w0[j] * up[m] + w1[j] * x[m] + w2[j] * dn[m];
                            if (bj == 0) ya[m][n][j] = y; else ya[m][n][j] = y * __builtin_amdgcn_rcpf(1.f + __builtin_amdgcn_exp2f(-1.4426950408889634f * y)) * ya[m][n][j];
                        }
                        asm volatile("" : "+v"(ya[0][n][j]), "+v"(ya[1][n][j]), "+v"(ya[2][n][j]), "+v"(ya[3][n][j]));
                        __builtin_amdgcn_sched_barrier(0);
                    }
                    asm volatile("" ::: "memory");
                }
#pragma unroll
            for (int m = 0; m < 4; ++m) {
                const int w = 4 * fr + m, tok = 248 * ti + 62 * (2 * ai + wr) + w - 1;
                u32x4 o; o.x = cvt_pk_bf16(ya[m][0][0], ya[m][0][1]); o.y = cvt_pk_bf16(ya[m][0][2], ya[m][0][3]); o.z = cvt_pk_bf16(ya[m][1][0], ya[m][1][1]); o.w = cvt_pk_bf16(ya[m][1][2], ya[m][1][3]);
                if (w >= 1 && w <= 62 && tok < SEQL) *(u32x4*)(ACT + ((size_t)b * SEQL + tok) * DFF + ca0) = o;
                __builtin_amdgcn_sched_barrier(0);
            }
        }
    }
};

__device__ __forceinline__ unsigned f2bf_u(float f) { unsigned u = __float_as_uint(f); return (u + 0x7fffu + ((u >> 16) & 1u)) >> 16; }
__device__ __forceinline__ unsigned pk2(float lo, float hi) { return f2bf_u(lo) | (f2bf_u(hi) << 16); }
template <class F>
__device__ __forceinline__ void transpose_item(const float* W, int K, int N, bf16_t* WT, LAS float* scr, int item, int lane, F srccol) {
    const int nblk = N / 32, kb = item / nblk, nb = item % nblk, k0 = 64 * kb, n0 = 32 * nb;
    const int col = srccol(n0 + (lane & 31));
    float v_[32];
#pragma unroll
    for (int i = 0; i < 32; ++i) v_[i] = __builtin_nontemporal_load(W + (size_t)(k0 + 2 * i + (lane >> 5)) * N + col);
#pragma unroll
    for (int i = 0; i < 32; ++i) scr[(2 * i + (lane >> 5)) * 33 + (lane & 31)] = v_[i];
    asm volatile("s_waitcnt lgkmcnt(0)" ::: "memory");
    const int c = lane & 7;
#pragma unroll
    for (int j = 0; j < 4; ++j) { const int n = (lane >> 3) + 8 * j; const LAS float* s = scr + (8 * c) * 33 + n;
        u32x4 o; o.x = cvt_pk_bf16(s[0 * 33], s[1 * 33]); o.y = cvt_pk_bf16(s[2 * 33], s[3 * 33]); o.z = cvt_pk_bf16(s[4 * 33], s[5 * 33]); o.w = cvt_pk_bf16(s[6 * 33], s[7 * 33]);
        *(u32x4*)(WT + (size_t)(n0 + n) * K + k0 + 8 * c) = o; }
    asm volatile("s_waitcnt lgkmcnt(0)" ::: "memory");
}
__device__ __forceinline__ void build_convtab(const Ptrs& P, int gtid) {
    if (gtid >= 1408 * 80) return;
    const int e = gtid % 80, entry = gtid / 80, bj = e / 40, n = (e / 20) & 1, k = (e >> 2) % 5, j = e & 3;
    const int fq = entry & 3, wc = (entry >> 2) & 3, pn = (entry >> 4) % 22, b = entry / 352;
    const int col = bj * DFF + 128 * pn + 32 * wc + 8 * fq + 4 * n + j;
    const float v = k < 3 ? P.in[IN_CONVW][k * NIN + col] : (k == 3 ? P.in[IN_CONVB][col] : ((const float*)(P.ws + WS_BIASUP))[b * NIN + col]);
    ((float*)(P.ws + WS_CONVTAB))[gtid] = v;
}
struct ColId { __device__ __forceinline__ int operator()(int n) const { return n; } };
struct ColIn { __device__ __forceinline__ int operator()(int n) const {
        if (n >= 2048) return n; const int s = n & 255, bj = s >> 7, wc = (s >> 5) & 3, fq = (s >> 3) & 3, nn = (s >> 2) & 1, j = s & 3; return (n & ~255) + 64 * wc + 32 * bj + 16 * nn + 4 * fq + j; } };
struct ColUp { __device__ __forceinline__ int operator()(int n) const { const int pn = n >> 8, s = n & 255; return s < 128 ? 128 * pn + s : DFF + 128 * pn + (s - 128); } };
constexpr int I_IN = 16 * 176, I_UP = 16 * 176, I_DN = 44 * 32, I_OUT = 16 * 32, I_BA = 16 * 32, I_BS = 8 * 32, I_GLU = 8 * 16;
constexpr int NTR_ITEMS = I_IN + I_UP + I_DN + I_OUT + I_BA + I_BS + I_GLU;
__device__ __forceinline__ void transpose_setA(const Ptrs& P, LAS float* scr, int r, int lane) {
    if (r < I_IN) { transpose_item(P.in[IN_WIN], DM, NIN, (bf16_t*)(P.ws + WS_WIN), scr, r, lane, ColIn()); return; } r -= I_IN;
    transpose_item(P.in[IN_GLUW], S5W, S5W, (bf16_t*)(P.ws + WS_WGLU), scr, r, lane, ColId());
}
__device__ __forceinline__ void transpose_setB(const Ptrs& P, LAS float* scr, int r, int lane) {
    if (r < I_OUT) { transpose_item(P.in[IN_WOUT], DM, DM, (bf16_t*)(P.ws + WS_WOUT), scr, r, lane, ColId()); return; } r -= I_OUT;
    if (r < I_BA) { transpose_item(P.in[IN_WBA], DM, DM, (bf16_t*)(P.ws + WS_WBA), scr, r, lane, ColId()); return; } r -= I_BA;
    transpose_item(P.in[IN_WBS], S5W, DM, (bf16_t*)(P.ws + WS_WBS), scr, r, lane, ColId());
}
__device__ __forceinline__ void transpose_setC(const Ptrs& P, LAS float* scr, int r, int lane) {
    if (r < I_UP) { transpose_item(P.in[IN_WUP], DM, NIN, (bf16_t*)(P.ws + WS_WUP), scr, r, lane, ColUp()); return; } r -= I_UP;
    transpose_item(P.in[IN_WDOWN], DFF, DM, (bf16_t*)(P.ws + WS_WDOWN), scr, r, lane, ColId());
}
constexpr int NTR_A = I_IN + I_GLU, NTR_B = I_OUT + I_BA + I_BS, NTR_C = I_UP + I_DN;
__device__ __forceinline__ void transposes_A(const Ptrs& P, LAS unsigned char* lds, int gw, int NGW, int wave, int lane) {
    LAS float* scr = (LAS float*)(lds + wave * 8704);
    for (int it = gw; it < NTR_A; it += NGW) transpose_setA(P, scr, it, lane);
}
__device__ __forceinline__ void transposes_B(const Ptrs& P, LAS unsigned char* lds, int gw, int NGW, int wave, int lane) {
    LAS float* scr = (LAS float*)(lds + wave * 8704);
    for (int it = gw; it < NTR_B; it += NGW) transpose_setB(P, scr, it, lane);
}
__device__ __forceinline__ void transposes_C(const Ptrs& P, LAS unsigned char* lds, int gw, int NGW, int wave, int lane) {
    LAS float* scr = (LAS float*)(lds + wave * 8704);
    for (int it = gw; it < NTR_C; it += NGW) transpose_setC(P, scr, it, lane);
}
}
#ifndef PROBE_MFMA
#define PROBE_MFMA 0
#endif
#ifndef PROBE_EXP
#define PROBE_EXP 0
#endif
#ifndef PROBE_LDS
#define PROBE_LDS 0
#endif
namespace at {
typedef float f32x16 __attribute__((ext_vector_type(16)));
typedef short bf16x8 __attribute__((ext_vector_type(8)));
typedef short s16x4 __attribute__((ext_vector_type(4)));
typedef unsigned u32x4 __attribute__((ext_vector_type(4)));
typedef float f32x4v __attribute__((ext_vector_type(4)));
constexpr int SLOT = 32768, XOFF = 65536, WSF = 131072;
__device__ __forceinline__ int crow(int r, int hi) { return (r & 3) + 8 * (r >> 2) + 4 * hi; }
typedef float f32x2_t __attribute__((ext_vector_type(2))); typedef __bf16 bf16x2_t __attribute__((ext_vector_type(2)));
__device__ __forceinline__ unsigned cvtpk(float lo, float hi) { f32x2_t v = {lo, hi}; bf16x2_t b = __builtin_convertvector(v, bf16x2_t); return __builtin_bit_cast(unsigned, b); }
__device__ __forceinline__ s16x4 vtr(const LAS unsigned char* p) { return __builtin_bit_cast(s16x4, __builtin_amdgcn_ds_read_tr16_b64_v4i16((LAS s16x4*)p)); }
#define AT_WAITBAR(N) asm volatile("s_waitcnt vmcnt(" #N ") lgkmcnt(0)\n\ts_barrier" ::: "memory")

struct Srcs { const char* k0; const char* k1; const char* v; unsigned lo; };
__device__ __forceinline__ void glds16(const char* sbase, unsigned voff, unsigned lds_dst) { unsigned keep;
    asm volatile("s_mov_b32 %0, m0\n\ts_mov_b32 m0, %3\n\ts_nop 0\n\tglobal_load_lds_dwordx4 %1, %2\n\ts_mov_b32 m0, %0" : "=&s"(keep) : "v"(voff), "s"(sbase), "s"(lds_dst) : "memory"); }
__device__ __forceinline__ void dma_piece(unsigned lds0, const Srcs& s, int t, int slot, int wid, int pc) {
    const unsigned d = (unsigned)__builtin_amdgcn_readfirstlane((int)(lds0 + slot * SLOT + wid * 1024));
    if (pc == 0) glds16(s.k0 + (size_t)t * 8192, s.lo, d);
    else if (pc == 1) glds16(s.k1 + (size_t)t * 8192, s.lo, d + 8192);
    else if (pc == 2) glds16(s.v + (size_t)t * 16384, s.lo, d + 16384 + wid * 1024);
    else glds16(s.v + (size_t)t * 16384 + 1024, s.lo, d + 16384 + wid * 1024 + 1024);
}
__device__ __forceinline__ void dma_tile(unsigned lds0, const Srcs& s, int t, int slot, int wid) {
#pragma unroll
    for (int pc = 0; pc < 4; ++pc) dma_piece(lds0, s, t, slot, wid, pc);
}
__device__ __forceinline__ Srcs unit_srcs(const Ptrs& P, int unit, int wid, int lane) {
    const int b = unit / (NHEAD * 32), h = (unit / 32) % NHEAD;
    Srcs s;
    s.k0 = (const char*)((const bf16_t*)(P.ws + WS_RK) + k_idx(b, h, 0, 0, 0)) + wid * 1024;
    s.k1 = (const char*)((const bf16_t*)(P.ws + WS_RK) + k_idx(b, h, 1, 0, 0)) + wid * 1024;
    s.v = (const char*)((const bf16_t*)(P.ws + WS_RV) + v_idx(b, h, 0, 0)) + wid * 2048;
    s.lo = (unsigned)lane * 16u;
    return s;
}
__device__ __forceinline__ void attn_unit(const Ptrs& P, LAS unsigned char* lds, int unit, int next_unit, bool first, float lam, float mshift, int wid, bf16_t* Obase) {
    int lane_ = lane_id(); asm volatile("" : "+v"(lane_));
    const int lane = lane_, r32 = lane & 31, hi = lane >> 5;
    const int mp = wid >> 2, wq = wid & 3;
    const int b = unit / (NHEAD * 32), h = (unit / 32) % NHEAD, q0 = (unit % 32) * 128;
    const Srcs S = unit_srcs(P, unit, wid, lane);
    const unsigned lds0 = (unsigned)(uintptr_t)lds;
    if (first) { dma_tile(lds0, S, 0, 0, wid); dma_tile(lds0, S, 1, 1, wid); }
    bf16_t* Qg = (bf16_t*)(P.ws + WS_RQ);
    bf16x8 qr[4];
#pragma unroll
    for (int d0 = 0; d0 < 4; ++d0) qr[d0] = *(const bf16x8*)(Qg + q_idx(b, q0 + wq * 32 + r32, h, mp, d0 * 16 + hi * 8));
    const f32x16 zero16 = (f32x16){0.f, 0.f, 0.f, 0.f, 0.f, 0.f, 0.f, 0.f, 0.f, 0.f, 0.f, 0.f, 0.f, 0.f, 0.f, 0.f};
    f32x16 o[4];
#pragma unroll
    for (int d0 = 0; d0 < 4; ++d0) o[d0] = zero16;
    float s0 = 0.f, s1 = 0.f;
    const int koff = mp * 8192 + hi * 1024 + r32 * 16;
    const int voff = 16384 + ((lane >> 4) & 1) * 32 + (lane & 3) * 8 + (4 * hi + ((lane & 15) >> 2)) * 64;
#define AT_SB() __builtin_amdgcn_sched_barrier(0)
#define AT_VF(src, k4) (bf16x8){src[2 * (k4)][0], src[2 * (k4)][1], src[2 * (k4)][2], src[2 * (k4)][3], src[2 * (k4) + 1][0], src[2 * (k4) + 1][1], src[2 * (k4) + 1][2], src[2 * (k4) + 1][3]}
#define AT_VT(vs_, d0, j) vtr(vs_ + (d0) * 4096 + ((j) >> 1) * 1024 + ((j) & 1) * 512)
#define AT_PACK() do { _Pragma("unroll") for (int q = 0; q < 4; ++q) { pw[0][q] = cvtpk(p0[2 * q], p0[2 * q + 1]); pw[1][q] = cvtpk(p0[8 + 2 * q], p0[8 + 2 * q + 1]); pw[2][q] = cvtpk(p1[2 * q], p1[2 * q + 1]); pw[3][q] = cvtpk(p1[8 + 2 * q], p1[8 + 2 * q + 1]); } } while (0)
    AT_WAITBAR(4);
    if (2 < NKT) dma_tile(lds0, S, 2, 2, wid);
    f32x16 p0, p1; u32x4 pw[4];
    {
        const LAS unsigned char* ks = lds + koff;
        bf16x8 kf[8];
#pragma unroll
        for (int i = 0; i < 8; ++i) kf[i] = *(const LAS bf16x8*)(ks + (i >> 1) * 2048 + (i & 1) * 512);
#pragma unroll
        for (int d0 = 0; d0 < 4; ++d0) {
            p0 = __builtin_amdgcn_mfma_f32_32x32x16_bf16(kf[2 * d0], qr[d0], d0 == 0 ? zero16 : p0, 0, 0, 0);
            p1 = __builtin_amdgcn_mfma_f32_32x32x16_bf16(kf[2 * d0 + 1], qr[d0], d0 == 0 ? zero16 : p1, 0, 0, 0);
        }
#pragma unroll
        for (int r = 0; r < 16; ++r) { p0[r] = __builtin_amdgcn_exp2f(p0[r]); p1[r] = __builtin_amdgcn_exp2f(p1[r]); s0 += p0[r]; s1 += p1[r]; }
    }
    for (int t = 0; t < NKT; ++t) {
        const bool more = t + 1 < NKT;
        if (t + 2 < NKT) { AT_WAITBAR(4); } else { AT_WAITBAR(0); }
        const bool pf = t + 3 < NKT;
        const LAS unsigned char* ks = lds + ((t + 1) & 3) * SLOT + koff;
        const LAS unsigned char* vs = lds + (t & 3) * SLOT + voff;
        bf16x8 kf[8]; s16x4 va[8], vb[8];
        if (more) {
#pragma unroll
            for (int i = 0; i < 8; ++i) kf[i] = *(const LAS bf16x8*)(ks + (i >> 1) * 2048 + (i & 1) * 512);
        }
#pragma unroll
        for (int j = 0; j < 8; ++j) va[j] = AT_VT(vs, 0, j);
        AT_SB();
        AT_PACK();
        AT_SB();
        if (more) {
#pragma unroll
            for (int i = 0; i < 8; ++i) {
                if ((i & 1) == 0) p0 = __builtin_amdgcn_mfma_f32_32x32x16_bf16(kf[i], qr[i >> 1], i < 2 ? zero16 : p0, 0, 0, 0);
                else p1 = __builtin_amdgcn_mfma_f32_32x32x16_bf16(kf[i], qr[i >> 1], i < 2 ? zero16 : p1, 0, 0, 0);
                vb[i] = AT_VT(vs, 1, i);
                if ((i & 1) && pf) dma_piece(lds0, S, t + 3, (t + 3) & 3, wid, i >> 1);
                AT_SB();
            }
        } else {
#pragma unroll
            for (int j = 0; j < 8; ++j) vb[j] = AT_VT(vs, 1, j);
            AT_SB();
        }
#pragma unroll
        for (int i = 0; i < 16; ++i) {
            const int d0 = i >> 2, k4 = i & 3;
            if ((d0 & 1) == 0) o[d0] = __builtin_amdgcn_mfma_f32_32x32x16_bf16(__builtin_bit_cast(bf16x8, pw[k4]), AT_VF(va, k4), o[d0], 0, 0, 0);
            else o[d0] = __builtin_amdgcn_mfma_f32_32x32x16_bf16(__builtin_bit_cast(bf16x8, pw[k4]), AT_VF(vb, k4), o[d0], 0, 0, 0);
            if (more) {
                const int r = 2 * (i & 7);
                if (i < 8) { p0[r] = __builtin_amdgcn_exp2f(p0[r]); p0[r + 1] = __builtin_amdgcn_exp2f(p0[r + 1]); s0 += p0[r]; s1 += p0[r + 1]; }
                else { p1[r] = __builtin_amdgcn_exp2f(p1[r]); p1[r + 1] = __builtin_amdgcn_exp2f(p1[r + 1]); s0 += p1[r]; s1 += p1[r + 1]; }
            }
            if (i >= 4 && i < 8) { va[2 * (i - 4)] = AT_VT(vs, 2, 2 * (i - 4)); va[2 * (i - 4) + 1] = AT_VT(vs, 2, 2 * (i - 4) + 1); }
            if (i >= 8 && i < 12) { vb[2 * (i - 8)] = AT_VT(vs, 3, 2 * (i - 8)); vb[2 * (i - 8) + 1] = AT_VT(vs, 3, 2 * (i - 8) + 1); }
            AT_SB();
        }
    }
    float l_reg = s0 + s1;
#undef AT_VF
#undef AT_VT
#undef AT_PACK
#undef AT_SB
    AT_WAITBAR(0);
    if (next_unit >= 0) { const Srcs N = unit_srcs(P, next_unit, wid, lane); dma_tile(lds0, N, 0, 0, wid); dma_tile(lds0, N, 1, 1, wid); }
    l_reg = xor32_sum(l_reg);
    LAS float* wsf = (LAS float*)(lds + WSF) + wid * 64;
    if (hi == 0) wsf[r32] = (mp == 0 ? 1.f : lam) / l_reg;
    asm volatile("s_waitcnt lgkmcnt(0)" ::: "memory");
    float fac[16];
#pragma unroll
    for (int r = 0; r < 16; ++r) fac[r] = wsf[crow(r, hi)];
    LAS f32x4v* X = (LAS f32x4v*)(lds + XOFF) + wq * 1024;
    if (mp == 1) {
#pragma unroll
        for (int d0 = 0; d0 < 4; ++d0)
#pragma unroll
            for (int q = 0; q < 4; ++q) X[(d0 * 4 + q) * 64 + lane] = (f32x4v){o[d0][4 * q] * fac[4 * q], o[d0][4 * q + 1] * fac[4 * q + 1], o[d0][4 * q + 2] * fac[4 * q + 2], o[d0][4 * q + 3] * fac[4 * q + 3]};
    }
    AT_WAITBAR(4);
    if (mp == 0) {
        float ss[16];
#pragma unroll
        for (int r = 0; r < 16; ++r) ss[r] = 0.f;
#pragma unroll
        for (int d0 = 0; d0 < 4; ++d0)
#pragma unroll
            for (int q = 0; q < 4; ++q) { const f32x4v xv = X[(d0 * 4 + q) * 64 + lane];
#pragma unroll
                for (int j = 0; j < 4; ++j) { const int r = 4 * q + j; const float v = o[d0][r] * fac[r] - xv[j]; o[d0][r] = v; ss[r] += v * v; } }
#pragma unroll
        for (int r = 0; r < 16; ++r) {
            float s = ss[r];
            s = xor16_sum(row16_sum(s));
            ss[r] = __builtin_amdgcn_rsqf(s * (1.f / 128.f) + EPSN) * (1.f - LAM_INIT);
        }
        asm volatile("s_waitcnt lgkmcnt(0)" ::: "memory");
        LAS bf16_t* stg = (LAS bf16_t*)(lds + XOFF + wq * 16384);
#pragma unroll
        for (int d0 = 0; d0 < 4; ++d0) {
            const float sw = P.in[IN_SUBLN][d0 * 32 + r32];
#pragma unroll
            for (int r = 0; r < 16; r += 2) { const unsigned pk = cvtpk(o[d0][r] * ss[r] * sw, o[d0][r + 1] * ss[r + 1] * sw);
                stg[crow(r, hi) * 128 + d0 * 32 + r32] = (bf16_t)(pk & 0xffffu); stg[crow(r + 1, hi) * 128 + d0 * 32 + r32] = (bf16_t)(pk >> 16); }
        }
        asm volatile("s_waitcnt lgkmcnt(0)" ::: "memory");
        bf16_t* On = Obase + ((size_t)(b * SEQL + q0 + wq * 32)) * 1024 + h * 128;
#pragma unroll
        for (int i = 0; i < 8; ++i) { const int row = i * 4 + (lane >> 4), ch = lane & 15;
            const u32x4 v = *(const LAS u32x4*)(stg + row * 128 + ch * 8);
            *(u32x4*)(On + (size_t)row * 1024 + ch * 8) = v; }
    }
}
#undef AT_WAITBAR
__device__ __forceinline__ void attn_phase(const Ptrs& P, LAS unsigned char* lds, int G, int bx, int wave, bf16_t* Obase) {
    const int lane = lane_id();
    asm volatile(".rept %0\n\ts_nop 0\n\t.endr" :: "i"(PAD_ATT));
    const float lam = __expf(wave_sum(P.in[IN_LQ1][lane] * P.in[IN_LK1][lane])) - __expf(wave_sum(P.in[IN_LQ2][lane] * P.in[IN_LK2][lane])) + LAM_INIT;
    const float mshift = 8.f * 1.4426950408889634f * wave_max(fabsf(P.in[IN_QNW][lane])) * wave_max(fabsf(P.in[IN_KNW][lane]));
    const int vcu = (G % 8 == 0) ? (bx % 8) * (G / 8) + bx / 8 : bx;
    const int NU = NB * NHEAD * 32;
    bool first = true;
    for (int u = vcu; u < NU; u += G) { attn_unit(P, lds, u, u + G < NU ? u + G : -1, first, lam, mshift, wave, Obase); first = false; }
    asm volatile("s_waitcnt vmcnt(0) lgkmcnt(0)" ::: "memory");
    __syncthreads();
}
}
namespace s5 {
using pg8::Unit; using pg8::f32x4; using pg8::u32x4;
typedef float f2 __attribute__((ext_vector_type(2)));
__device__ __forceinline__ f2 cmul(f2 a, f2 b) { return (f2){a.x * b.x - a.y * b.y, a.x * b.y + a.y * b.x}; }

template <int NDL>
__device__ __forceinline__ void stage2(const LAS f2* apow, const LAS f2* BB, const LAS f2* CC, LAS float* Mt, int d, int c, int cp) {
    float acc[NDL];
#pragma unroll
    for (int j = 0; j < NDL; ++j) acc[j] = 0.f;
#pragma unroll 2
    for (int p = 0; p < 64; ++p) {
        const f2 z = cmul(CC[(d * 64 + p) * 16 + c], BB[(d * 64 + p) * 16 + cp]);
        const LAS f2* ap = apow + (d * 64 + p) * 17;
#pragma unroll
        for (int j = 0; j < NDL; ++j) { const f2 a = ap[j]; acc[j] += z.x * a.x - z.y * a.y; }
    }
#pragma unroll
    for (int j = 0; j < NDL; ++j) Mt[((d * 16 + j) * 16 + c) * 16 + cp] = acc[j];
}
__device__ void build_tables(const Ptrs& P, LAS unsigned char* lds, int item, int tid) {
    const int g = item >> 3, qt = item & 7;
    LAS f2* apow = (LAS f2*)lds;
    LAS f2* BB = (LAS f2*)(lds + 17408);
    LAS f2* CC = (LAS f2*)(lds + 33792);
    LAS float* Mt = (LAS float*)(lds + 50176);
    {
        const int dp = tid & 127, cq = tid >> 7, d = dp >> 6, p = dp & 63, gi = (d * NGRP + g) * NST + p;
        const float lre = fminf(P.in[IN_ARE][gi], -1e-4f), lim = P.in[IN_AIM][gi], dt = __expf(P.in[IN_LOGDT][d * NGRP + g]);
        f2 a1; { const float mag = __expf(lre * dt); float sn, cs; sincosf(lim * dt, &sn, &cs); a1 = (f2){mag * cs, mag * sn}; }
        if (cq == 0) { f2 pw = (f2){1.f, 0.f};
            for (int n = 0; n <= 16; ++n) { apow[(d * 64 + p) * 17 + n] = pw; if (n == 16 && qt == 0) ((f2*)(P.ws + WS_A16))[(g * 2 + d) * 64 + p] = pw; pw = cmul(pw, a1); } }
        const float nr = a1.x - 1.f, ni = a1.y, den = lre * lre + lim * lim;
        const f2 fz = (f2){(nr * lre + ni * lim) / den, (ni * lre - nr * lim) / den};
#pragma unroll
        for (int cc = 0; cc < 4; ++cc) { const int c = 4 * cq + cc;
            BB[(d * 64 + p) * 16 + c] = cmul(fz, (f2){P.in[IN_BRE][(size_t)gi * 16 + c], P.in[IN_BIM][(size_t)gi * 16 + c]});
            CC[(d * 64 + p) * 16 + c] = (f2){P.in[IN_CRE][((size_t)(d * NGRP + g) * 16 + c) * NST + p], P.in[IN_CIM][((size_t)(d * NGRP + g) * 16 + c) * NST + p]};
        }
    }
    __syncthreads();
    {
        const int d = tid >> 8, c = (tid >> 4) & 15, cp = tid & 15;
        const int ndl = d == 0 ? 2 * qt + 2 : 16 - 2 * qt;
        switch (ndl >> 1) {
            case 1: stage2<2>(apow, BB, CC, Mt, d, c, cp); break;  case 2: stage2<4>(apow, BB, CC, Mt, d, c, cp); break;
            case 3: stage2<6>(apow, BB, CC, Mt, d, c, cp); break;  case 4: stage2<8>(apow, BB, CC, Mt, d, c, cp); break;
            case 5: stage2<10>(apow, BB, CC, Mt, d, c, cp); break; case 6: stage2<12>(apow, BB, CC, Mt, d, c, cp); break;
            case 7: stage2<14>(apow, BB, CC, Mt, d, c, cp); break; default: stage2<16>(apow, BB, CC, Mt, d, c, cp); break;
        }
    }
    __syncthreads();
    bf16_t* TQ = (bf16_t*)(P.ws + WS_TQ) + (size_t)g * 256 * 512;
    for (int e = tid; e < 32 * 64; e += 512) {
        const int row = qt * 32 + (e >> 6), K0 = (e & 63) * 8, tau = row >> 4, c = row & 15;
        float v[8];
        if (K0 < 256) { const int sg = K0 >> 4, cp0 = K0 & 15;
            const LAS float* m0p = tau > sg ? Mt + ((0 * 16 + (tau - sg)) * 16 + c) * 16 + cp0 : (tau < sg ? Mt + ((1 * 16 + (sg - tau)) * 16 + c) * 16 + cp0 : Mt + (0 * 16 * 16 + c) * 16 + cp0);
#pragma unroll
            for (int j = 0; j < 8; ++j) v[j] = m0p[j];
            if (tau == sg) { const LAS float* m1p = Mt + ((1 * 16) * 16 + c) * 16 + cp0;
#pragma unroll
                for (int j = 0; j < 8; ++j) v[j] += m1p[j]; }
        } else { const int r0 = K0 - 256, d = r0 >> 7, ri = (r0 >> 6) & 1, p0 = r0 & 63;
#pragma unroll
            for (int j = 0; j < 8; ++j) { const int p = p0 + j;
                const f2 t = cmul(CC[(d * 64 + p) * 16 + c], apow[(d * 64 + p) * 17 + (d == 0 ? tau + 1 : 16 - tau)]);
                v[j] = ri == 0 ? t.x : -t.y; } }
        u32x4 o; o.x = pg8::cvt_pk_bf16(v[0], v[1]); o.y = pg8::cvt_pk_bf16(v[2], v[3]); o.z = pg8::cvt_pk_bf16(v[4], v[5]); o.w = pg8::cvt_pk_bf16(v[6], v[7]);
        *(u32x4*)(TQ + (size_t)row * 512 + K0) = o;
    }
    bf16_t* PS = (bf16_t*)(P.ws + WS_PST) + (size_t)g * 256 * 256;
    for (int e = tid; e < 32 * 32; e += 512) {
        const int r = qt * 32 + (e >> 5), K0 = (e & 31) * 8, sg = K0 >> 4, cp0 = K0 & 15, d = r >> 7, ri = (r >> 6) & 1, p = r & 63;
        const f2 ap = apow[(d * 64 + p) * 17 + (d == 0 ? 15 - sg : sg)];
        float v[8];
#pragma unroll
        for (int j = 0; j < 8; ++j) { const f2 t = cmul(ap, BB[(d * 64 + p) * 16 + cp0 + j]); v[j] = ri == 0 ? t.x : t.y; }
        u32x4 o; o.x = pg8::cvt_pk_bf16(v[0], v[1]); o.y = pg8::cvt_pk_bf16(v[2], v[3]); o.z = pg8::cvt_pk_bf16(v[4], v[5]); o.w = pg8::cvt_pk_bf16(v[6], v[7]);
        *(u32x4*)(PS + (size_t)r * 256 + K0) = o;
    }
    __syncthreads();
}

struct SchedE { int bg, g; __device__ __forceinline__ bool next(int i, Unit& u) const { if (i >= 1) return false; u.arow = bg * NCH; u.brow = g * 256; u.pm = 0; u.pn = 0; return true; } };
struct EpiE {
    static constexpr bool PERM = true;
    float* Es;
    __device__ __forceinline__ void operator()(const f32x4 (&acc)[2][2][4][2], const Unit& u, int wr, int wc, int fr, int fq) const {
#pragma unroll
        for (int ai = 0; ai < 2; ++ai)
#pragma unroll
            for (int m = 0; m < 4; ++m) {
                const int j = 256 * u.pm + 128 * ai + 64 * wr + 16 * m + fr;
                if (j < NCH) {
#pragma unroll
                    for (int bj = 0; bj < 2; ++bj) { float* e = Es + (size_t)j * 256 + 128 * bj + 32 * wc + 8 * fq; *(f32x4*)e = acc[ai][bj][m][0]; *(f32x4*)(e + 4) = acc[ai][bj][m][1]; }
                }
            }
    }
};
struct EpiY {
    static constexpr bool PERM = true;
    const Ptrs* Pp; int b, g;
    __device__ __forceinline__ void operator()(const f32x4 (&acc)[2][2][4][2], const Unit& u, int wr, int wc, int fr, int fq) const {
        const Ptrs& P = *Pp;
        const int c0 = 8 * (fq & 1);
        const f32x4 d0 = *(const f32x4*)(P.in[IN_S5D] + g * 16 + c0), d1 = *(const f32x4*)(P.in[IN_S5D] + g * 16 + c0 + 4);
#pragma unroll
        for (int ai = 0; ai < 2; ++ai)
#pragma unroll
            for (int m = 0; m < 4; ++m) {
                const int j = 128 * ai + 64 * wr + 16 * m + fr;
#pragma unroll
                for (int bj = 0; bj < 2; ++bj) {
                    const int tau = 8 * bj + 2 * wc + (fq >> 1);
                    const u32x4 uu = *(const u32x4*)((const bf16_t*)(P.ws + WS_RU) + u_idx(b, g, j, tau, c0));
                    f32x4 y0 = acc[ai][bj][m][0] + d0 * og::unpk_lo(uu), y1 = acc[ai][bj][m][1] + d1 * og::unpk_hi(uu);
#pragma unroll
                    for (int q = 0; q < 4; ++q) {
                        const float a = y0[q], bb = y1[q];
                        y0[q] = a * __builtin_amdgcn_rcpf(1.f + __builtin_amdgcn_exp2f(a * __builtin_fmaf(a * a, -0.10294324f, -2.3022082f)));
                        y1[q] = bb * __builtin_amdgcn_rcpf(1.f + __builtin_amdgcn_exp2f(bb * __builtin_fmaf(bb * bb, -0.10294324f, -2.3022082f)));
                    }
                    *(u32x4*)((bf16_t*)(P.ws + WS_HS) + ((size_t)(b * SEQL + 16 * j + tau)) * S5W + g * 16 + c0) = og::pack8(y0, y1);
                }
            }
    }
};
__device__ __forceinline__ void scan(const Ptrs& P, int bg, int g, const float* Es, int tid) {
    if (tid >= 128) return;
    const int d = tid >> 6, p = tid & 63;
    const f2 a16 = ((const f2*)(P.ws + WS_A16))[(g * 2 + d) * 64 + p];
    const float ar = a16.x, ai = a16.y;
    const float* er = Es + d * 128 + p;
    float sr = 0.f, si = 0.f;
    {   float cx[16], cy[16];
#pragma unroll
        for (int k = 0; k < 16; ++k) { const int j = d == 0 ? 256 + k : 271 - k; cx[k] = er[(size_t)j * 256]; cy[k] = er[(size_t)j * 256 + 64]; }
#pragma unroll
        for (int k = 0; k < 16; ++k) { const float nr = ar * sr - ai * si + cx[k], ni = ar * si + ai * sr + cy[k]; sr = nr; si = ni; } }
    const long estep = d == 0 ? 256 : -256;
    const long ustep = d == 0 ? 512 : -512;
    const float* e = er + (size_t)(d == 0 ? 0 : 255) * 256;
    bf16_t* u = (bf16_t*)(P.ws + WS_RU) + (size_t)bg * NCH * 512 + 256 + d * 128 + p + (size_t)(d == 0 ? 0 : 255) * 512;
    float xa[16], ya[16], xb[16], yb[16];
#pragma unroll
    for (int k = 0; k < 16; ++k) { xa[k] = e[k * estep]; ya[k] = e[k * estep + 64]; }
#define S5_STEP(X, Y) do { const unsigned pk = pg8::cvt_pk_bf16(sr, si); u[0] = (bf16_t)(pk & 0xffffu); u[64] = (bf16_t)(pk >> 16); u += ustep; \
        const float nr = __builtin_fmaf(ar, sr, __builtin_fmaf(-ai, si, X)), ni = __builtin_fmaf(ar, si, __builtin_fmaf(ai, sr, Y)); sr = nr; si = ni; \
        asm volatile("" : "+v"(sr), "+v"(si)); } while (0)
#pragma unroll 1
    for (int k0 = 0; k0 < 256; k0 += 32) {
        e += 16 * estep;
#pragma unroll
        for (int k = 0; k < 16; ++k) { xb[k] = e[k * estep]; yb[k] = e[k * estep + 64]; }
#pragma unroll
        for (int k = 0; k < 16; ++k) S5_STEP(xa[k], ya[k]);
        e += 16 * estep;
        if (k0 + 32 < 256) {
#pragma unroll
            for (int k = 0; k < 16; ++k) { xa[k] = e[k * estep]; ya[k] = e[k * estep + 64]; }
        }
#pragma unroll
        for (int k = 0; k < 16; ++k) S5_STEP(xb[k], yb[k]);
    }
#undef S5_STEP
}
__device__ __forceinline__ void ctx_states(const Ptrs& P, int bg, int g, float* Es, int wave, int lane) {
    typedef short bf16x8 __attribute__((ext_vector_type(8)));
    const int i16 = lane & 15, kq = lane >> 4;
    const bf16_t* Ua = (const bf16_t*)(P.ws + WS_RU) + ((size_t)bg * NCH + 256 + i16) * 512 + 8 * kq;
    bf16x8 af[8];
#pragma unroll
    for (int ks = 0; ks < 8; ++ks) af[ks] = *(const bf16x8*)(Ua + 32 * ks);
#pragma unroll
    for (int q = 0; q < 2; ++q) {
        const int nt = 2 * wave + q;
        const bf16_t* Pb = (const bf16_t*)(P.ws + WS_PST) + ((size_t)g * 256 + 16 * nt + i16) * 256 + 8 * kq;
        f32x4 acc = (f32x4){0.f, 0.f, 0.f, 0.f};
#pragma unroll
        for (int ks = 0; ks < 8; ++ks) acc = __builtin_amdgcn_mfma_f32_16x16x32_bf16(af[ks], *(const bf16x8*)(Pb + 32 * ks), acc, 0, 0, 0);
#pragma unroll
        for (int reg = 0; reg < 4; ++reg) Es[(size_t)(256 + 4 * kq + reg) * 256 + 16 * nt + i16] = acc[reg];
    }
}
__device__ __forceinline__ void s5_item(const Ptrs& P, LAS unsigned char* ring, int bg, int wave) {
    const int b = bg / NGRP, g = bg % NGRP;
    float* Es = (float*)(P.ws + WS_RH) + (size_t)bg * NCH * 256;
    const bf16_t* U = (const bf16_t*)(P.ws + WS_RU);
    { int l_ = lane_id(); asm volatile("" : "+v"(l_)); ctx_states(P, bg, g, Es, wave, l_); }
    { const pg8::Gemm g1{U, (const bf16_t*)(P.ws + WS_PST), 256, 512, 256};
      pg8::gemm_phase<EpiE, SchedE, false, 0>(ring, g1, SchedE{bg, g}, EpiE{Es}, wave); }
    asm volatile("s_waitcnt vmcnt(0)" ::: "memory"); __syncthreads();
    { int t_ = wave * 64 + lane_id(); asm volatile("" : "+v"(t_)); scan(P, bg, g, Es, t_); }
    asm volatile("s_waitcnt vmcnt(0)" ::: "memory"); __syncthreads();
    { const pg8::Gemm g2{U, (const bf16_t*)(P.ws + WS_TQ), 512, 512, 512};
      og::SchedOne so; so.v.arow = bg * NCH; so.v.brow = g * 256; so.v.pm = 0; so.v.pn = 0;
      pg8::gemm_phase<EpiY, og::SchedOne, false, 0>(ring, g2, so, EpiY{&P, b, g}, wave); }
}
}
namespace p0 {
typedef float f32x4 __attribute__((ext_vector_type(4)));
typedef unsigned u32x2 __attribute__((ext_vector_type(2)));
__device__ __forceinline__ void mod_item(const Ptrs& P, LAS unsigned char* lds, int item, int half, int vt) {
    const int ct = item % 24, ks = item / 24, col = ct * 256 + vt, k0 = ks * 64;
    const float* W = P.in[IN_ADAW] + (size_t)k0 * 6144 + col;
    LAS float* sl = (LAS float*)(lds + 90112 + half * 2048);
    for (int e = vt; e < 320; e += 256) { const int r = e >> 6, k = e & 63; const float c = r < 4 ? P.in[IN_C][r * DM + k0 + k] : P.in[IN_CCTX][k0 + k];
        sl[e] = c * __builtin_amdgcn_rcpf(1.f + __builtin_amdgcn_exp2f(-1.4426950408889634f * c)); }
    __syncthreads();
    float acc[5] = {0.f, 0.f, 0.f, 0.f, 0.f};
#pragma unroll 1
    for (int kb = 0; kb < 64; kb += 16) {
    float wv[16];
#pragma unroll
    for (int k = 0; k < 16; ++k) wv[k] = __builtin_nontemporal_load(W + (size_t)(kb + k) * 6144);
#pragma unroll
    for (int kk = 0; kk < 16; ++kk) {
        const float w = wv[kk];
#pragma unroll
        for (int r = 0; r < 5; ++r) acc[r] += sl[r * 64 + kb + kk] * w;
    }
    }
    float* mod = (float*)(P.ws + WS_MODFIN);
#pragma unroll
    for (int r = 0; r < 5; ++r) atomicAdd(mod + r * 6144 + col, acc[r] + (ks == 0 ? P.in[IN_ADAB][col] : 0.f));
    __syncthreads();
}
__device__ __forceinline__ void biasup_item(const Ptrs& P, int item, int vt) {
    const int ct = item % 22, ks = item / 22, n = ct * 256 + vt, k0 = ks * 64;
    const float* W = P.in[IN_WUP] + (size_t)k0 * NIN + n;
    const float* mod = (const float*)(P.ws + WS_MODFIN) + 3072 + k0;
    float acc[4] = {0.f, 0.f, 0.f, 0.f};
#pragma unroll 1
    for (int kb = 0; kb < 64; kb += 16) {
    float wv[16];
#pragma unroll
    for (int k = 0; k < 16; ++k) wv[k] = __builtin_nontemporal_load(W + (size_t)(kb + k) * NIN);
#pragma unroll
    for (int kk = 0; kk < 16; ++kk) {
        const int k = kb + kk; const float w = wv[kk];
#pragma unroll
        for (int b = 0; b < 4; ++b) acc[b] += mod[b * 6144 + k] * w;
    }
    }
#pragma unroll
    for (int b = 0; b < 4; ++b) atomicAdd((float*)(P.ws + WS_BIASUP) + b * NIN + n, acc[b]);
}
__device__ __forceinline__ void modulate_row(const Ptrs& P, int r, int lane) {
    const float* xr = r < MR ? P.in[IN_X] + (size_t)r * DM : P.in[IN_CTX] + (size_t)(r - MR) * DM;
    const float* mod = (const float*)(P.ws + WS_MODFIN) + (r < MR ? r / SEQL : 4) * 6144;
    f32x4 v[4]; float ss = 0.f;
#pragma unroll
    for (int j = 0; j < 4; ++j) { v[j] = __builtin_nontemporal_load((const f32x4*)(xr + 256 * j + 4 * lane)); ss += (v[j][0] * v[j][0] + v[j][1] * v[j][1]) + (v[j][2] * v[j][2] + v[j][3] * v[j][3]); }
    const float rstd = __builtin_amdgcn_rsqf(wave_sum(ss) * (1.f / DM) + EPSN);
    bf16_t* H = (bf16_t*)(P.ws + WS_RH) + (size_t)r * DM;
#pragma unroll
    for (int j = 0; j < 4; ++j) { const int k = 256 * j + 4 * lane;
        const f32x4 w = *(const f32x4*)(P.in[IN_N1W] + k), sc = *(const f32x4*)(mod + 1024 + k), sh = *(const f32x4*)(mod + k);
        const f32x4 y = v[j] * rstd * w * (sc + 1.f) + sh;
        u32x2 o; o.x = pg8::cvt_pk_bf16(y[0], y[1]); o.y = pg8::cvt_pk_bf16(y[2], y[3]);
        *(u32x2*)(H + k) = o; }
}
__device__ __forceinline__ void modulate_rows(const Ptrs& P, int gw, int NGW, int lane) {
    const int per = (MT + NGW - 1) / NGW;
    int r = gw * per; const int rend = r + per < MT ? r + per : MT;
    if (r >= rend) return;
    f32x4 A[4], B[4], v[4], nv[4]; int curb = -1;
    { const float* xr = r < MR ? P.in[IN_X] + (size_t)r * DM : P.in[IN_CTX] + (size_t)(r - MR) * DM;
#pragma unroll
      for (int j = 0; j < 4; ++j) v[j] = __builtin_nontemporal_load((const f32x4*)(xr + 256 * j + 4 * lane)); }
#pragma unroll 1
    for (; r < rend; ++r) {
        if (r + 1 < rend) { const int rn = r + 1; const float* xr = rn < MR ? P.in[IN_X] + (size_t)rn * DM : P.in[IN_CTX] + (size_t)(rn - MR) * DM;
#pragma unroll
            for (int j = 0; j < 4; ++j) nv[j] = __builtin_nontemporal_load((const f32x4*)(xr + 256 * j + 4 * lane)); }
        const int b = r < MR ? r / SEQL : 4;
        if (b != curb) { curb = b; const float* mod = (const float*)(P.ws + WS_MODFIN) + b * 6144;
#pragma unroll
            for (int j = 0; j < 4; ++j) { const int k = 256 * j + 4 * lane; A[j] = *(const f32x4*)(P.in[IN_N1W] + k) * (*(const f32x4*)(mod + 1024 + k) + 1.f); B[j] = *(const f32x4*)(mod + k); } }
        float ss = 0.f;
#pragma unroll
        for (int j = 0; j < 4; ++j) ss += (v[j][0] * v[j][0] + v[j][1] * v[j][1]) + (v[j][2] * v[j][2] + v[j][3] * v[j][3]);
        const float rstd = __builtin_amdgcn_rsqf(wave_sum(ss) * (1.f / DM) + EPSN);
        bf16_t* H = (bf16_t*)(P.ws + WS_RH) + (size_t)r * DM;
#pragma unroll
        for (int j = 0; j < 4; ++j) { const int k = 256 * j + 4 * lane;
            const f32x4 y = v[j] * rstd * A[j] + B[j];
            u32x2 o; o.x = pg8::cvt_pk_bf16(y[0], y[1]); o.y = pg8::cvt_pk_bf16(y[2], y[3]);
            *(u32x2*)(H + k) = o; }
#pragma unroll
        for (int j = 0; j < 4; ++j) v[j] = nv[j];
    }
}
}

#define XB_TMO      128
#define XB_XCNT(j)  (256  + 64 * (j))
#define XB_XSUB(j)  (1280 + 64 * (j))
#define XB_XGEN(j)  (2304 + 64 * (j))
#define XB_TOP      3328
#define XB_TOPGEN   3392
#define XCD_BAR_WORDS 3456
#define XB_SPIN_CAP (1u << 22)
constexpr int CW_BAR = 4096;

__device__ __forceinline__ unsigned xb_ld(unsigned* p)              { return __hip_atomic_load(p, __ATOMIC_RELAXED, __HIP_MEMORY_SCOPE_AGENT); }
__device__ __forceinline__ unsigned xb_add(unsigned* p, unsigned v) { return __hip_atomic_fetch_add(p, v, __ATOMIC_RELAXED, __HIP_MEMORY_SCOPE_AGENT); }
__device__ __forceinline__ unsigned xb_xcc_id() { return (unsigned)__builtin_amdgcn_s_getreg((3 << 11) | 20) & 0xFu; }
#define XB_SPIN(cond, bar) do { unsigned _sp = 0; while (cond) { __builtin_amdgcn_s_sleep(1); \
    if ((++_sp & 255u) == 0u) { if (xb_ld(&(bar)[XB_TMO])) break; if (_sp > XB_SPIN_CAP) { atomicAdd(&(bar)[XB_TMO], 1u); break; } } } } while (0)
struct XcdBarrier { unsigned* bar; unsigned x; volatile LAS unsigned* st; };
__device__ __forceinline__ XcdBarrier xcd_barrier_post(unsigned* bar, volatile LAS unsigned* st, int tid) {
    XcdBarrier b; b.bar = bar; b.x = xb_xcc_id(); b.st = st;
    if (tid == 0) (void)xb_add(&bar[XB_XCNT(b.x)], 1u);
    return b;
}
__device__ __forceinline__ void xcd_barrier_complete(unsigned* bar, unsigned x, unsigned& nloc, unsigned& nx) {
    const unsigned G = gridDim.x * gridDim.y * gridDim.z;
    unsigned sum, cnt, mine, sp = 0u;
    for (;;) {
        sum = 0u; cnt = 0u; mine = 0u;
#pragma unroll
        for (unsigned j = 0; j < 16; ++j) { const unsigned c = xb_ld(&bar[XB_XCNT(j)]); sum += c; cnt += (c > 0u) ? 1u : 0u; mine = (j == x) ? c : mine; }
        if (sum == G) break;
        __builtin_amdgcn_s_sleep(1);
        if ((++sp & 255u) == 0u) { if (xb_ld(&bar[XB_TMO])) break; if (sp > XB_SPIN_CAP) { atomicAdd(&bar[XB_TMO], 1u); break; } }
    }
    nloc = mine > 0u ? mine : 1u; nx = cnt > 0u ? cnt : 1u;
}
__device__ __forceinline__ void xcd_barrier(const XcdBarrier& b, int wave) {
    const int tid0 = wave * 64 + lane_id();
    asm volatile("s_waitcnt vmcnt(0)" ::: "memory");
    __syncthreads();
    if (tid0 == 0) {
        unsigned* bar = b.bar;
        __builtin_amdgcn_s_waitcnt(0);
        unsigned nloc = b.st[0], nx = b.st[1];
        if (nloc == 0u) { xcd_barrier_complete(bar, b.x, nloc, nx); b.st[0] = nloc; b.st[1] = nx; }
        const unsigned old = xb_add(&bar[XB_XSUB(b.x)], 1u);
        const unsigned gen = old / nloc;
        if (old + 1u == (gen + 1u) * nloc) {
            __builtin_amdgcn_fence(__ATOMIC_RELEASE, "agent");
            asm volatile("s_waitcnt vmcnt(0)" ::: "memory");
            const unsigned og = xb_add(&bar[XB_TOP], 1u);
            const unsigned tg = og / nx;
            if (og + 1u == (tg + 1u) * nx) xb_add(&bar[XB_TOPGEN], 1u);
            else XB_SPIN(xb_ld(&bar[XB_TOPGEN]) == tg, bar);
            xb_add(&bar[XB_XGEN(b.x)], 1u);
            __builtin_amdgcn_fence(__ATOMIC_ACQUIRE, "agent");
            asm volatile("s_waitcnt vmcnt(0)" ::: "memory");
        } else {
            XB_SPIN(xb_ld(&bar[XB_XGEN(b.x)]) == gen, bar);
            __builtin_amdgcn_fence(__ATOMIC_ACQUIRE, "agent");
            asm volatile("s_waitcnt vmcnt(0)" ::: "memory");
        }
    }
    __syncthreads();
}

#ifndef OPT_GEMM
#define OPT_GEMM 1
#endif
#ifndef OPT_P1
#define OPT_P1 1
#endif
#ifndef OPT_P3
#define OPT_P3 1
#endif
#ifndef OPT_P4
#define OPT_P4 1
#endif
#ifndef OPT_ATTN
#define OPT_ATTN 1
#endif
#ifndef OPT_S5
#define OPT_S5 1
#endif
#ifndef OPT_P0
#define OPT_P0 1
#endif
#ifndef REP_P1
#define REP_P1 0
#endif
#ifndef REP_P4
#define REP_P4 0
#endif
#ifndef REP_S5
#define REP_S5 0
#endif
#ifndef REP_ATTN
#define REP_ATTN 0
#endif
#ifndef REP_BAR
#define REP_BAR 0
#endif
#ifndef REP_P3
#define REP_P3 0
#endif
#ifndef REP_P0
#define REP_P0 0
#endif
#ifndef USE_COOP_LAUNCH
#define USE_COOP_LAUNCH 1
#endif
#ifndef OPT_P5
#define OPT_P5 1
#endif
constexpr int LDS_BYTES = 147456;
constexpr int LDS_MISC = LDS_BYTES - 512;
struct Args { Ptrs P; int ph_lo, ph_hi; };

#define PADNOPS(n) asm volatile(".rept %0\n\ts_nop 0\n\t.endr" :: "i"(n))
__global__ void __launch_bounds__(512, 2) mega(Args a) {
    extern __shared__ __attribute__((aligned(16))) unsigned char lds[];
    const Ptrs& P = a.P;
    PADNOPS(PAD_ENTRY);
    const int wave = __builtin_amdgcn_readfirstlane(threadIdx.x >> 6);
    const int lane = lane_id(), tid = wave * 64 + lane, half = tid >> 8, vt = tid & 255;
    const int G = gridDim.x, bx = blockIdx.x;
    if (tid < 128) ((LAS unsigned*)(lds + LDS_MISC))[tid] = 0u;
    __syncthreads();
    XcdBarrier bar = xcd_barrier_post((unsigned*)(P.ws + WS_CTL) + CW_BAR, (volatile LAS unsigned*)(lds + LDS_MISC) + 8, tid);
    char* lh = (char*)lds + half * NB_LDS;
    const int lo = a.ph_lo, hi = a.ph_hi;
#define IN(k) (lo <= (k) && (k) < hi)
#define SEAM(k) do { if (IN(k) && IN((k) + 1)) xcd_barrier(bar, wave); } while (0)
#define VB2(NV) for (int v_ = 2 * bx + half; v_ < (NV); v_ += 2 * G)

    LAS unsigned char* ring = (LAS unsigned char*)lds;
#if REP_P0
    {
    if (IN(0)) {
#if OPT_P0
        VB2(24 * 16) p0::mod_item(P, ring, v_, half, vt);
#else
        VB2(120) nb_mod(P, v_ % 24, v_ / 24, vt);
#endif
        VB2(4) nb_rope(P, v_, vt);
        for (int i = bx * 512 + tid; i < MR + 512; i += G * 512) ((float*)(P.ws + WS_ROWSQ0))[i] = 0.f;
#if OPT_S5
        for (int it = bx; it < NGRP * 8; it += G) s5::build_tables(P, ring, it, tid);
#endif
#if OPT_GEMM
        og::transposes_A(P, ring, bx * 8 + wave, G * 8, wave, lane);
#endif
    }
    xcd_barrier(bar, wave);
    if (IN(1)) {
#if OPT_P0
        for (int r = bx * 8 + wave; r < MT; r += G * 8) p0::modulate_row(P, r, lane);
#else
        VB2(88) nb_biasup(P, v_ % 22, v_ / 22, vt);
        VB2(MT / 4) nb_modulate(P, v_, vt);
#endif
    }
    xcd_barrier(bar, wave);
    for (int i = bx * 512 + tid; i < (int)((768 * 1024 - 512 * 1024) / 4); i += G * 512) ((float*)(P.ws + WS_MODFIN))[i] = 0.f;
    xcd_barrier(bar, wave);
    }
#endif
    if (IN(0)) {
#if OPT_P0
        VB2(24 * 16) p0::mod_item(P, ring, v_, half, vt);
#else
        VB2(120) nb_mod(P, v_ % 24, v_ / 24, vt);
#endif
        VB2(4) nb_rope(P, v_, vt);
        for (int i = bx * 512 + tid; i < MR + 512; i += G * 512) ((float*)(P.ws + WS_ROWSQ0))[i] = 0.f;
#if OPT_S5
        for (int it = bx; it < NGRP * 8; it += G) s5::build_tables(P, ring, it, tid);
#endif
#if OPT_GEMM
        og::transposes_A(P, ring, bx * 8 + wave, G * 8, wave, lane);
#endif
    }
    SEAM(0);
    if (IN(1)) {
#if OPT_P0
        p0::modulate_rows(P, bx * 8 + wave, G * 8, lane);
#else
        VB2(88) nb_biasup(P, v_ % 22, v_ / 22, vt);
        VB2(MT / 4) nb_modulate(P, v_, vt);
#endif
    }
    SEAM(1);
    if (IN(2)) {
#if OPT_GEMM && OPT_P1
        { const pg8::Gemm g{(const bf16_t*)(P.ws + WS_RH), (const bf16_t*)(P.ws + WS_WIN), DM, DM, DM};
          for (int rep_ = 0; rep_ < 1 + REP_P1; ++rep_) pg8::gemm_phase<og::EpiIn, og::SchedIn, true, 0>(ring, g, og::SchedIn{G, bx}, og::EpiIn{&P}, wave); }
        {
            const int nshort = G - (1448 % G), first_short = 1448 % G;
            if (first_short == 0) { for (int v_ = 2 * bx + half; v_ < 22 * 16; v_ += 2 * G) p0::biasup_item(P, v_, vt); }
            else if (bx >= first_short) { for (int v_ = 2 * (bx - first_short) + half; v_ < 22 * 16; v_ += 2 * nshort) p0::biasup_item(P, v_, vt); }
            if (first_short == 0) og::transposes_B(P, ring, bx * 8 + wave, G * 8, wave, lane);
            else if (bx >= first_short) og::transposes_B(P, ring, (bx - first_short) * 8 + wave, nshort * 8, wave, lane);
        }
#else
        VB2((NIN / 64) * (MT / 64)) nb_inproj(P, v_ % (NIN / 64), v_ / (NIN / 64), vt, lh);
#endif
    }
#if REP_BAR
    for (int rb_ = 0; rb_ < 10; ++rb_) xcd_barrier(bar, wave);
#endif
    SEAM(2);
    if (IN(3)) {
#if OPT_GEMM
        og::build_convtab(P, bx * 512 + tid);
#endif
#if OPT_ATTN
#if REP_ATTN
        at::attn_phase(P, ring, G, bx, wave, (bf16_t*)(P.ws + WS_RH)); xcd_barrier(bar, wave);
#endif
        at::attn_phase(P, ring, G, bx, wave, (bf16_t*)(P.ws + WS_RQ));
#else
        if (wave < 4) for (int it = 4 * bx + wave; it < NB * NHEAD * SEQL; it += 4 * G) nb_attn(P, it, lane, (char*)lds + wave * 35328);
#endif
#if OPT_S5
        xcd_barrier(bar, wave);
        PADNOPS(PAD_WIN);
        {
            const int nS = NB * NGRP;
            const pg8::Gemm gya{(const bf16_t*)(P.ws + WS_RQ), (const bf16_t*)(P.ws + WS_WBA), DM, DM, DM};
            if (G > nS) {
                if (bx < nS) { for (int rep_ = 0; rep_ < 1 + REP_S5; ++rep_) s5::s5_item(P, ring, bx, wave); }
                else { PADNOPS(PAD_YA); pg8::gemm_phase<og::EpiBranch<0, 1024>, og::SchedMN, true, 0>(ring, gya, og::SchedMN{64, 4, G - nS, bx - nS}, og::EpiBranch<0, 1024>{&P}, wave); }
            } else {
                for (int it = bx; it < nS; it += G) s5::s5_item(P, ring, it, wave);
                pg8::gemm_phase<og::EpiBranch<0, 1024>, og::SchedMN, true, 0>(ring, gya, og::SchedMN{64, 4, G, bx}, og::EpiBranch<0, 1024>{&P}, wave);
            }
        }
#else
        xcd_barrier(bar, wave);
        for (int it = 8 * bx + wave; it < NB * NGRP * 2; it += 8 * G) nb_s5(P, it, lane);
        xcd_barrier(bar, wave);
        VB2(MR * S5W / 256) nb_s5fin(P, v_, vt);
#endif
    }
    SEAM(3);
    if (IN(4)) {
        PADNOPS(PAD_P3A);
#if OPT_GEMM && OPT_P3
        { const pg8::Gemm g{(const bf16_t*)(P.ws + WS_HS), (const bf16_t*)(P.ws + WS_WGLU), S5W, S5W, S5W};
          for (int rep_ = 0; rep_ < 1 + REP_P3; ++rep_) pg8::gemm_phase<og::EpiGlu, og::SchedMN, true, 0>(ring, g, og::SchedMN{64, 2, G, bx}, og::EpiGlu{&P}, wave);
          if (G > 128) { if (bx >= 128) og::transposes_C(P, ring, (bx - 128) * 8 + wave, (G - 128) * 8, wave, lane); }
          else og::transposes_C(P, ring, bx * 8 + wave, G * 8, wave, lane); }
#else
        VB2((S5W / 64) * (MR / 64)) nb_glu(P, v_ % (S5W / 64), v_ / (S5W / 64), vt, lh);
#endif
    }
    SEAM(4);
    if (IN(5)) {
        PADNOPS(PAD_P3B);
#if OPT_GEMM && OPT_P3
        { const pg8::Gemm g{(const bf16_t*)(P.ws + WS_HS2), (const bf16_t*)(P.ws + WS_WBS), S5W, S5W, S5W};
          pg8::gemm_phase<og::EpiBranch<1, 0>, og::SchedMN, true, 0>(ring, g, og::SchedMN{64, 4, G, bx}, og::EpiBranch<1, 0>{&P}, wave); }
#else
        VB2((DM / 64) * (MR / 64)) nb_ys(P, v_ % (DM / 64), v_ / (DM / 64), vt, lh);
        xcd_barrier(bar, wave);
        VB2((DM / 64) * (MR / 64)) nb_ya(P, v_ % (DM / 64), v_ / (DM / 64), vt, lh);
#endif
    }
    SEAM(5);
    if (IN(6)) {
        PADNOPS(PAD_P3C);
#if OPT_GEMM && OPT_P3
        { const pg8::Gemm g{(const bf16_t*)(P.ws + WS_MB), (const bf16_t*)(P.ws + WS_WOUT), DM, DM, DM};
          pg8::gemm_phase<og::EpiOut, og::SchedMN, true, 0>(ring, g, og::SchedMN{64, 4, G, bx}, og::EpiOut{&P}, wave); }
#else
        VB2((DM / 64) * (MR / 64)) nb_out(P, v_ % (DM / 64), v_ / (DM / 64), vt, lh);
#endif
    }
    SEAM(6);
    if (IN(7)) {
        PADNOPS(PAD_P4);
#if OPT_GEMM && OPT_P4
        { const pg8::Gemm g{(const bf16_t*)(P.ws + WS_X1B), (const bf16_t*)(P.ws + WS_WUP), DM, DM, DM};
          for (int rep_ = 0; rep_ < 1 + REP_P4; ++rep_) pg8::gemm_phase<og::EpiUp, og::SchedUp, true, 2, 1>(ring, g, og::SchedUp{G, bx}, og::EpiUp{&P}, wave); }
#else
        VB2((DFF / 64) * (NB * 67)) nb_up(P, v_ % (DFF / 64), v_ / (DFF / 64), vt, lh);
#endif
    }
    SEAM(7);
    if (IN(8)) {
        PADNOPS(PAD_P5);
#if OPT_GEMM && OPT_P5
        { const pg8::Gemm g{(const bf16_t*)(P.ws + WS_ACT), (const bf16_t*)(P.ws + WS_WDOWN), DFF, DFF, DFF};
          pg8::gemm_phase<og::EpiDown, og::SchedMN, true, 0>(ring, g, og::SchedMN{64, 4, G, bx}, og::EpiDown{&P}, wave); }
#else
        VB2((DM / 64) * (MR / 64)) nb_down(P, v_ % (DM / 64), v_ / (DM / 64), vt, lh);
#endif
    }
#undef IN
#undef SEAM
#undef VB2
}

extern "C" void kernel_launch(void* const* d_in, const int* in_sizes, int n_in, void* d_out, int out_size, void* d_ws, size_t ws_size, hipStream_t stream) {
    static int grid = 0;
    if (grid == 0) {
        if (n_in != 34 || ws_size < WS_END) { fprintf(stderr, "kernel_launch: unexpected inputs (n_in %d, ws %zu)\n", n_in, ws_size); grid = -1; return; }
        int dev = 0, cus = 0, per_cu = 0;
        if (hipGetDevice(&dev) != hipSuccess || hipDeviceGetAttribute(&cus, hipDeviceAttributeMultiprocessorCount, dev) != hipSuccess) { grid = -1; return; }
        if (hipFuncSetAttribute((const void*)mega, hipFuncAttributeMaxDynamicSharedMemorySize, LDS_BYTES) != hipSuccess) { fprintf(stderr, "kernel_launch: hipFuncSetAttribute failed\n"); grid = -1; return; }
        if (hipOccupancyMaxActiveBlocksPerMultiprocessor(&per_cu, (const void*)mega, 512, LDS_BYTES) != hipSuccess || per_cu < 1) { fprintf(stderr, "kernel_launch: occupancy query says %d\n", per_cu); (void)hipGetLastError(); per_cu = 1; }
        grid = cus;
    }
    if (grid < 0) return;
    (void)hipMemsetAsync((char*)d_ws + WS_CTL, 0, 1 * MiB, stream);
    Args a{};
    for (int i = 0; i < 34; ++i) a.P.in[i] = (const float*)d_in[i];
    a.P.out = (float*)d_out; a.P.ws = (unsigned char*)d_ws;
    a.ph_lo = 0; a.ph_hi = 9;
#if USE_COOP_LAUNCH
    void* args[] = {&a};
    hipError_t e = hipLaunchCooperativeKernel((const void*)mega, dim3(grid), dim3(512), args, LDS_BYTES, stream);
    if (e != hipSuccess) fprintf(stderr, "kernel_launch: cooperative launch failed: %s (grid %d)\n", hipGetErrorString(e), grid);
#else
    hipLaunchKernelGGL(mega, dim3(grid), dim3(512), LDS_BYTES, stream, a);
    const hipError_t e = hipPeekAtLastError();
    if (e != hipSuccess) fprintf(stderr, "kernel_launch: launch failed: %s (grid %d)\n", hipGetErrorString(e), grid);
#endif
}
```

```cpp
#include <hip/hip_runtime.h>
#include <cstdint>
#include <cstdio>

constexpr int NB = 4, SEQL = 4096, NCTX = 256, DM = 1024, MR = NB * SEQL, MCX = NB * NCTX, MT = MR + MCX;
constexpr int NHEAD = 8, HDIM = 64, VDIM = 128, S5W = 512, NGRP = 32, NST = 64, DFF = 2816, NIN = 5632;
constexpr int KOFF = 1024, VOFF = 2048, UOFF = 3072, GOFF = 3584;
constexpr int NKEY = NCTX + SEQL, NKT = NKEY / 64, NCH = SEQL / 16 + NCTX / 16;
constexpr float EPSN = 1e-6f, LAM_INIT = 0.2f;
constexpr float C2 = 0.125f * 1.4426950408889634f;

typedef unsigned short bf16_t;
__host__ __device__ __forceinline__ float bf2f(bf16_t v) { union { unsigned u; float f; } x; x.u = ((unsigned)v) << 16; return x.f; }
__host__ __device__ __forceinline__ bf16_t f2bf(float f) { union { unsigned u; float f; } x; x.f = f; return (bf16_t)((x.u + 0x7fffu + ((x.u >> 16) & 1u)) >> 16); }

constexpr size_t MiB = 1u << 20;
#define PAD_ENTRY 15
#define PAD_ATT 12
#define PAD_WIN 11
#define PAD_YA 12
#define PAD_P3A 8
#define PAD_P3B 2
#define PAD_P3C 4
#define PAD_P4 8
#define PAD_P5 15
constexpr size_t WS_CTL = 0;
constexpr size_t WS_MODPART = 1 * MiB;
constexpr size_t WS_MODFIN = 512 * 1024;
constexpr size_t WS_BIASUP = 512 * 1024 + 128 * 1024;
constexpr size_t WS_ROPE = 2 * MiB + 256 * 1024;
constexpr size_t WS_A16 = WS_ROPE + 16384;
constexpr size_t WS_ROWSQ0 = 2 * MiB + 512 * 1024;
constexpr size_t WS_ROWSQ = WS_ROWSQ0 + 256;
constexpr size_t WS_CONVTAB = 4 * MiB;
constexpr size_t WS_BIASPART = 4 * MiB;
constexpr size_t WS_WIN = 6 * MiB;
constexpr size_t WS_WUP = 17 * MiB;
constexpr size_t WS_WDOWN = 28 * MiB;
constexpr size_t WS_WOUT = 34 * MiB;
constexpr size_t WS_WBA = 36 * MiB;
constexpr size_t WS_WBS = 38 * MiB;
constexpr size_t WS_WGLU = 39 * MiB;
constexpr size_t WS_TQ = 40 * MiB;
constexpr size_t WS_PST = 48 * MiB;
constexpr size_t WS_RH = 52 * MiB;
constexpr size_t WS_RQ = 86 * MiB;
constexpr size_t WS_RK = 118 * MiB;
constexpr size_t WS_RV = 152 * MiB;
constexpr size_t WS_RU = 186 * MiB;
constexpr size_t WS_HS = 221 * MiB;
constexpr size_t WS_END = 237 * MiB;
constexpr size_t WS_T = WS_RK;
constexpr size_t WS_MB = WS_RU;
constexpr size_t WS_X1R = WS_RQ;
constexpr size_t WS_X1B = WS_RH + 8192;
constexpr size_t WS_HS2 = WS_RH;
constexpr size_t WS_ACT = WS_RK;
constexpr size_t WS_YTF = WS_RH;
constexpr size_t WS_YTB = WS_RK;

__host__ __device__ __forceinline__ unsigned q_idx(int b, int t, int h, int m, int d) { return (unsigned)((b * SEQL + t) * 1024 + h * 128 + m * 64 + d); }
__host__ __device__ __forceinline__ unsigned k_idx(int b, int h, int m, int key, int d) {
    return (unsigned)((((((b * NHEAD + h) * 2 + m) * NKT + (key >> 6)) * 8 + (d >> 3)) * 64 + (key & 63)) * 8 + (d & 7));
}
__host__ __device__ __forceinline__ unsigned v_idx(int b, int h, int key, int d) {
    const int row = key & 63;
    return (unsigned)(((((b * NHEAD + h) * NKT + (key >> 6)) * 16 + (d >> 5) * 4 + (row >> 4)) * 16 + (row & 15)) * 32 + (d & 31));
}
__host__ __device__ __forceinline__ unsigned u_idx(int b, int g, int chunk, int sig, int c) { return (unsigned)((((b * NGRP + g) * NCH + chunk) * 512) + sig * 16 + c); }

struct Ptrs {
    const float* in[34];
    float* out;
    unsigned char* ws;
};
#define IN_X 0
#define IN_C 1
#define IN_CTX 2
#define IN_CCTX 3
#define IN_ADAW 4
#define IN_ADAB 5
#define IN_N1W 6
#define IN_WIN 7
#define IN_BGATE 8
#define IN_QNW 9
#define IN_KNW 10
#define IN_LQ1 11
#define IN_LK1 12
#define IN_LQ2 13
#define IN_LK2 14
#define IN_SUBLN 15
#define IN_ARE 16
#define IN_AIM 17
#define IN_LOGDT 18
#define IN_BRE 19
#define IN_BIM 20
#define IN_CRE 21
#define IN_CIM 22
#define IN_S5D 23
#define IN_GLUW 24
#define IN_GLUB 25
#define IN_WBS 26
#define IN_WBA 27
#define IN_WOUT 28
#define IN_N2W 29
#define IN_WUP 30
#define IN_CONVW 31
#define IN_CONVB 32
#define IN_WDOWN 33

template <int CTRL> __device__ __forceinline__ float dppmov(float x) { return __builtin_bit_cast(float, __builtin_amdgcn_mov_dpp(__builtin_bit_cast(int, x), CTRL, 0xf, 0xf, true)); }
__device__ __forceinline__ float row16_sum(float v) {
    v += dppmov<0xB1>(v); v += dppmov<0x4E>(v); v += dppmov<0x141>(v); v += dppmov<0x140>(v); return v; }
__device__ __forceinline__ float row16_max(float v) {
    v = fmaxf(v, dppmov<0xB1>(v)); v = fmaxf(v, dppmov<0x4E>(v)); v = fmaxf(v, dppmov<0x141>(v)); v = fmaxf(v, dppmov<0x140>(v)); return v; }
__device__ __forceinline__ float xor16_sum(float x) {
    const auto s = __builtin_amdgcn_permlane16_swap(__float_as_uint(x), __float_as_uint(x), false, false); return __uint_as_float(s[0]) + __uint_as_float(s[1]); }
__device__ __forceinline__ float xor32_sum(float x) {
    const auto s = __builtin_amdgcn_permlane32_swap(__float_as_uint(x), __float_as_uint(x), false, false); return __uint_as_float(s[0]) + __uint_as_float(s[1]); }
__device__ __forceinline__ float xor16_max(float x) { const auto s = __builtin_amdgcn_permlane16_swap(__float_as_uint(x), __float_as_uint(x), false, false); return fmaxf(__uint_as_float(s[0]), __uint_as_float(s[1])); }
__device__ __forceinline__ float xor32_max(float x) { const auto s = __builtin_amdgcn_permlane32_swap(__float_as_uint(x), __float_as_uint(x), false, false); return fmaxf(__uint_as_float(s[0]), __uint_as_float(s[1])); }
__device__ __forceinline__ float wave_sum(float v) { return xor32_sum(xor16_sum(row16_sum(v))); }
__device__ __forceinline__ float wave_max(float v) { return xor32_max(xor16_max(row16_max(v))); }
__device__ __forceinline__ float sigmoidf_(float x) { return 1.f / (1.f + __expf(-x)); }
__device__ __forceinline__ float siluf_(float x) { return x / (1.f + __expf(-x)); }
__device__ __forceinline__ float gelu_tanh(float x) { const float u = 0.7978845608028654f * (x + 0.044715f * x * x * x); return 0.5f * x * (1.f + tanhf(u)); }

#define LAS __attribute__((address_space(3)))
__device__ __forceinline__ int lane_id() { return (int)__builtin_amdgcn_mbcnt_hi(~0u, __builtin_amdgcn_mbcnt_lo(~0u, 0u)); }
constexpr int NB_AS = 0, NB_WS = 4160, NB_Z = 8256, NB_Z2 = 24896, NB_LDS = 41536;

__device__ void nb_mod(const Ptrs& P, int vbx, int vby, int vt) {
    const int col = vbx * 256 + vt, row = vby;
    const float* cv = row < 4 ? P.in[IN_C] + row * DM : P.in[IN_CCTX];
    const float* W = P.in[IN_ADAW];
    float acc = 0.f;
    for (int k = 0; k < DM; ++k) acc += siluf_(cv[k]) * W[(size_t)k * 6144 + col];
    ((float*)(P.ws + WS_MODFIN))[row * 6144 + col] = acc + P.in[IN_ADAB][col];
}
__device__ void nb_biasup(const Ptrs& P, int vbx, int vby, int vt) {
    const int n = vbx * 256 + vt, b = vby;
    const float* sh2 = (const float*)(P.ws + WS_MODFIN) + b * 6144 + 3072;
    const float* W = P.in[IN_WUP];
    float acc = 0.f;
    for (int k = 0; k < DM; ++k) acc += sh2[k] * W[(size_t)k * NIN + n];
    ((float*)(P.ws + WS_BIASUP))[b * NIN + n] = acc;
}
__device__ void nb_rope(const Ptrs& P, int vbx, int vt) {
    const int i = vbx * 256 + vt;
    const int pos = i >> 4, f = i & 15;
    const float inv = powf(10000.f, -(float)(2 * f) / 32.f);
    const float ang = (float)pos * inv;
    float* tab = (float*)(P.ws + WS_ROPE);
    tab[2 * i] = cosf(ang); tab[2 * i + 1] = sinf(ang);
}
__device__ void nb_modulate(const Ptrs& P, int vbx, int vt) {
    const int r = vbx * 4 + (vt >> 6), lane = vt & 63;
    const float* xr = r < MR ? P.in[IN_X] + (size_t)r * DM : P.in[IN_CTX] + (size_t)(r - MR) * DM;
    const float* mod = (const float*)(P.ws + WS_MODFIN) + (r < MR ? r / SEQL : 4) * 6144;
    const float* w = P.in[IN_N1W];
    float v[16]; float ss = 0.f;
#pragma unroll
    for (int j = 0; j < 16; ++j) { v[j] = xr[lane + 64 * j]; ss += v[j] * v[j]; }
    const float rstd = rsqrtf(wave_sum(ss) * (1.f / DM) + EPSN);
    bf16_t* H = (bf16_t*)(P.ws + WS_RH) + (size_t)r * DM;
#pragma unroll
    for (int j = 0; j < 16; ++j) { const int k = lane + 64 * j; H[k] = f2bf(v[j] * rstd * w[k] * (1.f + mod[1024 + k]) + mod[k]); }
}
__device__ void ntile(const bf16_t* A, int lda, long row0, long rowmax, const float* W, int ldw, int col0, int K, char* lh, int zoff, int tid) {
    float (*As)[65] = (float (*)[65])(lh + NB_AS);
    float (*Ws)[64] = (float (*)[64])(lh + NB_WS);
    float (*Z)[65] = (float (*)[65])(lh + zoff);
    const int tx = tid & 15, ty = tid >> 4;
    float acc[4][4];
#pragma unroll
    for (int i = 0; i < 4; ++i)
#pragma unroll
        for (int j = 0; j < 4; ++j) acc[i][j] = 0.f;
    for (int k0 = 0; k0 < K; k0 += 16) {
        {
            const int ar = tid >> 2, ak = (tid & 3) * 4;
            long gr = row0 + ar; gr = gr < 0 ? 0 : (gr > rowmax ? rowmax : gr);
            const bf16_t* ap = A + (size_t)gr * lda + k0 + ak;
#pragma unroll
            for (int q = 0; q < 4; ++q) As[ak + q][ar] = bf2f(ap[q]);
            const int wk = tid >> 4, wc = (tid & 15) * 4;
            const float4 wv = *(const float4*)(W + (size_t)(k0 + wk) * ldw + col0 + wc);
            Ws[wk][wc] = wv.x; Ws[wk][wc + 1] = wv.y; Ws[wk][wc + 2] = wv.z; Ws[wk][wc + 3] = wv.w;
        }
        __syncthreads();
#pragma unroll
        for (int kk = 0; kk < 16; ++kk) {
            float a[4], w[4];
#pragma unroll
            for (int i = 0; i < 4; ++i) a[i] = As[kk][ty * 4 + i];
#pragma unroll
            for (int j = 0; j < 4; ++j) w[j] = Ws[kk][tx * 4 + j];
#pragma unroll
            for (int i = 0; i < 4; ++i)
#pragma unroll
                for (int j = 0; j < 4; ++j) acc[i][j] += a[i] * w[j];
        }
        __syncthreads();
    }
#pragma unroll
    for (int i = 0; i < 4; ++i)
#pragma unroll
        for (int j = 0; j < 4; ++j) Z[ty * 4 + i][tx * 4 + j] = acc[i][j];
    __syncthreads();
}
__device__ void nb_inproj(const Ptrs& P, int vbx, int vby, int tid, char* lh) {
    float (*Z)[65] = (float (*)[65])(lh + NB_Z);
    const int c0 = vbx * 64; const long r0 = (long)vby * 64;
    ntile((const bf16_t*)(P.ws + WS_RH), DM, r0, MT - 1, P.in[IN_WIN], NIN, c0, DM, lh, NB_Z, tid);
    const int lr = tid >> 2, j0 = (tid & 3) * 16;
    const int r = (int)r0 + lr;
    const bool isctx = r >= MR;
    const int b = isctx ? (r - MR) / NCTX : r / SEQL, t = isctx ? (r - MR) % NCTX : r % SEQL;
    const int key = isctx ? t : NCTX + t, chunk = isctx ? 256 + (t >> 4) : (t >> 4), sig = t & 15;
    const float* zr = Z[lr];
    if (c0 < VOFF) {
        const bool isq = c0 < KOFF;
        if (!(isq && isctx)) {
            const float* w = isq ? P.in[IN_QNW] : P.in[IN_KNW];
            float ss = 0.f;
            for (int j = 0; j < 64; ++j) ss += zr[j] * zr[j];
            const float rs = rsqrtf(ss * (1.f / 64.f) + EPSN);
            const int cc = isq ? c0 : c0 - KOFF, h = cc / 128, m = (cc / 64) & 1;
            const float* tab = (const float*)(P.ws + WS_ROPE);
            for (int d = j0; d < j0 + 16; ++d) {
                float val = zr[d] * rs * w[d];
                if (!isctx) {
                    const int half = d >> 5, dd = d & 31, i = dd & 15, second = dd >> 4;
                    const int pd = second ? d - 16 : d + 16;
                    const float pv = zr[pd] * rs * w[pd];
                    const int pos = half == 0 ? (t >> 6) : (t & 63);
                    const float cs = tab[(pos * 16 + i) * 2], sn = tab[(pos * 16 + i) * 2 + 1];
                    val = second ? (val * cs + pv * sn) : (val * cs - pv * sn);
                }
                if (isq) ((bf16_t*)(P.ws + WS_RQ))[q_idx(b, t, h, m, d)] = f2bf(val * C2);
                else ((bf16_t*)(P.ws + WS_RK))[k_idx(b, h, m, key, d)] = f2bf(val);
            }
        }
    } else if (c0 < UOFF) {
        const int cc = c0 - VOFF, h = cc / 128, dbase = cc % 128;
        for (int j = j0; j < j0 + 16; ++j) ((bf16_t*)(P.ws + WS_RV))[v_idx(b, h, key, dbase + j)] = f2bf(zr[j]);
    } else if (c0 < GOFF) {
        for (int j = j0; j < j0 + 16; ++j) { const int cc = c0 - UOFF + j; ((bf16_t*)(P.ws + WS_RU))[u_idx(b, cc >> 4, chunk, sig, cc & 15)] = f2bf(zr[j]); }
    } else if (!isctx) {
        bf16_t* G = (bf16_t*)P.out;
        for (int j = j0; j < j0 + 16; ++j) { const int cc = c0 - GOFF + j; G[(size_t)r * 2048 + cc] = f2bf(sigmoidf_(zr[j] + P.in[IN_BGATE][cc])); }
    }
    __syncthreads();
}
__device__ void nb_attn(const Ptrs& P, int item, int lane, char* lw) {
    float* p0 = (float*)lw; float* p1 = p0 + NKEY; float* qs = p1 + NKEY;
    const int b = item / (NHEAD * SEQL), h = (item / SEQL) % NHEAD, t = item % SEQL;
    bf16_t* Q = (bf16_t*)(P.ws + WS_RQ); const bf16_t* K = (const bf16_t*)(P.ws + WS_RK); const bf16_t* V = (const bf16_t*)(P.ws + WS_RV);
    qs[lane] = bf2f(Q[q_idx(b, t, h, 0, lane)]); qs[64 + lane] = bf2f(Q[q_idx(b, t, h, 1, lane)]);
    const float lam = __expf(wave_sum(P.in[IN_LQ1][lane] * P.in[IN_LK1][lane])) - __expf(wave_sum(P.in[IN_LQ2][lane] * P.in[IN_LK2][lane])) + LAM_INIT;
    const float mshift = 8.f * 1.4426950408889634f * wave_max(fabsf(P.in[IN_QNW][lane])) * wave_max(fabsf(P.in[IN_KNW][lane]));
    __builtin_amdgcn_s_waitcnt(0xc07f); __builtin_amdgcn_wave_barrier();
    float l0 = 0.f, l1 = 0.f;
    for (int i = 0; i < NKT; ++i) {
        const int key = i * 64 + lane;
#pragma unroll
        for (int m = 0; m < 2; ++m) {
            float s = 0.f;
#pragma unroll
            for (int ch = 0; ch < 8; ++ch) {
                const uint4 kv = *(const uint4*)(K + k_idx(b, h, m, key, ch * 8));
                const unsigned w[4] = {kv.x, kv.y, kv.z, kv.w};
#pragma unroll
                for (int e = 0; e < 4; ++e) { s += qs[m * 64 + ch * 8 + 2 * e] * bf2f((bf16_t)(w[e] & 0xffff)) + qs[m * 64 + ch * 8 + 2 * e + 1] * bf2f((bf16_t)(w[e] >> 16)); }
            }
            const float p = exp2f(s - mshift);
            if (m == 0) { p0[key] = p; l0 += p; } else { p1[key] = p; l1 += p; }
        }
    }
    l0 = wave_sum(l0); l1 = wave_sum(l1);
    __builtin_amdgcn_s_waitcnt(0xc07f); __builtin_amdgcn_wave_barrier();
    const float i0 = 1.f / l0, i1 = lam / l1;
    float o0 = 0.f, o1 = 0.f;
    for (int key = 0; key < NKEY; ++key) {
        const float a = p0[key] * i0 - p1[key] * i1;
        o0 += a * bf2f(V[v_idx(b, h, key, lane)]); o1 += a * bf2f(V[v_idx(b, h, key, lane + 64)]);
    }
    const float rs = rsqrtf(wave_sum(o0 * o0 + o1 * o1) * (1.f / 128.f) + EPSN) * (1.f - LAM_INIT);
    bf16_t* On = Q;
    const size_t ob = ((size_t)(b * SEQL + t)) * 1024 + h * 128;
    On[ob + lane] = f2bf(o0 * rs * P.in[IN_SUBLN][lane]); On[ob + 64 + lane] = f2bf(o1 * rs * P.in[IN_SUBLN][64 + lane]);
    __builtin_amdgcn_s_waitcnt(0xc07f); __builtin_amdgcn_wave_barrier();
}
__device__ void nb_s5(const Ptrs& P, int item, int p) {
    const int d = item & 1, bg = item >> 1, b = bg / NGRP, g = bg % NGRP;
    const int gi = (d * NGRP + g) * NST + p;
    const float lre = fminf(P.in[IN_ARE][gi], -1e-4f), lim = P.in[IN_AIM][gi], dt = __expf(P.in[IN_LOGDT][d * NGRP + g]);
    const float mag = __expf(lre * dt); float sn, cs; sincosf(lim * dt, &sn, &cs);
    const float ar = mag * cs, ai = mag * sn;
    const float nr = ar - 1.f, ni = ai, den = lre * lre + lim * lim;
    const float fr = (nr * lre + ni * lim) / den, fi = (ni * lre - nr * lim) / den;
    float bre[16], bim[16], cre[16], cim[16];
#pragma unroll
    for (int c = 0; c < 16; ++c) {
        const float br = P.in[IN_BRE][(size_t)gi * 16 + c], bi = P.in[IN_BIM][(size_t)gi * 16 + c];
        bre[c] = fr * br - fi * bi; bim[c] = fr * bi + fi * br;
        cre[c] = P.in[IN_CRE][((size_t)(d * NGRP + g) * 16 + c) * NST + p]; cim[c] = P.in[IN_CIM][((size_t)(d * NGRP + g) * 16 + c) * NST + p];
    }
    const bf16_t* U = (const bf16_t*)(P.ws + WS_RU);
    float* yt = (float*)(P.ws + (d == 0 ? WS_YTF : WS_YTB)) + (size_t)(b * NGRP + g) * SEQL * 16;
    float sr = 0.f, si = 0.f;
    for (int step = 0; step < NKEY; ++step) {
        const bool isctx = step < NCTX;
        const int idx = isctx ? step : step - NCTX;
        const int t = d == 0 ? idx : (isctx ? NCTX - 1 - idx : SEQL - 1 - idx);
        const int chunk = isctx ? 256 + (t >> 4) : (t >> 4);
        const bf16_t* up = U + u_idx(b, g, chunk, t & 15, 0);
        float bur = 0.f, bui = 0.f;
#pragma unroll
        for (int c = 0; c < 16; ++c) { const float u = bf2f(up[c]); bur += bre[c] * u; bui += bim[c] * u; }
        const float nsr = ar * sr - ai * si + bur, nsi = ar * si + ai * sr + bui;
        sr = nsr; si = nsi;
        if (!isctx) {
            float mine = 0.f;
#pragma unroll
            for (int c = 0; c < 16; ++c) { const float v = wave_sum(cre[c] * sr - cim[c] * si); if (p == c) mine = v; }
            if (p < 16) yt[(size_t)t * 16 + p] = mine;
        }
    }
}
__device__ void nb_s5fin(const Ptrs& P, int vbx, int vt) {
    const size_t i = (size_t)vbx * 256 + vt;
    const int ch = (int)(i % 512); const size_t bt = i / 512; const int b = (int)(bt / SEQL), t = (int)(bt % SEQL), g = ch >> 4, c = ch & 15;
    const float u = bf2f(((const bf16_t*)(P.ws + WS_RU))[u_idx(b, g, t >> 4, t & 15, c)]);
    const size_t yi = ((size_t)(b * NGRP + g) * SEQL + t) * 16 + c;
    const float y = P.in[IN_S5D][ch] * u + ((const float*)(P.ws + WS_YTF))[yi] + ((const float*)(P.ws + WS_YTB))[yi];
    ((bf16_t*)(P.ws + WS_HS))[i] = f2bf(gelu_tanh(y));
}
__device__ void nb_glu(const Ptrs& P, int vbx, int vby, int tid, char* lh) {
    float (*Z)[65] = (float (*)[65])(lh + NB_Z);
    const int c0 = vbx * 64; const long r0 = (long)vby * 64;
    const bf16_t* Hs = (const bf16_t*)(P.ws + WS_HS);
    ntile(Hs, S5W, r0, MR - 1, P.in[IN_GLUW], S5W, c0, S5W, lh, NB_Z, tid);
    const int lr = tid >> 2, j0 = (tid & 3) * 16; const size_t r = r0 + lr;
    for (int j = j0; j < j0 + 16; ++j) { const int c = c0 + j; ((bf16_t*)(P.ws + WS_HS2))[r * S5W + c] = f2bf(bf2f(Hs[r * S5W + c]) * sigmoidf_(Z[lr][j] + P.in[IN_GLUB][c])); }
    __syncthreads();
}
__device__ void nb_ys(const Ptrs& P, int vbx, int vby, int tid, char* lh) {
    float (*Z)[65] = (float (*)[65])(lh + NB_Z);
    const int c0 = vbx * 64; const long r0 = (long)vby * 64;
    ntile((const bf16_t*)(P.ws + WS_HS2), S5W, r0, MR - 1, P.in[IN_WBS], DM, c0, S5W, lh, NB_Z, tid);
    const int lr = tid >> 2, j0 = (tid & 3) * 16; const size_t r = r0 + lr;
    const bf16_t* G = (const bf16_t*)P.out;
    for (int j = j0; j < j0 + 16; ++j) { const int c = c0 + j; ((float*)(P.ws + WS_T))[r * DM + c] = bf2f(G[r * 2048 + c]) * Z[lr][j]; }
    __syncthreads();
}
__device__ void nb_ya(const Ptrs& P, int vbx, int vby, int tid, char* lh) {
    float (*Z)[65] = (float (*)[65])(lh + NB_Z);
    const int c0 = vbx * 64; const long r0 = (long)vby * 64;
    ntile((const bf16_t*)(P.ws + WS_RQ), DM, r0, MR - 1, P.in[IN_WBA], DM, c0, DM, lh, NB_Z, tid);
    const int lr = tid >> 2, j0 = (tid & 3) * 16; const size_t r = r0 + lr;
    const bf16_t* G = (const bf16_t*)P.out;
    for (int j = j0; j < j0 + 16; ++j) { const int c = c0 + j; ((bf16_t*)(P.ws + WS_MB))[r * DM + c] = f2bf(((const float*)(P.ws + WS_T))[r * DM + c] + bf2f(G[r * 2048 + 1024 + c]) * Z[lr][j]); }
    __syncthreads();
}
__device__ void nb_out(const Ptrs& P, int vbx, int vby, int tid, char* lh) {
    float (*Z)[65] = (float (*)[65])(lh + NB_Z);
    const int c0 = vbx * 64; const long r0 = (long)vby * 64;
    ntile((const bf16_t*)(P.ws + WS_MB), DM, r0, MR - 1, P.in[IN_WOUT], DM, c0, DM, lh, NB_Z, tid);
    const int lr = tid >> 2, j0 = (tid & 3) * 16; const size_t r = r0 + lr; const int b = (int)(r / SEQL);
    const float* mod = (const float*)(P.ws + WS_MODFIN) + b * 6144;
    float ss = 0.f;
    for (int j = j0; j < j0 + 16; ++j) {
        const int c = c0 + j;
        const float x1 = P.in[IN_X][r * DM + c] + mod[2048 + c] * Z[lr][j];
        P.out[r * DM + c] = x1;
        ((bf16_t*)(P.ws + WS_X1B))[r * DM + c] = f2bf(x1 * P.in[IN_N2W][c] * (1.f + mod[4096 + c]));
        ss += x1 * x1;
    }
    ss += __shfl_xor(ss, 1); ss += __shfl_xor(ss, 2);
    if ((tid & 3) == 0) atomicAdd((float*)(P.ws + WS_ROWSQ) + r, ss);
    __syncthreads();
}
__device__ void nb_up(const Ptrs& P, int vbx, int vby, int tid, char* lh) {
    float (*Za)[65] = (float (*)[65])(lh + NB_Z);
    float (*Zg)[65] = (float (*)[65])(lh + NB_Z2);
    const int c0 = vbx * 64;
    const int b = vby / 67, ti = vby % 67;
    const long r0 = (long)b * SEQL + 62 * ti - 1;
    const bf16_t* A = (const bf16_t*)(P.ws + WS_X1B);
    ntile(A, DM, r0, MR - 1, P.in[IN_WUP], NIN, c0, DM, lh, NB_Z, tid);
    ntile(A, DM, r0, MR - 1, P.in[IN_WUP], NIN, DFF + c0, DM, lh, NB_Z2, tid);
    const int lr = tid >> 2, j0 = (tid & 3) * 16;
    {
        const int tok = 62 * ti + lr - 1; const bool valid = tok >= 0 && tok < SEQL;
        float rstd = 0.f;
        if (valid) { const size_t r = (size_t)b * SEQL + tok; rstd = rsqrtf(((const float*)(P.ws + WS_ROWSQ))[r] * (1.f / DM) + EPSN); }
        const float* bu = (const float*)(P.ws + WS_BIASUP) + b * NIN;
        for (int j = j0; j < j0 + 16; ++j) { Za[lr][j] = valid ? rstd * Za[lr][j] + bu[c0 + j] : 0.f; Zg[lr][j] = valid ? rstd * Zg[lr][j] + bu[DFF + c0 + j] : 0.f; }
    }
    __syncthreads();
    const int tok = 62 * ti + lr - 1;
    if (lr >= 1 && lr <= 62 && tok < SEQL) {
        const float* cw = P.in[IN_CONVW]; const float* cb = P.in[IN_CONVB];
        const size_t r = (size_t)b * SEQL + tok;
        for (int j = j0; j < j0 + 16; ++j) {
            const int ca = c0 + j, cg = DFF + c0 + j;
            const float ya = cb[ca] + cw[ca] * Za[lr - 1][j] + cw[NIN + ca] * Za[lr][j] + cw[2 * NIN + ca] * Za[lr + 1][j];
            const float yg = cb[cg] + cw[cg] * Zg[lr - 1][j] + cw[NIN + cg] * Zg[lr][j] + cw[2 * NIN + cg] * Zg[lr + 1][j];
            ((bf16_t*)(P.ws + WS_ACT))[r * DFF + ca] = f2bf(siluf_(yg) * ya);
        }
    }
    __syncthreads();
}
__device__ void nb_down(const Ptrs& P, int vbx, int vby, int tid, char* lh) {
    float (*Z)[65] = (float (*)[65])(lh + NB_Z);
    const int c0 = vbx * 64; const long r0 = (long)vby * 64;
    ntile((const bf16_t*)(P.ws + WS_ACT), DFF, r0, MR - 1, P.in[IN_WDOWN], DM, c0, DFF, lh, NB_Z, tid);
    const int lr = tid >> 2, j0 = (tid & 3) * 16; const size_t r = r0 + lr; const int b = (int)(r / SEQL);
    const float* mod = (const float*)(P.ws + WS_MODFIN) + b * 6144;
    for (int j = j0; j < j0 + 16; ++j) { const int c = c0 + j; P.out[r * DM + c] = P.out[r * DM + c] + mod[5120 + c] * Z[lr][j]; }
    __syncthreads();
}
namespace pg8 {
typedef short bf16x8 __attribute__((ext_vector_type(8)));
typedef float f32x4 __attribute__((ext_vector_type(4)));
typedef unsigned u32x4 __attribute__((ext_vector_type(4)));
typedef unsigned u32x2 __attribute__((ext_vector_type(2)));
constexpr int BM = 256, BK = 64, HALF = 128, HTB = HALF * BK * 2, STAGE_BYTES = 8 * HTB;
__host__ __device__ __forceinline__ int lds_byte(int r, int c) { const int st = (r >> 4) * 2 + (c >> 5), rr = r & 15, cc = c & 31, ob = rr * 64 + cc * 2; return st * 1024 + (ob ^ (((ob >> 9) & 1) << 5)); }
__host__ __device__ __forceinline__ void stage_rc(int b, int& R, int& C) { const int st = b / 1024, sb = b % 1024, swz = sb ^ (((sb >> 9) & 1) << 5); R = (st >> 1) * 16 + swz / 64; C = (st & 1) * 32 + (swz % 64) / 2; }
__host__ __device__ __forceinline__ int perm32(int rho) { const int n = rho >> 4, i = rho & 15; return 8 * (i >> 2) + 4 * n + (i & 3); }
struct Unit { int arow, brow, pm, pn; };
struct Gemm { const bf16_t* A; const bf16_t* Bt; int K, lda, ldb; };
typedef float f32x2c __attribute__((ext_vector_type(2))); typedef __bf16 bf16x2c __attribute__((ext_vector_type(2)));
__device__ __forceinline__ unsigned cvt_pk_bf16(float lo, float hi) { const f32x2c v = {lo, hi}; const bf16x2c b = __builtin_convertvector(v, bf16x2c); return __builtin_bit_cast(unsigned, b); }

template <class Epi, class Sched, bool ALIGN_EPI, int SHR, int APERM = 0>
__device__ __forceinline__ void gemm_phase(LAS unsigned char* lds, const Gemm g, const Sched& S, const Epi& E, int wave) {
    int tid_ = wave * 64 + lane_id(); asm volatile("" : "+v"(tid_));
    const int tid = tid_, wid = __builtin_amdgcn_readfirstlane(tid >> 6), lane = tid & 63, wr = wid >> 2, wc = wid & 3, fr = lane & 15, fq = lane >> 4;
    int nt_ = g.K / BK; asm volatile("" : "+s"(nt_)); const int nt = nt_;
    unsigned voffA[2], voffB[2];
#pragma unroll
    for (int i = 0; i < 2; ++i) { int R, C; stage_rc(tid * 16 + i * 8192, R, C); const int Rb = Epi::PERM ? ((R & ~31) + perm32(R & 31)) : R;
        const int Ra = APERM ? (R & ~63) + 4 * (R & 15) + ((R >> 4) & 3) : R;
        voffA[i] = (unsigned)((Ra - SHR * (R >> 6)) * g.lda + C) * 2u; voffB[i] = (unsigned)(Rb * g.ldb + C) * 2u; }
    const size_t kstep = (size_t)(BK * 2);
    const size_t hA = (size_t)(HALF - 2 * SHR) * g.lda * 2, hB = (size_t)HALF * g.ldb * 2;
    const unsigned ldsw = (unsigned)wid * 1024u;
    const int aoff = lds_byte(wr * 64 + fr, fq * 8), boff = lds_byte(wc * 32 + fr, fq * 8);
#define PG8_SA(b, h) (((b) * 2 + (h)) * HTB)
#define PG8_SB(b, h) ((4 + (b) * 2 + (h)) * HTB)
#define PG8_STAGE(bufoff, gbase, voff) do { _Pragma("unroll") for (int _i = 0; _i < 2; ++_i) \
        __builtin_amdgcn_global_load_lds((const unsigned*)((const char*)(gbase) + (voff)[_i]), (LAS unsigned*)(lds + (bufoff) + ldsw + _i * 8192), 16, 0, 0); } while (0)
#define PG8_LDA(dst, b, h) do { _Pragma("unroll") for (int m = 0; m < 4; ++m) _Pragma("unroll") for (int k = 0; k < 2; ++k) dst[m][k] = *(const LAS bf16x8*)(lds + PG8_SA(b, h) + aoff + m * 2048 + k * 1024); } while (0)
#define PG8_LDB(dst, b, h) do { _Pragma("unroll") for (int n = 0; n < 2; ++n) _Pragma("unroll") for (int k = 0; k < 2; ++k) dst[n][k] = *(const LAS bf16x8*)(lds + PG8_SB(b, h) + boff + n * 2048 + k * 1024); } while (0)
#define PG8_MMA(ai, bj, At, Bt) do { __builtin_amdgcn_s_setprio(1); _Pragma("unroll") for (int m = 0; m < 4; ++m) _Pragma("unroll") for (int n = 0; n < 2; ++n) _Pragma("unroll") for (int k = 0; k < 2; ++k) \
        acc[ai][bj][m][n] = __builtin_amdgcn_mfma_f32_16x16x32_bf16(Bt[n][k], At[m][k], acc[ai][bj][m][n], 0, 0, 0); __builtin_amdgcn_s_setprio(0); } while (0)
#define PG8_WAIT_V(n) asm volatile("s_waitcnt vmcnt(" #n ")" ::: "memory")
#define PG8_WAIT_L(n) asm volatile("s_waitcnt lgkmcnt(" #n ")" ::: "memory")
#define PG8_BAR __builtin_amdgcn_s_barrier()
#define PG8_SCHED __builtin_amdgcn_sched_barrier(0)
    Unit cur, nxt; int ui = 0;
    if (!S.next(0, cur)) return;
    f32x4 acc[2][2][4][2];
#pragma unroll
    for (int a = 0; a < 2; ++a)
#pragma unroll
        for (int b = 0; b < 2; ++b)
#pragma unroll
            for (int m = 0; m < 4; ++m)
#pragma unroll
                for (int n = 0; n < 2; ++n) acc[a][b][m][n] = (f32x4){0.f, 0.f, 0.f, 0.f};
    bf16x8 At[4][2], B0[2][2], B1[2][2];
    const char* cA = (const char*)g.A + (long)cur.arow * g.lda * 2; const char* cB = (const char*)g.Bt + (long)cur.brow * g.ldb * 2;
    PG8_STAGE(PG8_SB(0, 0), cB, voffB); PG8_STAGE(PG8_SB(0, 1), cB + hB, voffB); PG8_STAGE(PG8_SA(0, 0), cA, voffA); PG8_STAGE(PG8_SA(0, 1), cA + hA, voffA);
    if (wr == 1) PG8_BAR;
    PG8_WAIT_V(2); PG8_BAR;
    PG8_STAGE(PG8_SB(1, 0), cB + kstep, voffB); PG8_STAGE(PG8_SA(1, 0), cA + kstep, voffA); PG8_STAGE(PG8_SB(1, 1), cB + hB + kstep, voffB);
    PG8_WAIT_V(6); PG8_BAR;
    for (;;) {
        const bool has_next = S.next(ui + 1, nxt);
        const char* nA = has_next ? (const char*)g.A + (long)nxt.arow * g.lda * 2 : cA; const char* nB = has_next ? (const char*)g.Bt + (long)nxt.brow * g.ldb * 2 : cB;
#pragma unroll 1
        for (int t = 0; t < nt; t += 2) {
            asm volatile("" : "+v"(voffA[0]), "+v"(voffA[1]), "+v"(voffB[0]), "+v"(voffB[1]));
            const bool last = (t == nt - 2);
            const char* a1 = cA + (size_t)(t + 1) * kstep;
            const char* a2 = last ? nA : cA + (size_t)(t + 2) * kstep; const char* b2 = last ? nB : cB + (size_t)(t + 2) * kstep;
            const char* a3 = a2 + kstep; const char* b3 = b2 + kstep;
            asm volatile("" : "+s"(a3), "+s"(b3));
            PG8_LDB(B0, 0, 0); PG8_LDB(B1, 0, 1); PG8_SCHED; PG8_LDA(At, 0, 0); PG8_STAGE(PG8_SA(1, 1), a1 + hA, voffA);
            PG8_WAIT_V(8); PG8_WAIT_L(0); PG8_BAR; PG8_MMA(0, 0, At, B0); PG8_MMA(0, 1, At, B1); PG8_BAR; PG8_SCHED;
            PG8_LDA(At, 0, 1); PG8_STAGE(PG8_SB(0, 0), b2, voffB); PG8_STAGE(PG8_SB(0, 1), b2 + hB, voffB); PG8_STAGE(PG8_SA(0, 0), a2, voffA);
            PG8_WAIT_V(8); PG8_WAIT_L(0); PG8_BAR; PG8_MMA(1, 0, At, B0); PG8_MMA(1, 1, At, B1); PG8_BAR; PG8_SCHED;
            PG8_LDB(B0, 1, 0); PG8_LDB(B1, 1, 1); PG8_SCHED; PG8_LDA(At, 1, 0); PG8_STAGE(PG8_SA(0, 1), a2 + hA, voffA);
            PG8_WAIT_V(8); PG8_WAIT_L(0); PG8_BAR; PG8_MMA(0, 0, At, B0); PG8_MMA(0, 1, At, B1); PG8_BAR; PG8_SCHED;
            PG8_LDA(At, 1, 1); PG8_STAGE(PG8_SB(1, 0), b3, voffB); PG8_STAGE(PG8_SB(1, 1), b3 + hB, voffB); PG8_STAGE(PG8_SA(1, 0), a3, voffA);
            PG8_WAIT_V(8); PG8_WAIT_L(0); PG8_BAR; PG8_MMA(1, 0, At, B0); PG8_MMA(1, 1, At, B1); PG8_BAR; PG8_SCHED;
        }
        if constexpr (ALIGN_EPI) { if (wr == 0) PG8_BAR; }
        { int fr_ = fr, fq_ = fq, wr_ = wr, wc_ = wc; asm volatile("" : "+v"(fr_), "+v"(fq_), "+s"(wr_), "+s"(wc_));
          E(acc, cur, wr_, wc_, fr_, fq_); }
        if (!has_next) break;
#pragma unroll
        for (int a = 0; a < 2; ++a)
#pragma unroll
            for (int b = 0; b < 2; ++b)
#pragma unroll
                for (int m = 0; m < 4; ++m)
#pragma unroll
                    for (int n = 0; n < 2; ++n) acc[a][b][m][n] = (f32x4){0.f, 0.f, 0.f, 0.f};
        cur = nxt; cA = nA; cB = nB; ++ui;
        if constexpr (ALIGN_EPI) { if (wr == 1) PG8_BAR; }
    }
    PG8_WAIT_V(0);
    if constexpr (!ALIGN_EPI) { if (wr == 0) PG8_BAR; }
    PG8_BAR;
#undef PG8_SA
#undef PG8_SB
#undef PG8_STAGE
#undef PG8_LDA
#undef PG8_LDB
#undef PG8_MMA
#undef PG8_WAIT_V
#undef PG8_WAIT_L
#undef PG8_BAR
#undef PG8_SCHED
}
}
namespace og {
using pg8::Unit; using pg8::f32x4; using pg8::u32x4; using pg8::u32x2; using pg8::cvt_pk_bf16;
__device__ __forceinline__ void grid2d(int L, int nM, int nN, int& pm, int& pn) {
    const int nwg = nM * nN; int wgid = L;
    { const int q = nwg / 8, r = nwg % 8, xcd = wgid % 8, off = wgid / 8; wgid = (xcd < r ? xcd * (q + 1) : r * (q + 1) + (xcd - r) * q) + off; }
    const int nig = 8 * nN, gid = wgid / nig, fm = gid * 8, gsz = (nM - fm) < 8 ? (nM - fm) : 8;
    pm = fm + ((wgid % nig) % gsz); pn = (wgid % nig) / gsz;
}
struct SchedMN { int nM, nN, G, c;
    __device__ __forceinline__ bool next(int i, Unit& u) const { const int L = i * G + c; if (L >= nM * nN) return false; grid2d(L, nM, nN, u.pm, u.pn); u.arow = 256 * u.pm; u.brow = 256 * u.pn; return true; } };
struct SchedIn { int G, c;
    __device__ __forceinline__ bool next(int i, Unit& u) const { const int L = i * G + c;
        if (L < 1408) { grid2d(L, 64, 22, u.pm, u.pn); } else if (L < 1448) { const int lc = L - 1408; u.pm = 64 + lc / 10; u.pn = 4 + lc % 10; } else return false;
        u.arow = 256 * u.pm; u.brow = 256 * u.pn; return true; } };
struct SchedUp { int G, c;
    __device__ __forceinline__ bool next(int i, Unit& u) const { const int L = i * G + c; if (L >= 68 * 22) return false; grid2d(L, 68, 22, u.pm, u.pn);
        u.arow = (u.pm / 17) * SEQL + 248 * (u.pm % 17) - 1; u.brow = 256 * u.pn; return true; } };
struct SchedOne { Unit v; __device__ __forceinline__ bool next(int i, Unit& u) const { if (i) return false; u = v; return true; } };

__device__ __forceinline__ u32x4 pack8(const f32x4 a, const f32x4 b) { u32x4 w; w.x = cvt_pk_bf16(a[0], a[1]); w.y = cvt_pk_bf16(a[2], a[3]); w.z = cvt_pk_bf16(b[0], b[1]); w.w = cvt_pk_bf16(b[2], b[3]); return w; }
__device__ __forceinline__ u32x2 pack4(const f32x4 a) { u32x2 w; w.x = cvt_pk_bf16(a[0], a[1]); w.y = cvt_pk_bf16(a[2], a[3]); return w; }
__device__ __forceinline__ u32x4 ld_nt(const u32x4* p) { return __builtin_nontemporal_load(p); }
__device__ __forceinline__ f32x4 ld_nt(const f32x4* p) { return __builtin_nontemporal_load(p); }
__device__ __forceinline__ f32x4 unpk_lo(const u32x4 w) { return (f32x4){__uint_as_float(w.x << 16), __uint_as_float(w.x & 0xffff0000u), __uint_as_float(w.y << 16), __uint_as_float(w.y & 0xffff0000u)}; }
__device__ __forceinline__ f32x4 unpk_hi(const u32x4 w) { return (f32x4){__uint_as_float(w.z << 16), __uint_as_float(w.z & 0xffff0000u), __uint_as_float(w.w << 16), __uint_as_float(w.w & 0xffff0000u)}; }
__device__ __forceinline__ float sigf(float x) { return __builtin_amdgcn_rcpf(1.f + __builtin_amdgcn_exp2f(-1.4426950408889634f * x)); }
__device__ __forceinline__ f32x4 sig4(const f32x4 x) { return (f32x4){sigf(x[0]), sigf(x[1]), sigf(x[2]), sigf(x[3])}; }

struct EpiIn {
    static constexpr bool PERM = true;
    const Ptrs* Pp;
    __device__ __forceinline__ void operator()(const f32x4 (&acc)[2][2][4][2], const Unit& u, int wr, int wc, int fr, int fq) const {
        const Ptrs& P = *Pp;
        const bool isctx = u.pm >= 64; const int pn = u.pn;
        if (pn < 8) {
            const bool isq = pn < 4;
            const float* w = isq ? P.in[IN_QNW] : P.in[IN_KNW];
            f32x4 wv[2][2];
#pragma unroll
            for (int bj = 0; bj < 2; ++bj)
#pragma unroll
                for (int n = 0; n < 2; ++n) wv[bj][n] = *(const f32x4*)(w + 32 * bj + 16 * n + 4 * fq);
            const int h = (pn & 3) * 2 + (wc >> 1), mm = wc & 1;
            const float* tab = (const float*)(P.ws + WS_ROPE);
#pragma unroll
            for (int ai = 0; ai < 2; ++ai)
#pragma unroll
                for (int m = 0; m < 4; ++m) {
                    const int r = 256 * u.pm + 128 * ai + 64 * wr + 16 * m + fr;
                    const int b = isctx ? (r - MR) / NCTX : r / SEQL, t = isctx ? (r - MR) % NCTX : r % SEQL, key = isctx ? t : NCTX + t;
                    float ss = 0.f;
#pragma unroll
                    for (int bj = 0; bj < 2; ++bj)
#pragma unroll
                        for (int n = 0; n < 2; ++n) { const f32x4 x = acc[ai][bj][m][n]; ss += (x[0] * x[0] + x[1] * x[1]) + (x[2] * x[2] + x[3] * x[3]); }
                    ss = xor32_sum(xor16_sum(ss));
                    const float rs = __builtin_amdgcn_rsqf(ss * (1.f / 64.f) + EPSN);
#pragma unroll
                    for (int bj = 0; bj < 2; ++bj) {
                        f32x4 x1 = acc[ai][bj][m][0] * rs * wv[bj][0], x2 = acc[ai][bj][m][1] * rs * wv[bj][1];
                        if (!isctx) {
                            const int pos = bj == 0 ? (t >> 6) : (t & 63);
                            const f32x4 t0 = *(const f32x4*)(tab + (pos * 16 + 4 * fq) * 2), t1 = *(const f32x4*)(tab + (pos * 16 + 4 * fq) * 2 + 4);
                            const f32x4 cs = (f32x4){t0[0], t0[2], t1[0], t1[2]}, sn = (f32x4){t0[1], t0[3], t1[1], t1[3]};
                            const f32x4 o1 = x1 * cs - x2 * sn, o2 = x2 * cs + x1 * sn;
                            x1 = o1; x2 = o2;
                        }
                        if (isq) {
                            bf16_t* q = (bf16_t*)(P.ws + WS_RQ);
                            *(u32x2*)(q + q_idx(b, t, h, mm, 32 * bj + 4 * fq)) = pack4(x1 * C2);
                            *(u32x2*)(q + q_idx(b, t, h, mm, 32 * bj + 16 + 4 * fq)) = pack4(x2 * C2);
                        } else {
                            bf16_t* k = (bf16_t*)(P.ws + WS_RK);
                            *(u32x2*)(k + k_idx(b, h, mm, key, 32 * bj + 4 * fq)) = pack4(x1);
                            *(u32x2*)(k + k_idx(b, h, mm, key, 32 * bj + 16 + 4 * fq)) = pack4(x2);
                        }
                    }
                }
        } else if (pn < 12) {
#pragma unroll
            for (int ai = 0; ai < 2; ++ai)
#pragma unroll
                for (int m = 0; m < 4; ++m) {
                    const int r = 256 * u.pm + 128 * ai + 64 * wr + 16 * m + fr;
                    const int b = isctx ? (r - MR) / NCTX : r / SEQL, t = isctx ? (r - MR) % NCTX : r % SEQL, key = isctx ? t : NCTX + t;
#pragma unroll
                    for (int bj = 0; bj < 2; ++bj)
                        *(u32x4*)((bf16_t*)(P.ws + WS_RV) + v_idx(b, 2 * (pn - 8) + bj, key, 32 * wc + 8 * fq)) = pack8(acc[ai][bj][m][0], acc[ai][bj][m][1]);
                }
        } else if (pn < 14) {
#pragma unroll
            for (int ai = 0; ai < 2; ++ai)
#pragma unroll
                for (int m = 0; m < 4; ++m) {
                    const int r = 256 * u.pm + 128 * ai + 64 * wr + 16 * m + fr;
                    const int b = isctx ? (r - MR) / NCTX : r / SEQL, t = isctx ? (r - MR) % NCTX : r % SEQL;
                    const int chunk = isctx ? 256 + (t >> 4) : (t >> 4), sig = t & 15;
#pragma unroll
                    for (int bj = 0; bj < 2; ++bj) { const int c = 256 * (pn - 12) + 128 * bj + 32 * wc + 8 * fq;
                        *(u32x4*)((bf16_t*)(P.ws + WS_RU) + u_idx(b, c >> 4, chunk, sig, c & 15)) = pack8(acc[ai][bj][m][0], acc[ai][bj][m][1]); }
                }
        } else if (!isctx) {
#pragma unroll
            for (int bj = 0; bj < 2; ++bj) {
                const int c = 256 * (pn - 14) + 128 * bj + 32 * wc + 8 * fq;
                const f32x4 b0 = *(const f32x4*)(P.in[IN_BGATE] + c), b1 = *(const f32x4*)(P.in[IN_BGATE] + c + 4);
#pragma unroll
                for (int ai = 0; ai < 2; ++ai)
#pragma unroll
                    for (int m = 0; m < 4; ++m) {
                        const int r = 256 * u.pm + 128 * ai + 64 * wr + 16 * m + fr;
                        *(u32x4*)((bf16_t*)P.out + (size_t)r * 2048 + c) = pack8(sig4(acc[ai][bj][m][0] + b0), sig4(acc[ai][bj][m][1] + b1));
                    }
            }
        }
    }
};
struct EpiGlu {
    static constexpr bool PERM = true;
    const Ptrs* Pp;
    __device__ __forceinline__ void operator()(const f32x4 (&acc)[2][2][4][2], const Unit& u, int wr, int wc, int fr, int fq) const {
        const Ptrs& P = *Pp;
#pragma unroll
        for (int bj = 0; bj < 2; ++bj) {
            const int c = 256 * u.pn + 128 * bj + 32 * wc + 8 * fq;
            const f32x4 b0 = *(const f32x4*)(P.in[IN_GLUB] + c), b1 = *(const f32x4*)(P.in[IN_GLUB] + c + 4);
#pragma unroll
            for (int ai = 0; ai < 2; ++ai)
#pragma unroll
                for (int m = 0; m < 4; ++m) {
                    const size_t r = 256 * u.pm + 128 * ai + 64 * wr + 16 * m + fr;
                    const u32x4 hs = *(const u32x4*)((const bf16_t*)(P.ws + WS_HS) + r * S5W + c);
                    *(u32x4*)((bf16_t*)(P.ws + WS_HS2) + r * S5W + c) = pack8(unpk_lo(hs) * sig4(acc[ai][bj][m][0] + b0), unpk_hi(hs) * sig4(acc[ai][bj][m][1] + b1));
                }
        }
    }
};
template <int STEP, int GO> struct EpiBranch {
    static constexpr bool PERM = true;
    const Ptrs* Pp;
    __device__ __forceinline__ void operator()(const f32x4 (&acc)[2][2][4][2], const Unit& u, int wr, int wc, int fr, int fq) const {
        const Ptrs& P = *Pp;
#pragma unroll
        for (int ai = 0; ai < 2; ++ai)
#pragma unroll
            for (int m = 0; m < 4; ++m) {
                const size_t r = 256 * u.pm + 128 * ai + 64 * wr + 16 * m + fr;
#pragma unroll
                for (int bj = 0; bj < 2; ++bj) {
                    const int c = 256 * u.pn + 128 * bj + 32 * wc + 8 * fq;
                    const u32x4 gt = *(const u32x4*)((const bf16_t*)P.out + r * 2048 + GO + c);
                    bf16_t* T = (bf16_t*)(P.ws + WS_T) + r * DM + c;
                    if (STEP == 0) { *(u32x4*)T = pack8(unpk_lo(gt) * acc[ai][bj][m][0], unpk_hi(gt) * acc[ai][bj][m][1]); }
                    else { const u32x4 tt = *(const u32x4*)T;
                        *(u32x4*)((bf16_t*)(P.ws + WS_MB) + r * DM + c) = pack8(unpk_lo(tt) + unpk_lo(gt) * acc[ai][bj][m][0], unpk_hi(tt) + unpk_hi(gt) * acc[ai][bj][m][1]); }
                }
            }
    }
};
struct EpiOut {
    static constexpr bool PERM = true;
    const Ptrs* Pp;
    __device__ __forceinline__ void operator()(const f32x4 (&acc)[2][2][4][2], const Unit& u, int wr, int wc, int fr, int fq) const {
        const Ptrs& P = *Pp;
        const int b = u.pm / 16;
        const float* mod = (const float*)(P.ws + WS_MODFIN) + b * 6144;
        f32x4 ga[2][2], sw[2][2];
#pragma unroll
        for (int bj = 0; bj < 2; ++bj)
#pragma unroll
            for (int n = 0; n < 2; ++n) { const int c = 256 * u.pn + 128 * bj + 32 * wc + 8 * fq + 4 * n;
                ga[bj][n] = *(const f32x4*)(mod + 2048 + c); sw[bj][n] = *(const f32x4*)(P.in[IN_N2W] + c) * (*(const f32x4*)(mod + 4096 + c) + 1.f); }
        float ssg[8];
#pragma unroll
        for (int ai = 0; ai < 2; ++ai)
#pragma unroll
            for (int m = 0; m < 4; ++m) {
                const size_t r = 256 * u.pm + 128 * ai + 64 * wr + 16 * m + fr;
                float ss = 0.f;
#pragma unroll
                for (int bj = 0; bj < 2; ++bj) {
                    const int c = 256 * u.pn + 128 * bj + 32 * wc + 8 * fq;
                    const f32x4 x0 = ld_nt((const f32x4*)(P.in[IN_X] + r * DM + c)) + ga[bj][0] * acc[ai][bj][m][0], x1 = ld_nt((const f32x4*)(P.in[IN_X] + r * DM + c + 4)) + ga[bj][1] * acc[ai][bj][m][1];
                    *(u32x4*)((bf16_t*)(P.ws + WS_X1R) + r * DM + c) = pack8(x0, x1);
                    *(u32x4*)((bf16_t*)(P.ws + WS_X1B) + r * DM + c) = pack8(x0 * sw[bj][0], x1 * sw[bj][1]);
                    ss += (x0[0] * x0[0] + x0[1] * x0[1]) + (x0[2] * x0[2] + x0[3] * x0[3]) + (x1[0] * x1[0] + x1[1] * x1[1]) + (x1[2] * x1[2] + x1[3] * x1[3]);
                }
                ssg[ai * 4 + m] = xor32_sum(xor16_sum(ss));
            }
        { const float v0 = fq == 0 ? ssg[0] : fq == 1 ? ssg[1] : fq == 2 ? ssg[2] : ssg[3], v1 = fq == 0 ? ssg[4] : fq == 1 ? ssg[5] : fq == 2 ? ssg[6] : ssg[7];
          float* rq = (float*)(P.ws + WS_ROWSQ) + 256 * u.pm + 64 * wr + 16 * fq + fr;
          atomicAdd(rq, v0); atomicAdd(rq + 128, v1); }
    }
};
struct EpiDown {
    static constexpr bool PERM = true;
    const Ptrs* Pp;
    __device__ __forceinline__ void operator()(const f32x4 (&acc)[2][2][4][2], const Unit& u, int wr, int wc, int fr, int fq) const {
        const Ptrs& P = *Pp;
        const float* mod = (const float*)(P.ws + WS_MODFIN) + (u.pm / 16) * 6144 + 5120;
#pragma unroll
        for (int bj = 0; bj < 2; ++bj) {
            const int c = 256 * u.pn + 128 * bj + 32 * wc + 8 * fq;
            const f32x4 g0 = *(const f32x4*)(mod + c), g1 = *(const f32x4*)(mod + c + 4);
#pragma unroll
            for (int ai = 0; ai < 2; ++ai)
#pragma unroll
                for (int m = 0; m < 4; ++m) {
                    const size_t e = (size_t)(256 * u.pm + 128 * ai + 64 * wr + 16 * m + fr) * DM + c;
                    const u32x4 xr = ld_nt((const u32x4*)((const bf16_t*)(P.ws + WS_X1R) + e));
                    float* o = P.out + e;
                    __builtin_nontemporal_store(unpk_lo(xr) + g0 * acc[ai][bj][m][0], (f32x4*)o); __builtin_nontemporal_store(unpk_hi(xr) + g1 * acc[ai][bj][m][1], (f32x4*)(o + 4));
                }
        }
    }
};
__device__ __forceinline__ float dpp_ror1(float v) { return __int_as_float(__builtin_amdgcn_mov_dpp(__float_as_int(v), 0x121, 0xf, 0xf, true)); }
__device__ __forceinline__ float dpp_rol1(float v) { return __int_as_float(__builtin_amdgcn_mov_dpp(__float_as_int(v), 0x12f, 0xf, 0xf, true)); }
__device__ __forceinline__ float dpp_shr1_zero(float v) { return __int_as_float(__builtin_amdgcn_mov_dpp(__float_as_int(v), 0x111, 0xf, 0xf, true)); }
__device__ __forceinline__ float dpp_shl1_zero(float v) { return __int_as_float(__builtin_amdgcn_mov_dpp(__float_as_int(v), 0x101, 0xf, 0xf, true)); }
__device__ __forceinline__ float dpp_shr1_keep(float old, float v) { return __int_as_float(__builtin_amdgcn_update_dpp(__float_as_int(old), __float_as_int(v), 0x111, 0xf, 0xf, false)); }
__device__ __forceinline__ float dpp_shl1_keep(float old, float v) { return __int_as_float(__builtin_amdgcn_update_dpp(__float_as_int(old), __float_as_int(v), 0x101, 0xf, 0xf, false)); }
struct EpiUp {
    static constexpr bool PERM = true;
    const Ptrs* Pp;
    __device__ __forceinline__ void operator()(const f32x4 (&acc)[2][2][4][2], const Unit& u, int wr_, int wc_, int fr_, int fq_) const {
        const Ptrs& P = *Pp;
        const int wr = wr_, wc = wc_, fr = fr_, fq = fq_;
        const int b = u.pm / 17, ti = u.pm % 17;
        const float* rq = (const float*)(P.ws + WS_ROWSQ) + (size_t)b * SEQL + 248 * ti + 62 * wr + 4 * fr - 1;
        const f32x4* ct = (const f32x4*)(P.ws + WS_CONVTAB) + (size_t)((((b * 22 + u.pn) * 4 + wc) * 4 + fq) * 20);
        const int ca0 = 128 * u.pn + 32 * wc + 8 * fq;
        float rstd[2][4]; bool valid[2][4];
#pragma unroll
        for (int ai = 0; ai < 2; ++ai)
#pragma unroll
            for (int m = 0; m < 4; ++m) {
                const int tok = 248 * ti + 62 * (2 * ai + wr) + 4 * fr + m - 1;
                valid[ai][m] = tok >= 0 && tok < SEQL;
                rstd[ai][m] = __builtin_amdgcn_rsqf(rq[124 * ai + m] * (1.f / DM) + EPSN);
            }
        bf16_t* ACT = (bf16_t*)(P.ws + WS_ACT);
        f32x4 nw0 = ct[0], nw1 = ct[1], nw2 = ct[2], nbb = ct[3], nbv = ct[4];
#pragma unroll
        for (int ai = 0; ai < 2; ++ai) {
            float ya[4][2][4];
#pragma unroll
            for (int bj = 0; bj < 2; ++bj)
#pragma unroll
                for (int n = 0; n < 2; ++n) {
                    const f32x4 w0 = nw0, w1 = nw1, w2 = nw2, bb = nbb, bv = nbv;
                    { const int gn = (bj * 2 + n + 1) & 3;
                      if (!(ai == 1 && bj == 1 && n == 1)) { nw0 = ct[gn * 5 + 0]; nw1 = ct[gn * 5 + 1]; nw2 = ct[gn * 5 + 2]; nbb = ct[gn * 5 + 3]; nbv = ct[gn * 5 + 4]; } }
                    __builtin_amdgcn_sched_barrier(0);
#pragma unroll
                    for (int j = 0; j < 4; ++j) {
                        float x[4], up[4], dn[4];
#pragma unroll
                        for (int m = 0; m < 4; ++m) { const float v = acc[ai][bj][m][n][j] * rstd[ai][m] + bv[j]; x[m] = valid[ai][m] ? v : 0.f; }
                        up[0] = dpp_shr1_zero(x[3]);
                        dn[3] = dpp_shl1_zero(x[0]);
#pragma unroll
                        for (int m = 1; m < 4; ++m) up[m] = x[m - 1];
#pragma unroll
                        for (int m = 0; m < 3; ++m) dn[m] = x[m + 1];
#pragma unroll
                        for (int m = 0; m < 4; ++m) {
                            const float y = bb[j] + w0[j] * up[m] + w1[j] * x[m] + w2[j] * dn[m];
                            if (bj == 0) ya[m][n][j] = y; else ya[m][n][j] = y * __builtin_amdgcn_rcpf(1.f + __builtin_amdgcn_exp2f(-1.4426950408889634f * y)) * ya[m][n][j];
                        }
                        asm volatile("" : "+v"(ya[0][n][j]), "+v"(ya[1][n][j]), "+v"(ya[2][n][j]), "+v"(ya[3][n][j]));
                        __builtin_amdgcn_sched_barrier(0);
                    }
                    asm volatile("" ::: "memory");
                }
#pragma unroll
            for (int m = 0; m < 4; ++m) {
                const int w = 4 * fr + m, tok = 248 * ti + 62 * (2 * ai + wr) + w - 1;
                u32x4 o; o.x = cvt_pk_bf16(ya[m][0][0], ya[m][0][1]); o.y = cvt_pk_bf16(ya[m][0][2], ya[m][0][3]); o.z = cvt_pk_bf16(ya[m][1][0], ya[m][1][1]); o.w = cvt_pk_bf16(ya[m][1][2], ya[m][1][3]);
                if (w >= 1 && w <= 62 && tok < SEQL) *(u32x4*)(ACT + ((size_t)b * SEQL + tok) * DFF + ca0) = o;
                __builtin_amdgcn_sched_barrier(0);
            }
        }
    }
};

__device__ __forceinline__ unsigned f2bf_u(float f) { unsigned u = __float_as_uint(f); return (u + 0x7fffu + ((u >> 16) & 1u)) >> 16; }
__device__ __forceinline__ unsigned pk2(float lo, float hi) { return f2bf_u(lo) | (f2bf_u(hi) << 16); }
template <class F>
__device__ __forceinline__ void transpose_item(const float* W, int K, int N, bf16_t* WT, LAS float* scr, int item, int lane, F srccol) {
    const int nblk = N / 32, kb = item / nblk, nb = item % nblk, k0 = 64 * kb, n0 = 32 * nb;
    const int col = srccol(n0 + (lane & 31));
    float v_[32];
#pragma unroll
    for (int i = 0; i < 32; ++i) v_[i] = __builtin_nontemporal_load(W + (size_t)(k0 + 2 * i + (lane >> 5)) * N + col);
#pragma unroll
    for (int i = 0; i < 32; ++i) scr[(2 * i + (lane >> 5)) * 33 + (lane & 31)] = v_[i];
    asm volatile("s_waitcnt lgkmcnt(0)" ::: "memory");
    const int c = lane & 7;
#pragma unroll
    for (int j = 0; j < 4; ++j) { const int n = (lane >> 3) + 8 * j; const LAS float* s = scr + (8 * c) * 33 + n;
        u32x4 o; o.x = cvt_pk_bf16(s[0 * 33], s[1 * 33]); o.y = cvt_pk_bf16(s[2 * 33], s[3 * 33]); o.z = cvt_pk_bf16(s[4 * 33], s[5 * 33]); o.w = cvt_pk_bf16(s[6 * 33], s[7 * 33]);
        *(u32x4*)(WT + (size_t)(n0 + n) * K + k0 + 8 * c) = o; }
    asm volatile("s_waitcnt lgkmcnt(0)" ::: "memory");
}
__device__ __forceinline__ void build_convtab(const Ptrs& P, int gtid) {
    if (gtid >= 1408 * 80) return;
    const int e = gtid % 80, entry = gtid / 80, bj = e / 40, n = (e / 20) & 1, k = (e >> 2) % 5, j = e & 3;
    const int fq = entry & 3, wc = (entry >> 2) & 3, pn = (entry >> 4) % 22, b = entry / 352;
    const int col = bj * DFF + 128 * pn + 32 * wc + 8 * fq + 4 * n + j;
    const float v = k < 3 ? P.in[IN_CONVW][k * NIN + col] : (k == 3 ? P.in[IN_CONVB][col] : ((const float*)(P.ws + WS_BIASUP))[b * NIN + col]);
    ((float*)(P.ws + WS_CONVTAB))[gtid] = v;
}
struct ColId { __device__ __forceinline__ int operator()(int n) const { return n; } };
struct ColIn { __device__ __forceinline__ int operator()(int n) const {
        if (n >= 2048) return n; const int s = n & 255, bj = s >> 7, wc = (s >> 5) & 3, fq = (s >> 3) & 3, nn = (s >> 2) & 1, j = s & 3; return (n & ~255) + 64 * wc + 32 * bj + 16 * nn + 4 * fq + j; } };
struct ColUp { __device__ __forceinline__ int operator()(int n) const { const int pn = n >> 8, s = n & 255; return s < 128 ? 128 * pn + s : DFF + 128 * pn + (s - 128); } };
constexpr int I_IN = 16 * 176, I_UP = 16 * 176, I_DN = 44 * 32, I_OUT = 16 * 32, I_BA = 16 * 32, I_BS = 8 * 32, I_GLU = 8 * 16;
constexpr int NTR_ITEMS = I_IN + I_UP + I_DN + I_OUT + I_BA + I_BS + I_GLU;
__device__ __forceinline__ void transpose_setA(const Ptrs& P, LAS float* scr, int r, int lane) {
    if (r < I_IN) { transpose_item(P.in[IN_WIN], DM, NIN, (bf16_t*)(P.ws + WS_WIN), scr, r, lane, ColIn()); return; } r -= I_IN;
    transpose_item(P.in[IN_GLUW], S5W, S5W, (bf16_t*)(P.ws + WS_WGLU), scr, r, lane, ColId());
}
__device__ __forceinline__ void transpose_setB(const Ptrs& P, LAS float* scr, int r, int lane) {
    if (r < I_OUT) { transpose_item(P.in[IN_WOUT], DM, DM, (bf16_t*)(P.ws + WS_WOUT), scr, r, lane, ColId()); return; } r -= I_OUT;
    if (r < I_BA) { transpose_item(P.in[IN_WBA], DM, DM, (bf16_t*)(P.ws + WS_WBA), scr, r, lane, ColId()); return; } r -= I_BA;
    transpose_item(P.in[IN_WBS], S5W, DM, (bf16_t*)(P.ws + WS_WBS), scr, r, lane, ColId());
}
__device__ __forceinline__ void transpose_setC(const Ptrs& P, LAS float* scr, int r, int lane) {
    if (r < I_UP) { transpose_item(P.in[IN_WUP], DM, NIN, (bf16_t*)(P.ws + WS_WUP), scr, r, lane, ColUp()); return; } r -= I_UP;
    transpose_item(P.in[IN_WDOWN], DFF, DM, (bf16_t*)(P.ws + WS_WDOWN), scr, r, lane, ColId());
}
constexpr int NTR_A = I_IN + I_GLU, NTR_B = I_OUT + I_BA + I_BS, NTR_C = I_UP + I_DN;
__device__ __forceinline__ void transposes_A(const Ptrs& P, LAS unsigned char* lds, int gw, int NGW, int wave, int lane) {
    LAS float* scr = (LAS float*)(lds + wave * 8704);
    for (int it = gw; it < NTR_A; it += NGW) transpose_setA(P, scr, it, lane);
}
__device__ __forceinline__ void transposes_B(const Ptrs& P, LAS unsigned char* lds, int gw, int NGW, int wave, int lane) {
    LAS float* scr = (LAS float*)(lds + wave * 8704);
    for (int it = gw; it < NTR_B; it += NGW) transpose_setB(P, scr, it, lane);
}
__device__ __forceinline__ void transposes_C(const Ptrs& P, LAS unsigned char* lds, int gw, int NGW, int wave, int lane) {
    LAS float* scr = (LAS float*)(lds + wave * 8704);
    for (int it = gw; it < NTR_C; it += NGW) transpose_setC(P, scr, it, lane);
}
}
#ifndef PROBE_MFMA
#define PROBE_MFMA 0
#endif
#ifndef PROBE_EXP
#define PROBE_EXP 0
#endif
#ifndef PROBE_LDS
#define PROBE_LDS 0
#endif
namespace at {
typedef float f32x16 __attribute__((ext_vector_type(16)));
typedef short bf16x8 __attribute__((ext_vector_type(8)));
typedef short s16x4 __attribute__((ext_vector_type(4)));
typedef unsigned u32x4 __attribute__((ext_vector_type(4)));
typedef float f32x4v __attribute__((ext_vector_type(4)));
constexpr int SLOT = 32768, XOFF = 65536, WSF = 131072;
__device__ __forceinline__ int crow(int r, int hi) { return (r & 3) + 8 * (r >> 2) + 4 * hi; }
typedef float f32x2_t __attribute__((ext_vector_type(2))); typedef __bf16 bf16x2_t __attribute__((ext_vector_type(2)));
__device__ __forceinline__ unsigned cvtpk(float lo, float hi) { f32x2_t v = {lo, hi}; bf16x2_t b = __builtin_convertvector(v, bf16x2_t); return __builtin_bit_cast(unsigned, b); }
__device__ __forceinline__ s16x4 vtr(const LAS unsigned char* p) { return __builtin_bit_cast(s16x4, __builtin_amdgcn_ds_read_tr16_b64_v4i16((LAS s16x4*)p)); }
#define AT_WAITBAR(N) asm volatile("s_waitcnt vmcnt(" #N ") lgkmcnt(0)\n\ts_barrier" ::: "memory")

struct Srcs { const char* k0; const char* k1; const char* v; unsigned lo; };
__device__ __forceinline__ void glds16(const char* sbase, unsigned voff, unsigned lds_dst) { unsigned keep;
    asm volatile("s_mov_b32 %0, m0\n\ts_mov_b32 m0, %3\n\ts_nop 0\n\tglobal_load_lds_dwordx4 %1, %2\n\ts_mov_b32 m0, %0" : "=&s"(keep) : "v"(voff), "s"(sbase), "s"(lds_dst) : "memory"); }
__device__ __forceinline__ void dma_piece(unsigned lds0, const Srcs& s, int t, int slot, int wid, int pc) {
    const unsigned d = (unsigned)__builtin_amdgcn_readfirstlane((int)(lds0 + slot * SLOT + wid * 1024));
    if (pc == 0) glds16(s.k0 + (size_t)t * 8192, s.lo, d);
    else if (pc == 1) glds16(s.k1 + (size_t)t * 8192, s.lo, d + 8192);
    else if (pc == 2) glds16(s.v + (size_t)t * 16384, s.lo, d + 16384 + wid * 1024);
    else glds16(s.v + (size_t)t * 16384 + 1024, s.lo, d + 16384 + wid * 1024 + 1024);
}
__device__ __forceinline__ void dma_tile(unsigned lds0, const Srcs& s, int t, int slot, int wid) {
#pragma unroll
    for (int pc = 0; pc < 4; ++pc) dma_piece(lds0, s, t, slot, wid, pc);
}
__device__ __forceinline__ Srcs unit_srcs(const Ptrs& P, int unit, int wid, int lane) {
    const int b = unit / (NHEAD * 32), h = (unit / 32) % NHEAD;
    Srcs s;
    s.k0 = (const char*)((const bf16_t*)(P.ws + WS_RK) + k_idx(b, h, 0, 0, 0)) + wid * 1024;
    s.k1 = (const char*)((const bf16_t*)(P.ws + WS_RK) + k_idx(b, h, 1, 0, 0)) + wid * 1024;
    s.v = (const char*)((const bf16_t*)(P.ws + WS_RV) + v_idx(b, h, 0, 0)) + wid * 2048;
    s.lo = (unsigned)lane * 16u;
    return s;
}
__device__ __forceinline__ void attn_unit(const Ptrs& P, LAS unsigned char* lds, int unit, int next_unit, bool first, float lam, float mshift, int wid, bf16_t* Obase) {
    int lane_ = lane_id(); asm volatile("" : "+v"(lane_));
    const int lane = lane_, r32 = lane & 31, hi = lane >> 5;
    const int mp = wid >> 2, wq = wid & 3;
    const int b = unit / (NHEAD * 32), h = (unit / 32) % NHEAD, q0 = (unit % 32) * 128;
    const Srcs S = unit_srcs(P, unit, wid, lane);
    const unsigned lds0 = (unsigned)(uintptr_t)lds;
    if (first) { dma_tile(lds0, S, 0, 0, wid); dma_tile(lds0, S, 1, 1, wid); }
    bf16_t* Qg = (bf16_t*)(P.ws + WS_RQ);
    bf16x8 qr[4];
#pragma unroll
    for (int d0 = 0; d0 < 4; ++d0) qr[d0] = *(const bf16x8*)(Qg + q_idx(b, q0 + wq * 32 + r32, h, mp, d0 * 16 + hi * 8));
    const f32x16 zero16 = (f32x16){0.f, 0.f, 0.f, 0.f, 0.f, 0.f, 0.f, 0.f, 0.f, 0.f, 0.f, 0.f, 0.f, 0.f, 0.f, 0.f};
    f32x16 o[4];
#pragma unroll
    for (int d0 = 0; d0 < 4; ++d0) o[d0] = zero16;
    float s0 = 0.f, s1 = 0.f;
    const int koff = mp * 8192 + hi * 1024 + r32 * 16;
    const int voff = 16384 + ((lane >> 4) & 1) * 32 + (lane & 3) * 8 + (4 * hi + ((lane & 15) >> 2)) * 64;
#define AT_SB() __builtin_amdgcn_sched_barrier(0)
#define AT_VF(src, k4) (bf16x8){src[2 * (k4)][0], src[2 * (k4)][1], src[2 * (k4)][2], src[2 * (k4)][3], src[2 * (k4) + 1][0], src[2 * (k4) + 1][1], src[2 * (k4) + 1][2], src[2 * (k4) + 1][3]}
#define AT_VT(vs_, d0, j) vtr(vs_ + (d0) * 4096 + ((j) >> 1) * 1024 + ((j) & 1) * 512)
#define AT_PACK() do { _Pragma("unroll") for (int q = 0; q < 4; ++q) { pw[0][q] = cvtpk(p0[2 * q], p0[2 * q + 1]); pw[1][q] = cvtpk(p0[8 + 2 * q], p0[8 + 2 * q + 1]); pw[2][q] = cvtpk(p1[2 * q], p1[2 * q + 1]); pw[3][q] = cvtpk(p1[8 + 2 * q], p1[8 + 2 * q + 1]); } } while (0)
    AT_WAITBAR(4);
    if (2 < NKT) dma_tile(lds0, S, 2, 2, wid);
    f32x16 p0, p1; u32x4 pw[4];
    {
        const LAS unsigned char* ks = lds + koff;
        bf16x8 kf[8];
#pragma unroll
        for (int i = 0; i < 8; ++i) kf[i] = *(const LAS bf16x8*)(ks + (i >> 1) * 2048 + (i & 1) * 512);
#pragma unroll
        for (int d0 = 0; d0 < 4; ++d0) {
            p0 = __builtin_amdgcn_mfma_f32_32x32x16_bf16(kf[2 * d0], qr[d0], d0 == 0 ? zero16 : p0, 0, 0, 0);
            p1 = __builtin_amdgcn_mfma_f32_32x32x16_bf16(kf[2 * d0 + 1], qr[d0], d0 == 0 ? zero16 : p1, 0, 0, 0);
        }
#pragma unroll
        for (int r = 0; r < 16; ++r) { p0[r] = __builtin_amdgcn_exp2f(p0[r]); p1[r] = __builtin_amdgcn_exp2f(p1[r]); s0 += p0[r]; s1 += p1[r]; }
    }
    for (int t = 0; t < NKT; ++t) {
        const bool more = t + 1 < NKT;
        if (t + 2 < NKT) { AT_WAITBAR(4); } else { AT_WAITBAR(0); }
        const bool pf = t + 3 < NKT;
        const LAS unsigned char* ks = lds + ((t + 1) & 3) * SLOT + koff;
        const LAS unsigned char* vs = lds + (t & 3) * SLOT + voff;
        bf16x8 kf[8]; s16x4 va[8], vb[8];
        if (more) {
#pragma unroll
            for (int i = 0; i < 8; ++i) kf[i] = *(const LAS bf16x8*)(ks + (i >> 1) * 2048 + (i & 1) * 512);
        }
#pragma unroll
        for (int j = 0; j < 8; ++j) va[j] = AT_VT(vs, 0, j);
        AT_SB();
        AT_PACK();
        AT_SB();
        if (more) {
#pragma unroll
            for (int i = 0; i < 8; ++i) {
                if ((i & 1) == 0) p0 = __builtin_amdgcn_mfma_f32_32x32x16_bf16(kf[i], qr[i >> 1], i < 2 ? zero16 : p0, 0, 0, 0);
                else p1 = __builtin_amdgcn_mfma_f32_32x32x16_bf16(kf[i], qr[i >> 1], i < 2 ? zero16 : p1, 0, 0, 0);
                vb[i] = AT_VT(vs, 1, i);
                if ((i & 1) && pf) dma_piece(lds0, S, t + 3, (t + 3) & 3, wid, i >> 1);
                AT_SB();
            }
        } else {
#pragma unroll
            for (int j = 0; j < 8; ++j) vb[j] = AT_VT(vs, 1, j);
            AT_SB();
        }
#pragma unroll
        for (int i = 0; i < 16; ++i) {
            const int d0 = i >> 2, k4 = i & 3;
            if ((d0 & 1) == 0) o[d0] = __builtin_amdgcn_mfma_f32_32x32x16_bf16(__builtin_bit_cast(bf16x8, pw[k4]), AT_VF(va, k4), o[d0], 0, 0, 0);
            else o[d0] = __builtin_amdgcn_mfma_f32_32x32x16_bf16(__builtin_bit_cast(bf16x8, pw[k4]), AT_VF(vb, k4), o[d0], 0, 0, 0);
            if (more) {
                const int r = 2 * (i & 7);
                if (i < 8) { p0[r] = __builtin_amdgcn_exp2f(p0[r]); p0[r + 1] = __builtin_amdgcn_exp2f(p0[r + 1]); s0 += p0[r]; s1 += p0[r + 1]; }
                else { p1[r] = __builtin_amdgcn_exp2f(p1[r]); p1[r + 1] = __builtin_amdgcn_exp2f(p1[r + 1]); s0 += p1[r]; s1 += p1[r + 1]; }
            }
            if (i >= 4 && i < 8) { va[2 * (i - 4)] = AT_VT(vs, 2, 2 * (i - 4)); va[2 * (i - 4) + 1] = AT_VT(vs, 2, 2 * (i - 4) + 1); }
            if (i >= 8 && i < 12) { vb[2 * (i - 8)] = AT_VT(vs, 3, 2 * (i - 8)); vb[2 * (i - 8) + 1] = AT_VT(vs, 3, 2 * (i - 8) + 1); }
            AT_SB();
        }
    }
    float l_reg = s0 + s1;
#undef AT_VF
#undef AT_VT
#undef AT_PACK
#undef AT_SB
    AT_WAITBAR(0);
    if (next_unit >= 0) { const Srcs N = unit_srcs(P, next_unit, wid, lane); dma_tile(lds0, N, 0, 0, wid); dma_tile(lds0, N, 1, 1, wid); }
    l_reg = xor32_sum(l_reg);
    LAS float* wsf = (LAS float*)(lds + WSF) + wid * 64;
    if (hi == 0) wsf[r32] = (mp == 0 ? 1.f : lam) / l_reg;
    asm volatile("s_waitcnt lgkmcnt(0)" ::: "memory");
    float fac[16];
#pragma unroll
    for (int r = 0; r < 16; ++r) fac[r] = wsf[crow(r, hi)];
    LAS f32x4v* X = (LAS f32x4v*)(lds + XOFF) + wq * 1024;
    if (mp == 1) {
#pragma unroll
        for (int d0 = 0; d0 < 4; ++d0)
#pragma unroll
            for (int q = 0; q < 4; ++q) X[(d0 * 4 + q) * 64 + lane] = (f32x4v){o[d0][4 * q] * fac[4 * q], o[d0][4 * q + 1] * fac[4 * q + 1], o[d0][4 * q + 2] * fac[4 * q + 2], o[d0][4 * q + 3] * fac[4 * q + 3]};
    }
    AT_WAITBAR(4);
    if (mp == 0) {
        float ss[16];
#pragma unroll
        for (int r = 0; r < 16; ++r) ss[r] = 0.f;
#pragma unroll
        for (int d0 = 0; d0 < 4; ++d0)
#pragma unroll
            for (int q = 0; q < 4; ++q) { const f32x4v xv = X[(d0 * 4 + q) * 64 + lane];
#pragma unroll
                for (int j = 0; j < 4; ++j) { const int r = 4 * q + j; const float v = o[d0][r] * fac[r] - xv[j]; o[d0][r] = v; ss[r] += v * v; } }
#pragma unroll
        for (int r = 0; r < 16; ++r) {
            float s = ss[r];
            s = xor16_sum(row16_sum(s));
            ss[r] = __builtin_amdgcn_rsqf(s * (1.f / 128.f) + EPSN) * (1.f - LAM_INIT);
        }
        asm volatile("s_waitcnt lgkmcnt(0)" ::: "memory");
        LAS bf16_t* stg = (LAS bf16_t*)(lds + XOFF + wq * 16384);
#pragma unroll
        for (int d0 = 0; d0 < 4; ++d0) {
            const float sw = P.in[IN_SUBLN][d0 * 32 + r32];
#pragma unroll
            for (int r = 0; r < 16; r += 2) { const unsigned pk = cvtpk(o[d0][r] * ss[r] * sw, o[d0][r + 1] * ss[r + 1] * sw);
                stg[crow(r, hi) * 128 + d0 * 32 + r32] = (bf16_t)(pk & 0xffffu); stg[crow(r + 1, hi) * 128 + d0 * 32 + r32] = (bf16_t)(pk >> 16); }
        }
        asm volatile("s_waitcnt lgkmcnt(0)" ::: "memory");
        bf16_t* On = Obase + ((size_t)(b * SEQL + q0 + wq * 32)) * 1024 + h * 128;
#pragma unroll
        for (int i = 0; i < 8; ++i) { const int row = i * 4 + (lane >> 4), ch = lane & 15;
            const u32x4 v = *(const LAS u32x4*)(stg + row * 128 + ch * 8);
            *(u32x4*)(On + (size_t)row * 1024 + ch * 8) = v; }
    }
}
#undef AT_WAITBAR
__device__ __forceinline__ void attn_phase(const Ptrs& P, LAS unsigned char* lds, int G, int bx, int wave, bf16_t* Obase) {
    const int lane = lane_id();
    asm volatile(".rept %0\n\ts_nop 0\n\t.endr" :: "i"(PAD_ATT));
    const float lam = __expf(wave_sum(P.in[IN_LQ1][lane] * P.in[IN_LK1][lane])) - __expf(wave_sum(P.in[IN_LQ2][lane] * P.in[IN_LK2][lane])) + LAM_INIT;
    const float mshift = 8.f * 1.4426950408889634f * wave_max(fabsf(P.in[IN_QNW][lane])) * wave_max(fabsf(P.in[IN_KNW][lane]));
    const int vcu = (G % 8 == 0) ? (bx % 8) * (G / 8) + bx / 8 : bx;
    const int NU = NB * NHEAD * 32;
    bool first = true;
    for (int u = vcu; u < NU; u += G) { attn_unit(P, lds, u, u + G < NU ? u + G : -1, first, lam, mshift, wave, Obase); first = false; }
    asm volatile("s_waitcnt vmcnt(0) lgkmcnt(0)" ::: "memory");
    __syncthreads();
}
}
namespace s5 {
using pg8::Unit; using pg8::f32x4; using pg8::u32x4;
typedef float f2 __attribute__((ext_vector_type(2)));
__device__ __forceinline__ f2 cmul(f2 a, f2 b) { return (f2){a.x * b.x - a.y * b.y, a.x * b.y + a.y * b.x}; }

template <int NDL>
__device__ __forceinline__ void stage2(const LAS f2* apow, const LAS f2* BB, const LAS f2* CC, LAS float* Mt, int d, int c, int cp) {
    float acc[NDL];
#pragma unroll
    for (int j = 0; j < NDL; ++j) acc[j] = 0.f;
#pragma unroll 2
    for (int p = 0; p < 64; ++p) {
        const f2 z = cmul(CC[(d * 64 + p) * 16 + c], BB[(d * 64 + p) * 16 + cp]);
        const LAS f2* ap = apow + (d * 64 + p) * 17;
#pragma unroll
        for (int j = 0; j < NDL; ++j) { const f2 a = ap[j]; acc[j] += z.x * a.x - z.y * a.y; }
    }
#pragma unroll
    for (int j = 0; j < NDL; ++j) Mt[((d * 16 + j) * 16 + c) * 16 + cp] = acc[j];
}
__device__ void build_tables(const Ptrs& P, LAS unsigned char* lds, int item, int tid) {
    const int g = item >> 3, qt = item & 7;
    LAS f2* apow = (LAS f2*)lds;
    LAS f2* BB = (LAS f2*)(lds + 17408);
    LAS f2* CC = (LAS f2*)(lds + 33792);
    LAS float* Mt = (LAS float*)(lds + 50176);
    {
        const int dp = tid & 127, cq = tid >> 7, d = dp >> 6, p = dp & 63, gi = (d * NGRP + g) * NST + p;
        const float lre = fminf(P.in[IN_ARE][gi], -1e-4f), lim = P.in[IN_AIM][gi], dt = __expf(P.in[IN_LOGDT][d * NGRP + g]);
        f2 a1; { const float mag = __expf(lre * dt); float sn, cs; sincosf(lim * dt, &sn, &cs); a1 = (f2){mag * cs, mag * sn}; }
        if (cq == 0) { f2 pw = (f2){1.f, 0.f};
            for (int n = 0; n <= 16; ++n) { apow[(d * 64 + p) * 17 + n] = pw; if (n == 16 && qt == 0) ((f2*)(P.ws + WS_A16))[(g * 2 + d) * 64 + p] = pw; pw = cmul(pw, a1); } }
        const float nr = a1.x - 1.f, ni = a1.y, den = lre * lre + lim * lim;
        const f2 fz = (f2){(nr * lre + ni * lim) / den, (ni * lre - nr * lim) / den};
#pragma unroll
        for (int cc = 0; cc < 4; ++cc) { const int c = 4 * cq + cc;
            BB[(d * 64 + p) * 16 + c] = cmul(fz, (f2){P.in[IN_BRE][(size_t)gi * 16 + c], P.in[IN_BIM][(size_t)gi * 16 + c]});
            CC[(d * 64 + p) * 16 + c] = (f2){P.in[IN_CRE][((size_t)(d * NGRP + g) * 16 + c) * NST + p], P.in[IN_CIM][((size_t)(d * NGRP + g) * 16 + c) * NST + p]};
        }
    }
    __syncthreads();
    {
        const int d = tid >> 8, c = (tid >> 4) & 15, cp = tid & 15;
        const int ndl = d == 0 ? 2 * qt + 2 : 16 - 2 * qt;
        switch (ndl >> 1) {
            case 1: stage2<2>(apow, BB, CC, Mt, d, c, cp); break;  case 2: stage2<4>(apow, BB, CC, Mt, d, c, cp); break;
            case 3: stage2<6>(apow, BB, CC, Mt, d, c, cp); break;  case 4: stage2<8>(apow, BB, CC, Mt, d, c, cp); break;
            case 5: stage2<10>(apow, BB, CC, Mt, d, c, cp); break; case 6: stage2<12>(apow, BB, CC, Mt, d, c, cp); break;
            case 7: stage2<14>(apow, BB, CC, Mt, d, c, cp); break; default: stage2<16>(apow, BB, CC, Mt, d, c, cp); break;
        }
    }
    __syncthreads();
    bf16_t* TQ = (bf16_t*)(P.ws + WS_TQ) + (size_t)g * 256 * 512;
    for (int e = tid; e < 32 * 64; e += 512) {
        const int row = qt * 32 + (e >> 6), K0 = (e & 63) * 8, tau = row >> 4, c = row & 15;
        float v[8];
        if (K0 < 256) { const int sg = K0 >> 4, cp0 = K0 & 15;
            const LAS float* m0p = tau > sg ? Mt + ((0 * 16 + (tau - sg)) * 16 + c) * 16 + cp0 : (tau < sg ? Mt + ((1 * 16 + (sg - tau)) * 16 + c) * 16 + cp0 : Mt + (0 * 16 * 16 + c) * 16 + cp0);
#pragma unroll
            for (int j = 0; j < 8; ++j) v[j] = m0p[j];
            if (tau == sg) { const LAS float* m1p = Mt + ((1 * 16) * 16 + c) * 16 + cp0;
#pragma unroll
                for (int j = 0; j < 8; ++j) v[j] += m1p[j]; }
        } else { const int r0 = K0 - 256, d = r0 >> 7, ri = (r0 >> 6) & 1, p0 = r0 & 63;
#pragma unroll
            for (int j = 0; j < 8; ++j) { const int p = p0 + j;
                const f2 t = cmul(CC[(d * 64 + p) * 16 + c], apow[(d * 64 + p) * 17 + (d == 0 ? tau + 1 : 16 - tau)]);
                v[j] = ri == 0 ? t.x : -t.y; } }
        u32x4 o; o.x = pg8::cvt_pk_bf16(v[0], v[1]); o.y = pg8::cvt_pk_bf16(v[2], v[3]); o.z = pg8::cvt_pk_bf16(v[4], v[5]); o.w = pg8::cvt_pk_bf16(v[6], v[7]);
        *(u32x4*)(TQ + (size_t)row * 512 + K0) = o;
    }
    bf16_t* PS = (bf16_t*)(P.ws + WS_PST) + (size_t)g * 256 * 256;
    for (int e = tid; e < 32 * 32; e += 512) {
        const int r = qt * 32 + (e >> 5), K0 = (e & 31) * 8, sg = K0 >> 4, cp0 = K0 & 15, d = r >> 7, ri = (r >> 6) & 1, p = r & 63;
        const f2 ap = apow[(d * 64 + p) * 17 + (d == 0 ? 15 - sg : sg)];
        float v[8];
#pragma unroll
        for (int j = 0; j < 8; ++j) { const f2 t = cmul(ap, BB[(d * 64 + p) * 16 + cp0 + j]); v[j] = ri == 0 ? t.x : t.y; }
        u32x4 o; o.x = pg8::cvt_pk_bf16(v[0], v[1]); o.y = pg8::cvt_pk_bf16(v[2], v[3]); o.z = pg8::cvt_pk_bf16(v[4], v[5]); o.w = pg8::cvt_pk_bf16(v[6], v[7]);
        *(u32x4*)(PS + (size_t)r * 256 + K0) = o;
    }
    __syncthreads();
}

struct SchedE { int bg, g; __device__ __forceinline__ bool next(int i, Unit& u) const { if (i >= 1) return false; u.arow = bg * NCH; u.brow = g * 256; u.pm = 0; u.pn = 0; return true; } };
struct EpiE {
    static constexpr bool PERM = true;
    float* Es;
    __device__ __forceinline__ void operator()(const f32x4 (&acc)[2][2][4][2], const Unit& u, int wr, int wc, int fr, int fq) const {
#pragma unroll
        for (int ai = 0; ai < 2; ++ai)
#pragma unroll
            for (int m = 0; m < 4; ++m) {
                const int j = 256 * u.pm + 128 * ai + 64 * wr + 16 * m + fr;
                if (j < NCH) {
#pragma unroll
                    for (int bj = 0; bj < 2; ++bj) { float* e = Es + (size_t)j * 256 + 128 * bj + 32 * wc + 8 * fq; *(f32x4*)e = acc[ai][bj][m][0]; *(f32x4*)(e + 4) = acc[ai][bj][m][1]; }
                }
            }
    }
};
struct EpiY {
    static constexpr bool PERM = true;
    const Ptrs* Pp; int b, g;
    __device__ __forceinline__ void operator()(const f32x4 (&acc)[2][2][4][2], const Unit& u, int wr, int wc, int fr, int fq) const {
        const Ptrs& P = *Pp;
        const int c0 = 8 * (fq & 1);
        const f32x4 d0 = *(const f32x4*)(P.in[IN_S5D] + g * 16 + c0), d1 = *(const f32x4*)(P.in[IN_S5D] + g * 16 + c0 + 4);
#pragma unroll
        for (int ai = 0; ai < 2; ++ai)
#pragma unroll
            for (int m = 0; m < 4; ++m) {
                const int j = 128 * ai + 64 * wr + 16 * m + fr;
#pragma unroll
                for (int bj = 0; bj < 2; ++bj) {
                    const int tau = 8 * bj + 2 * wc + (fq >> 1);
                    const u32x4 uu = *(const u32x4*)((const bf16_t*)(P.ws + WS_RU) + u_idx(b, g, j, tau, c0));
                    f32x4 y0 = acc[ai][bj][m][0] + d0 * og::unpk_lo(uu), y1 = acc[ai][bj][m][1] + d1 * og::unpk_hi(uu);
#pragma unroll
                    for (int q = 0; q < 4; ++q) {
                        const float a = y0[q], bb = y1[q];
                        y0[q] = a * __builtin_amdgcn_rcpf(1.f + __builtin_amdgcn_exp2f(a * __builtin_fmaf(a * a, -0.10294324f, -2.3022082f)));
                        y1[q] = bb * __builtin_amdgcn_rcpf(1.f + __builtin_amdgcn_exp2f(bb * __builtin_fmaf(bb * bb, -0.10294324f, -2.3022082f)));
                    }
                    *(u32x4*)((bf16_t*)(P.ws + WS_HS) + ((size_t)(b * SEQL + 16 * j + tau)) * S5W + g * 16 + c0) = og::pack8(y0, y1);
                }
            }
    }
};
__device__ __forceinline__ void scan(const Ptrs& P, int bg, int g, const float* Es, int tid) {
    if (tid >= 128) return;
    const int d = tid >> 6, p = tid & 63;
    const f2 a16 = ((const f2*)(P.ws + WS_A16))[(g * 2 + d) * 64 + p];
    const float ar = a16.x, ai = a16.y;
    const float* er = Es + d * 128 + p;
    float sr = 0.f, si = 0.f;
    {   float cx[16], cy[16];
#pragma unroll
        for (int k = 0; k < 16; ++k) { const int j = d == 0 ? 256 + k : 271 - k; cx[k] = er[(size_t)j * 256]; cy[k] = er[(size_t)j * 256 + 64]; }
#pragma unroll
        for (int k = 0; k < 16; ++k) { const float nr = ar * sr - ai * si + cx[k], ni = ar * si + ai * sr + cy[k]; sr = nr; si = ni; } }
    const long estep = d == 0 ? 256 : -256;
    const long ustep = d == 0 ? 512 : -512;
    const float* e = er + (size_t)(d == 0 ? 0 : 255) * 256;
    bf16_t* u = (bf16_t*)(P.ws + WS_RU) + (size_t)bg * NCH * 512 + 256 + d * 128 + p + (size_t)(d == 0 ? 0 : 255) * 512;
    float xa[16], ya[16], xb[16], yb[16];
#pragma unroll
    for (int k = 0; k < 16; ++k) { xa[k] = e[k * estep]; ya[k] = e[k * estep + 64]; }
#define S5_STEP(X, Y) do { const unsigned pk = pg8::cvt_pk_bf16(sr, si); u[0] = (bf16_t)(pk & 0xffffu); u[64] = (bf16_t)(pk >> 16); u += ustep; \
        const float nr = __builtin_fmaf(ar, sr, __builtin_fmaf(-ai, si, X)), ni = __builtin_fmaf(ar, si, __builtin_fmaf(ai, sr, Y)); sr = nr; si = ni; \
        asm volatile("" : "+v"(sr), "+v"(si)); } while (0)
#pragma unroll 1
    for (int k0 = 0; k0 < 256; k0 += 32) {
        e += 16 * estep;
#pragma unroll
        for (int k = 0; k < 16; ++k) { xb[k] = e[k * estep]; yb[k] = e[k * estep + 64]; }
#pragma unroll
        for (int k = 0; k < 16; ++k) S5_STEP(xa[k], ya[k]);
        e += 16 * estep;
        if (k0 + 32 < 256) {
#pragma unroll
            for (int k = 0; k < 16; ++k) { xa[k] = e[k * estep]; ya[k] = e[k * estep + 64]; }
        }
#pragma unroll
        for (int k = 0; k < 16; ++k) S5_STEP(xb[k], yb[k]);
    }
#undef S5_STEP
}
__device__ __forceinline__ void ctx_states(const Ptrs& P, int bg, int g, float* Es, int wave, int lane) {
    typedef short bf16x8 __attribute__((ext_vector_type(8)));
    const int i16 = lane & 15, kq = lane >> 4;
    const bf16_t* Ua = (const bf16_t*)(P.ws + WS_RU) + ((size_t)bg * NCH + 256 + i16) * 512 + 8 * kq;
    bf16x8 af[8];
#pragma unroll
    for (int ks = 0; ks < 8; ++ks) af[ks] = *(const bf16x8*)(Ua + 32 * ks);
#pragma unroll
    for (int q = 0; q < 2; ++q) {
        const int nt = 2 * wave + q;
        const bf16_t* Pb = (const bf16_t*)(P.ws + WS_PST) + ((size_t)g * 256 + 16 * nt + i16) * 256 + 8 * kq;
        f32x4 acc = (f32x4){0.f, 0.f, 0.f, 0.f};
#pragma unroll
        for (int ks = 0; ks < 8; ++ks) acc = __builtin_amdgcn_mfma_f32_16x16x32_bf16(af[ks], *(const bf16x8*)(Pb + 32 * ks), acc, 0, 0, 0);
#pragma unroll
        for (int reg = 0; reg < 4; ++reg) Es[(size_t)(256 + 4 * kq + reg) * 256 + 16 * nt + i16] = acc[reg];
    }
}
__device__ __forceinline__ void s5_item(const Ptrs& P, LAS unsigned char* ring, int bg, int wave) {
    const int b = bg / NGRP, g = bg % NGRP;
    float* Es = (float*)(P.ws + WS_RH) + (size_t)bg * NCH * 256;
    const bf16_t* U = (const bf16_t*)(P.ws + WS_RU);
    { int l_ = lane_id(); asm volatile("" : "+v"(l_)); ctx_states(P, bg, g, Es, wave, l_); }
    { const pg8::Gemm g1{U, (const bf16_t*)(P.ws + WS_PST), 256, 512, 256};
      pg8::gemm_phase<EpiE, SchedE, false, 0>(ring, g1, SchedE{bg, g}, EpiE{Es}, wave); }
    asm volatile("s_waitcnt vmcnt(0)" ::: "memory"); __syncthreads();
    { int t_ = wave * 64 + lane_id(); asm volatile("" : "+v"(t_)); scan(P, bg, g, Es, t_); }
    asm volatile("s_waitcnt vmcnt(0)" ::: "memory"); __syncthreads();
    { const pg8::Gemm g2{U, (const bf16_t*)(P.ws + WS_TQ), 512, 512, 512};
      og::SchedOne so; so.v.arow = bg * NCH; so.v.brow = g * 256; so.v.pm = 0; so.v.pn = 0;
      pg8::gemm_phase<EpiY, og::SchedOne, false, 0>(ring, g2, so, EpiY{&P, b, g}, wave); }
}
}
namespace p0 {
typedef float f32x4 __attribute__((ext_vector_type(4)));
typedef unsigned u32x2 __attribute__((ext_vector_type(2)));
__device__ __forceinline__ void mod_item(const Ptrs& P, LAS unsigned char* lds, int item, int half, int vt) {
    const int ct = item % 24, ks = item / 24, col = ct * 256 + vt, k0 = ks * 64;
    const float* W = P.in[IN_ADAW] + (size_t)k0 * 6144 + col;
    LAS float* sl = (LAS float*)(lds + 90112 + half * 2048);
    for (int e = vt; e < 320; e += 256) { const int r = e >> 6, k = e & 63; const float c = r < 4 ? P.in[IN_C][r * DM + k0 + k] : P.in[IN_CCTX][k0 + k];
        sl[e] = c * __builtin_amdgcn_rcpf(1.f + __builtin_amdgcn_exp2f(-1.4426950408889634f * c)); }
    __syncthreads();
    float acc[5] = {0.f, 0.f, 0.f, 0.f, 0.f};
#pragma unroll 1
    for (int kb = 0; kb < 64; kb += 16) {
    float wv[16];
#pragma unroll
    for (int k = 0; k < 16; ++k) wv[k] = __builtin_nontemporal_load(W + (size_t)(kb + k) * 6144);
#pragma unroll
    for (int kk = 0; kk < 16; ++kk) {
        const float w = wv[kk];
#pragma unroll
        for (int r = 0; r < 5; ++r) acc[r] += sl[r * 64 + kb + kk] * w;
    }
    }
    float* mod = (float*)(P.ws + WS_MODFIN);
#pragma unroll
    for (int r = 0; r < 5; ++r) atomicAdd(mod + r * 6144 + col, acc[r] + (ks == 0 ? P.in[IN_ADAB][col] : 0.f));
    __syncthreads();
}
__device__ __forceinline__ void biasup_item(const Ptrs& P, int item, int vt) {
    const int ct = item % 22, ks = item / 22, n = ct * 256 + vt, k0 = ks * 64;
    const float* W = P.in[IN_WUP] + (size_t)k0 * NIN + n;
    const float* mod = (const float*)(P.ws + WS_MODFIN) + 3072 + k0;
    float acc[4] = {0.f, 0.f, 0.f, 0.f};
#pragma unroll 1
    for (int kb = 0; kb < 64; kb += 16) {
    float wv[16];
#pragma unroll
    for (int k = 0; k < 16; ++k) wv[k] = __builtin_nontemporal_load(W + (size_t)(kb + k) * NIN);
#pragma unroll
    for (int kk = 0; kk < 16; ++kk) {
        const int k = kb + kk; const float w = wv[kk];
#pragma unroll
        for (int b = 0; b < 4; ++b) acc[b] += mod[b * 6144 + k] * w;
    }
    }
#pragma unroll
    for (int b = 0; b < 4; ++b) atomicAdd((float*)(P.ws + WS_BIASUP) + b * NIN + n, acc[b]);
}
__device__ __forceinline__ void modulate_row(const Ptrs& P, int r, int lane) {
    const float* xr = r < MR ? P.in[IN_X] + (size_t)r * DM : P.in[IN_CTX] + (size_t)(r - MR) * DM;
    const float* mod = (const float*)(P.ws + WS_MODFIN) + (r < MR ? r / SEQL : 4) * 6144;
    f32x4 v[4]; float ss = 0.f;
#pragma unroll
    for (int j = 0; j < 4; ++j) { v[j] = __builtin_nontemporal_load((const f32x4*)(xr + 256 * j + 4 * lane)); ss += (v[j][0] * v[j][0] + v[j][1] * v[j][1]) + (v[j][2] * v[j][2] + v[j][3] * v[j][3]); }
    const float rstd = __builtin_amdgcn_rsqf(wave_sum(ss) * (1.f / DM) + EPSN);
    bf16_t* H = (bf16_t*)(P.ws + WS_RH) + (size_t)r * DM;
#pragma unroll
    for (int j = 0; j < 4; ++j) { const int k = 256 * j + 4 * lane;
        const f32x4 w = *(const f32x4*)(P.in[IN_N1W] + k), sc = *(const f32x4*)(mod + 1024 + k), sh = *(const f32x4*)(mod + k);
        const f32x4 y = v[j] * rstd * w * (sc + 1.f) + sh;
        u32x2 o; o.x = pg8::cvt_pk_bf16(y[0], y[1]); o.y = pg8::cvt_pk_bf16(y[2], y[3]);
        *(u32x2*)(H + k) = o; }
}
__device__ __forceinline__ void modulate_rows(const Ptrs& P, int gw, int NGW, int lane) {
    const int per = (MT + NGW - 1) / NGW;
    int r = gw * per; const int rend = r + per < MT ? r + per : MT;
    if (r >= rend) return;
    f32x4 A[4], B[4], v[4], nv[4]; int curb = -1;
    { const float* xr = r < MR ? P.in[IN_X] + (size_t)r * DM : P.in[IN_CTX] + (size_t)(r - MR) * DM;
#pragma unroll
      for (int j = 0; j < 4; ++j) v[j] = __builtin_nontemporal_load((const f32x4*)(xr + 256 * j + 4 * lane)); }
#pragma unroll 1
    for (; r < rend; ++r) {
        if (r + 1 < rend) { const int rn = r + 1; const float* xr = rn < MR ? P.in[IN_X] + (size_t)rn * DM : P.in[IN_CTX] + (size_t)(rn - MR) * DM;
#pragma unroll
            for (int j = 0; j < 4; ++j) nv[j] = __builtin_nontemporal_load((const f32x4*)(xr + 256 * j + 4 * lane)); }
        const int b = r < MR ? r / SEQL : 4;
        if (b != curb) { curb = b; const float* mod = (const float*)(P.ws + WS_MODFIN) + b * 6144;
#pragma unroll
            for (int j = 0; j < 4; ++j) { const int k = 256 * j + 4 * lane; A[j] = *(const f32x4*)(P.in[IN_N1W] + k) * (*(const f32x4*)(mod + 1024 + k) + 1.f); B[j] = *(const f32x4*)(mod + k); } }
        float ss = 0.f;
#pragma unroll
        for (int j = 0; j < 4; ++j) ss += (v[j][0] * v[j][0] + v[j][1] * v[j][1]) + (v[j][2] * v[j][2] + v[j][3] * v[j][3]);
        const float rstd = __builtin_amdgcn_rsqf(wave_sum(ss) * (1.f / DM) + EPSN);
        bf16_t* H = (bf16_t*)(P.ws + WS_RH) + (size_t)r * DM;
#pragma unroll
        for (int j = 0; j < 4; ++j) { const int k = 256 * j + 4 * lane;
            const f32x4 y = v[j] * rstd * A[j] + B[j];
            u32x2 o; o.x = pg8::cvt_pk_bf16(y[0], y[1]); o.y = pg8::cvt_pk_bf16(y[2], y[3]);
            *(u32x2*)(H + k) = o; }
#pragma unroll
        for (int j = 0; j < 4; ++j) v[j] = nv[j];
    }
}
}

#define XB_TMO      128
#define XB_XCNT(j)  (256  + 64 * (j))
#define XB_XSUB(j)  (1280 + 64 * (j))
#define XB_XGEN(j)  (2304 + 64 * (j))
#define XB_TOP      3328
#define XB_TOPGEN   3392
#define XCD_BAR_WORDS 3456
#define XB_SPIN_CAP (1u << 22)
constexpr int CW_BAR = 4096;

__device__ __forceinline__ unsigned xb_ld(unsigned* p)              { return __hip_atomic_load(p, __ATOMIC_RELAXED, __HIP_MEMORY_SCOPE_AGENT); }
__device__ __forceinline__ unsigned xb_add(unsigned* p, unsigned v) { return __hip_atomic_fetch_add(p, v, __ATOMIC_RELAXED, __HIP_MEMORY_SCOPE_AGENT); }
__device__ __forceinline__ unsigned xb_xcc_id() { return (unsigned)__builtin_amdgcn_s_getreg((3 << 11) | 20) & 0xFu; }
#define XB_SPIN(cond, bar) do { unsigned _sp = 0; while (cond) { __builtin_amdgcn_s_sleep(1); \
    if ((++_sp & 255u) == 0u) { if (xb_ld(&(bar)[XB_TMO])) break; if (_sp > XB_SPIN_CAP) { atomicAdd(&(bar)[XB_TMO], 1u); break; } } } } while (0)
struct XcdBarrier { unsigned* bar; unsigned x; volatile LAS unsigned* st; };
__device__ __forceinline__ XcdBarrier xcd_barrier_post(unsigned* bar, volatile LAS unsigned* st, int tid) {
    XcdBarrier b; b.bar = bar; b.x = xb_xcc_id(); b.st = st;
    if (tid == 0) (void)xb_add(&bar[XB_XCNT(b.x)], 1u);
    return b;
}
__device__ __forceinline__ void xcd_barrier_complete(unsigned* bar, unsigned x, unsigned& nloc, unsigned& nx) {
    const unsigned G = gridDim.x * gridDim.y * gridDim.z;
    unsigned sum, cnt, mine, sp = 0u;
    for (;;) {
        sum = 0u; cnt = 0u; mine = 0u;
#pragma unroll
        for (unsigned j = 0; j < 16; ++j) { const unsigned c = xb_ld(&bar[XB_XCNT(j)]); sum += c; cnt += (c > 0u) ? 1u : 0u; mine = (j == x) ? c : mine; }
        if (sum == G) break;
        __builtin_amdgcn_s_sleep(1);
        if ((++sp & 255u) == 0u) { if (xb_ld(&bar[XB_TMO])) break; if (sp > XB_SPIN_CAP) { atomicAdd(&bar[XB_TMO], 1u); break; } }
    }
    nloc = mine > 0u ? mine : 1u; nx = cnt > 0u ? cnt : 1u;
}
__device__ __forceinline__ void xcd_barrier(const XcdBarrier& b, int wave) {
    const int tid0 = wave * 64 + lane_id();
    asm volatile("s_waitcnt vmcnt(0)" ::: "memory");
    __syncthreads();
    if (tid0 == 0) {
        unsigned* bar = b.bar;
        __builtin_amdgcn_s_waitcnt(0);
        unsigned nloc = b.st[0], nx = b.st[1];
        if (nloc == 0u) { xcd_barrier_complete(bar, b.x, nloc, nx); b.st[0] = nloc; b.st[1] = nx; }
        const unsigned old = xb_add(&bar[XB_XSUB(b.x)], 1u);
        const unsigned gen = old / nloc;
        if (old + 1u == (gen + 1u) * nloc) {
            __builtin_amdgcn_fence(__ATOMIC_RELEASE, "agent");
            asm volatile("s_waitcnt vmcnt(0)" ::: "memory");
            const unsigned og = xb_add(&bar[XB_TOP], 1u);
            const unsigned tg = og / nx;
            if (og + 1u == (tg + 1u) * nx) xb_add(&bar[XB_TOPGEN], 1u);
            else XB_SPIN(xb_ld(&bar[XB_TOPGEN]) == tg, bar);
            xb_add(&bar[XB_XGEN(b.x)], 1u);
            __builtin_amdgcn_fence(__ATOMIC_ACQUIRE, "agent");
            asm volatile("s_waitcnt vmcnt(0)" ::: "memory");
        } else {
            XB_SPIN(xb_ld(&bar[XB_XGEN(b.x)]) == gen, bar);
            __builtin_amdgcn_fence(__ATOMIC_ACQUIRE, "agent");
            asm volatile("s_waitcnt vmcnt(0)" ::: "memory");
        }
    }
    __syncthreads();
}

#ifndef OPT_GEMM
#define OPT_GEMM 1
#endif
#ifndef OPT_P1
#define OPT_P1 1
#endif
#ifndef OPT_P3
#define OPT_P3 1
#endif
#ifndef OPT_P4
#define OPT_P4 1
#endif
#ifndef OPT_ATTN
#define OPT_ATTN 1
#endif
#ifndef OPT_S5
#define OPT_S5 1
#endif
#ifndef OPT_P0
#define OPT_P0 1
#endif
#ifndef REP_P1
#define REP_P1 0
#endif
#ifndef REP_P4
#define REP_P4 0
#endif
#ifndef REP_S5
#define REP_S5 0
#endif
#ifndef REP_ATTN
#define REP_ATTN 0
#endif
#ifndef REP_BAR
#define REP_BAR 0
#endif
#ifndef REP_P3
#define REP_P3 0
#endif
#ifndef REP_P0
#define REP_P0 0
#endif
#ifndef USE_COOP_LAUNCH
#define USE_COOP_LAUNCH 1
#endif
#ifndef OPT_P5
#define OPT_P5 1
#endif
constexpr int LDS_BYTES = 147456;
constexpr int LDS_MISC = LDS_BYTES - 512;
struct Args { Ptrs P; int ph_lo, ph_hi; };

#define PADNOPS(n) asm volatile(".rept %0\n\ts_nop 0\n\t.endr" :: "i"(n))
__global__ void __launch_bounds__(512, 2) mega(Args a) {
    extern __shared__ __attribute__((aligned(16))) unsigned char lds[];
    const Ptrs& P = a.P;
    PADNOPS(PAD_ENTRY);
    const int wave = __builtin_amdgcn_readfirstlane(threadIdx.x >> 6);
    const int lane = lane_id(), tid = wave * 64 + lane, half = tid >> 8, vt = tid & 255;
    const int G = gridDim.x, bx = blockIdx.x;
    if (tid < 128) ((LAS unsigned*)(lds + LDS_MISC))[tid] = 0u;
    __syncthreads();
    XcdBarrier bar = xcd_barrier_post((unsigned*)(P.ws + WS_CTL) + CW_BAR, (volatile LAS unsigned*)(lds + LDS_MISC) + 8, tid);
    char* lh = (char*)lds + half * NB_LDS;
    const int lo = a.ph_lo, hi = a.ph_hi;
#define IN(k) (lo <= (k) && (k) < hi)
#define SEAM(k) do { if (IN(k) && IN((k) + 1)) xcd_barrier(bar, wave); } while (0)
#define VB2(NV) for (int v_ = 2 * bx + half; v_ < (NV); v_ += 2 * G)

    LAS unsigned char* ring = (LAS unsigned char*)lds;
#if REP_P0
    {
    if (IN(0)) {
#if OPT_P0
        VB2(24 * 16) p0::mod_item(P, ring, v_, half, vt);
#else
        VB2(120) nb_mod(P, v_ % 24, v_ / 24, vt);
#endif
        VB2(4) nb_rope(P, v_, vt);
        for (int i = bx * 512 + tid; i < MR + 512; i += G * 512) ((float*)(P.ws + WS_ROWSQ0))[i] = 0.f;
#if OPT_S5
        for (int it = bx; it < NGRP * 8; it += G) s5::build_tables(P, ring, it, tid);
#endif
#if OPT_GEMM
        og::transposes_A(P, ring, bx * 8 + wave, G * 8, wave, lane);
#endif
    }
    xcd_barrier(bar, wave);
    if (IN(1)) {
#if OPT_P0
        for (int r = bx * 8 + wave; r < MT; r += G * 8) p0::modulate_row(P, r, lane);
#else
        VB2(88) nb_biasup(P, v_ % 22, v_ / 22, vt);
        VB2(MT / 4) nb_modulate(P, v_, vt);
#endif
    }
    xcd_barrier(bar, wave);
    for (int i = bx * 512 + tid; i < (int)((768 * 1024 - 512 * 1024) / 4); i += G * 512) ((float*)(P.ws + WS_MODFIN))[i] = 0.f;
    xcd_barrier(bar, wave);
    }
#endif
    if (IN(0)) {
#if OPT_P0
        VB2(24 * 16) p0::mod_item(P, ring, v_, half, vt);
#else
        VB2(120) nb_mod(P, v_ % 24, v_ / 24, vt);
#endif
        VB2(4) nb_rope(P, v_, vt);
        for (int i = bx * 512 + tid; i < MR + 512; i += G * 512) ((float*)(P.ws + WS_ROWSQ0))[i] = 0.f;
#if OPT_S5
        for (int it = bx; it < NGRP * 8; it += G) s5::build_tables(P, ring, it, tid);
#endif
#if OPT_GEMM
        og::transposes_A(P, ring, bx * 8 + wave, G * 8, wave, lane);
#endif
    }
    SEAM(0);
    if (IN(1)) {
#if OPT_P0
        p0::modulate_rows(P, bx * 8 + wave, G * 8, lane);
#else
        VB2(88) nb_biasup(P, v_ % 22, v_ / 22, vt);
        VB2(MT / 4) nb_modulate(P, v_, vt);
#endif
    }
    SEAM(1);
    if (IN(2)) {
#if OPT_GEMM && OPT_P1
        { const pg8::Gemm g{(const bf16_t*)(P.ws + WS_RH), (const bf16_t*)(P.ws + WS_WIN), DM, DM, DM};
          for (int rep_ = 0; rep_ < 1 + REP_P1; ++rep_) pg8::gemm_phase<og::EpiIn, og::SchedIn, true, 0>(ring, g, og::SchedIn{G, bx}, og::EpiIn{&P}, wave); }
        {
            const int nshort = G - (1448 % G), first_short = 1448 % G;
            if (first_short == 0) { for (int v_ = 2 * bx + half; v_ < 22 * 16; v_ += 2 * G) p0::biasup_item(P, v_, vt); }
            else if (bx >= first_short) { for (int v_ = 2 * (bx - first_short) + half; v_ < 22 * 16; v_ += 2 * nshort) p0::biasup_item(P, v_, vt); }
            if (first_short == 0) og::transposes_B(P, ring, bx * 8 + wave, G * 8, wave, lane);
            else if (bx >= first_short) og::transposes_B(P, ring, (bx - first_short) * 8 + wave, nshort * 8, wave, lane);
        }
#else
        VB2((NIN / 64) * (MT / 64)) nb_inproj(P, v_ % (NIN / 64), v_ / (NIN / 64), vt, lh);
#endif
    }
#if REP_BAR
    for (int rb_ = 0; rb_ < 10; ++rb_) xcd_barrier(bar, wave);
#endif
    SEAM(2);
    if (IN(3)) {
#if OPT_GEMM
        og::build_convtab(P, bx * 512 + tid);
#endif
#if OPT_ATTN
#if REP_ATTN
        at::attn_phase(P, ring, G, bx, wave, (bf16_t*)(P.ws + WS_RH)); xcd_barrier(bar, wave);
#endif
        at::attn_phase(P, ring, G, bx, wave, (bf16_t*)(P.ws + WS_RQ));
#else
        if (wave < 4) for (int it = 4 * bx + wave; it < NB * NHEAD * SEQL; it += 4 * G) nb_attn(P, it, lane, (char*)lds + wave * 35328);
#endif
#if OPT_S5
        xcd_barrier(bar, wave);
        PADNOPS(PAD_WIN);
        {
            const int nS = NB * NGRP;
            const pg8::Gemm gya{(const bf16_t*)(P.ws + WS_RQ), (const bf16_t*)(P.ws + WS_WBA), DM, DM, DM};
            if (G > nS) {
                if (bx < nS) { for (int rep_ = 0; rep_ < 1 + REP_S5; ++rep_) s5::s5_item(P, ring, bx, wave); }
                else { PADNOPS(PAD_YA); pg8::gemm_phase<og::EpiBranch<0, 1024>, og::SchedMN, true, 0>(ring, gya, og::SchedMN{64, 4, G - nS, bx - nS}, og::EpiBranch<0, 1024>{&P}, wave); }
            } else {
                for (int it = bx; it < nS; it += G) s5::s5_item(P, ring, it, wave);
                pg8::gemm_phase<og::EpiBranch<0, 1024>, og::SchedMN, true, 0>(ring, gya, og::SchedMN{64, 4, G, bx}, og::EpiBranch<0, 1024>{&P}, wave);
            }
        }
#else
        xcd_barrier(bar, wave);
        for (int it = 8 * bx + wave; it < NB * NGRP * 2; it += 8 * G) nb_s5(P, it, lane);
        xcd_barrier(bar, wave);
        VB2(MR * S5W / 256) nb_s5fin(P, v_, vt);
#endif
    }
    SEAM(3);
    if (IN(4)) {
        PADNOPS(PAD_P3A);
#if OPT_GEMM && OPT_P3
        { const pg8::Gemm g{(const bf16_t*)(P.ws + WS_HS), (const bf16_t*)(P.ws + WS_WGLU), S5W, S5W, S5W};
          for (int rep_ = 0; rep_ < 1 + REP_P3; ++rep_) pg8::gemm_phase<og::EpiGlu, og::SchedMN, true, 0>(ring, g, og::SchedMN{64, 2, G, bx}, og::EpiGlu{&P}, wave);
          if (G > 128) { if (bx >= 128) og::transposes_C(P, ring, (bx - 128) * 8 + wave, (G - 128) * 8, wave, lane); }
          else og::transposes_C(P, ring, bx * 8 + wave, G * 8, wave, lane); }
#else
        VB2((S5W / 64) * (MR / 64)) nb_glu(P, v_ % (S5W / 64), v_ / (S5W / 64), vt, lh);
#endif
    }
    SEAM(4);
    if (IN(5)) {
        PADNOPS(PAD_P3B);
#if OPT_GEMM && OPT_P3
        { const pg8::Gemm g{(const bf16_t*)(P.ws + WS_HS2), (const bf16_t*)(P.ws + WS_WBS), S5W, S5W, S5W};
          pg8::gemm_phase<og::EpiBranch<1, 0>, og::SchedMN, true, 0>(ring, g, og::SchedMN{64, 4, G, bx}, og::EpiBranch<1, 0>{&P}, wave); }
#else
        VB2((DM / 64) * (MR / 64)) nb_ys(P, v_ % (DM / 64), v_ / (DM / 64), vt, lh);
        xcd_barrier(bar, wave);
        VB2((DM / 64) * (MR / 64)) nb_ya(P, v_ % (DM / 64), v_ / (DM / 64), vt, lh);
#endif
    }
    SEAM(5);
    if (IN(6)) {
        PADNOPS(PAD_P3C);
#if OPT_GEMM && OPT_P3
        { const pg8::Gemm g{(const bf16_t*)(P.ws + WS_MB), (const bf16_t*)(P.ws + WS_WOUT), DM, DM, DM};
          pg8::gemm_phase<og::EpiOut, og::SchedMN, true, 0>(ring, g, og::SchedMN{64, 4, G, bx}, og::EpiOut{&P}, wave); }
#else
        VB2((DM / 64) * (MR / 64)) nb_out(P, v_ % (DM / 64), v_ / (DM / 64), vt, lh);
#endif
    }
    SEAM(6);
    if (IN(7)) {
        PADNOPS(PAD_P4);
#if OPT_GEMM && OPT_P4
        { const pg8::Gemm g{(const bf16_t*)(P.ws + WS_X1B), (const bf16_t*)(P.ws + WS_WUP), DM, DM, DM};
          for (int rep_ = 0; rep_ < 1 + REP_P4; ++rep_) pg8::gemm_phase<og::EpiUp, og::SchedUp, true, 2, 1>(ring, g, og::SchedUp{G, bx}, og::EpiUp{&P}, wave); }
#else
        VB2((DFF / 64) * (NB * 67)) nb_up(P, v_ % (DFF / 64), v_ / (DFF / 64), vt, lh);
#endif
    }
    SEAM(7);
    if (IN(8)) {
        PADNOPS(PAD_P5);
#if OPT_GEMM && OPT_P5
        { const pg8::Gemm g{(const bf16_t*)(P.ws + WS_ACT), (const bf16_t*)(P.ws + WS_WDOWN), DFF, DFF, DFF};
          pg8::gemm_phase<og::EpiDown, og::SchedMN, true, 0>(ring, g, og::SchedMN{64, 4, G, bx}, og::EpiDown{&P}, wave); }
#else
        VB2((DM / 64) * (MR / 64)) nb_down(P, v_ % (DM / 64), v_ / (DM / 64), vt, lh);
#endif
    }
#undef IN
#undef SEAM
#undef VB2
}

extern "C" void kernel_launch(void* const* d_in, const int* in_sizes, int n_in, void* d_out, int out_size, void* d_ws, size_t ws_size, hipStream_t stream) {
    static int grid = 0;
    if (grid == 0) {
        if (n_in != 34 || ws_size < WS_END) { fprintf(stderr, "kernel_launch: unexpected inputs (n_in %d, ws %zu)\n", n_in, ws_size); grid = -1; return; }
        int dev = 0, cus = 0, per_cu = 0;
        if (hipGetDevice(&dev) != hipSuccess || hipDeviceGetAttribute(&cus, hipDeviceAttributeMultiprocessorCount, dev) != hipSuccess) { grid = -1; return; }
        if (hipFuncSetAttribute((const void*)mega, hipFuncAttributeMaxDynamicSharedMemorySize, LDS_BYTES) != hipSuccess) { fprintf(stderr, "kernel_launch: hipFuncSetAttribute failed\n"); grid = -1; return; }
        if (hipOccupancyMaxActiveBlocksPerMultiprocessor(&per_cu, (const void*)mega, 512, LDS_BYTES) != hipSuccess || per_cu < 1) { fprintf(stderr, "kernel_launch: occupancy query says %d\n", per_cu); (void)hipGetLastError(); per_cu = 1; }
        grid = cus;
    }
    if (grid < 0) return;
    (void)hipMemsetAsync((char*)d_ws + WS_CTL, 0, 1 * MiB, stream);
    Args a{};
    for (int i = 0; i < 34; ++i) a.P.in[i] = (const float*)d_in[i];
    a.P.out = (float*)d_out; a.P.ws = (unsigned char*)d_ws;
    a.ph_lo = 0; a.ph_hi = 9;
#if USE_COOP_LAUNCH
    void* args[] = {&a};
    hipError_t e = hipLaunchCooperativeKernel((const void*)mega, dim3(grid), dim3(512), args, LDS_BYTES, stream);
    if (e != hipSuccess) fprintf(stderr, "kernel_launch: cooperative launch failed: %s (grid %d)\n", hipGetErrorString(e), grid);
#else
    hipLaunchKernelGGL(mega, dim3(grid), dim3(512), LDS_BYTES, stream, a);
    const hipError_t e = hipPeekAtLastError();
    if (e != hipSuccess) fprintf(stderr, "kernel_launch: launch failed: %s (grid %d)\n", hipGetErrorString(e), grid);
#endif
}
```

```cpp
#include <hip/hip_runtime.h>
#include <cstdint>
#include <cstdio>

constexpr int NB = 4, SEQL = 4096, NCTX = 256, DM = 1024, MR = NB * SEQL, MCX = NB * NCTX, MT = MR + MCX;
constexpr int NHEAD = 8, HDIM = 64, VDIM = 128, S5W = 512, NGRP = 32, NST = 64, DFF = 2816, NIN = 5632;
constexpr int KOFF = 1024, VOFF = 2048, UOFF = 3072, GOFF = 3584;
constexpr int NKEY = NCTX + SEQL, NKT = NKEY / 64, NCH = SEQL / 16 + NCTX / 16;
constexpr float EPSN = 1e-6f, LAM_INIT = 0.2f;
constexpr float C2 = 0.125f * 1.4426950408889634f;

typedef unsigned short bf16_t;
__host__ __device__ __forceinline__ float bf2f(bf16_t v) { union { unsigned u; float f; } x; x.u = ((unsigned)v) << 16; return x.f; }
__host__ __device__ __forceinline__ bf16_t f2bf(float f) { union { unsigned u; float f; } x; x.f = f; return (bf16_t)((x.u + 0x7fffu + ((x.u >> 16) & 1u)) >> 16); }

constexpr size_t MiB = 1u << 20;
#define PAD_ENTRY 13
#define PAD_ATT 7
#define PAD_WIN 3
#define PAD_YA 12
#define PAD_P3A 11
#define PAD_P3B 12
#define PAD_P3C 12
#define PAD_P4 12
#define PAD_P5 2
constexpr size_t WS_CTL = 0;
constexpr size_t WS_MODPART = 1 * MiB;
constexpr size_t WS_MODFIN = 512 * 1024;
constexpr size_t WS_BIASUP = 512 * 1024 + 128 * 1024;
constexpr size_t WS_ROPE = 2 * MiB + 256 * 1024;
constexpr size_t WS_A16 = WS_ROPE + 16384;
constexpr size_t WS_ROWSQ0 = 2 * MiB + 512 * 1024;
constexpr size_t WS_ROWSQ = WS_ROWSQ0 + 256;
constexpr size_t WS_CONVTAB = 4 * MiB;
constexpr size_t WS_BIASPART = 4 * MiB;
constexpr size_t WS_WIN = 6 * MiB;
constexpr size_t WS_WUP = 17 * MiB;
constexpr size_t WS_WDOWN = 28 * MiB;
constexpr size_t WS_WOUT = 34 * MiB;
constexpr size_t WS_WBA = 36 * MiB;
constexpr size_t WS_WBS = 38 * MiB;
constexpr size_t WS_WGLU = 39 * MiB;
constexpr size_t WS_TQ = 40 * MiB;
constexpr size_t WS_PST = 48 * MiB;
constexpr size_t WS_RH = 52 * MiB;
constexpr size_t WS_RQ = 86 * MiB;
constexpr size_t WS_RK = 118 * MiB;
constexpr size_t WS_RV = 152 * MiB;
constexpr size_t WS_RU = 186 * MiB;
constexpr size_t WS_HS = 221 * MiB;
constexpr size_t WS_END = 237 * MiB;
constexpr size_t WS_T = WS_RK;
constexpr size_t WS_MB = WS_RU;
constexpr size_t WS_X1R = WS_RQ;
constexpr size_t WS_X1B = WS_RH + 8192;
constexpr size_t WS_HS2 = WS_RH;
constexpr size_t WS_ACT = WS_RK;
constexpr size_t WS_YTF = WS_RH;
constexpr size_t WS_YTB = WS_RK;

__host__ __device__ __forceinline__ unsigned q_idx(int b, int t, int h, int m, int d) { return (unsigned)((b * SEQL + t) * 1024 + h * 128 + m * 64 + d); }
__host__ __device__ __forceinline__ unsigned k_idx(int b, int h, int m, int key, int d) {
    return (unsigned)((((((b * NHEAD + h) * 2 + m) * NKT + (key >> 6)) * 8 + (d >> 3)) * 64 + (key & 63)) * 8 + (d & 7));
}
__host__ __device__ __forceinline__ unsigned v_idx(int b, int h, int key, int d) {
    const int row = key & 63;
    return (unsigned)(((((b * NHEAD + h) * NKT + (key >> 6)) * 16 + (d >> 5) * 4 + (row >> 4)) * 16 + (row & 15)) * 32 + (d & 31));
}
__host__ __device__ __forceinline__ unsigned u_idx(int b, int g, int chunk, int sig, int c) { return (unsigned)((((b * NGRP + g) * NCH + chunk) * 512) + sig * 16 + c); }

struct Ptrs {
    const float* in[34];
    float* out;
    unsigned char* ws;
};
#define IN_X 0
#define IN_C 1
#define IN_CTX 2
#define IN_CCTX 3
#define IN_ADAW 4
#define IN_ADAB 5
#define IN_N1W 6
#define IN_WIN 7
#define IN_BGATE 8
#define IN_QNW 9
#define IN_KNW 10
#define IN_LQ1 11
#define IN_LK1 12
#define IN_LQ2 13
#define IN_LK2 14
#define IN_SUBLN 15
#define IN_ARE 16
#define IN_AIM 17
#define IN_LOGDT 18
#define IN_BRE 19
#define IN_BIM 20
#define IN_CRE 21
#define IN_CIM 22
#define IN_S5D 23
#define IN_GLUW 24
#define IN_GLUB 25
#define IN_WBS 26
#define IN_WBA 27
#define IN_WOUT 28
#define IN_N2W 29
#define IN_WUP 30
#define IN_CONVW 31
#define IN_CONVB 32
#define IN_WDOWN 33

template <int CTRL> __device__ __forceinline__ float dppmov(float x) { return __builtin_bit_cast(float, __builtin_amdgcn_mov_dpp(__builtin_bit_cast(int, x), CTRL, 0xf, 0xf, true)); }
__device__ __forceinline__ float row16_sum(float v) {
    v += dppmov<0xB1>(v); v += dppmov<0x4E>(v); v += dppmov<0x141>(v); v += dppmov<0x140>(v); return v; }
__device__ __forceinline__ float row16_max(float v) {
    v = fmaxf(v, dppmov<0xB1>(v)); v = fmaxf(v, dppmov<0x4E>(v)); v = fmaxf(v, dppmov<0x141>(v)); v = fmaxf(v, dppmov<0x140>(v)); return v; }
__device__ __forceinline__ float xor16_sum(float x) {
    const auto s = __builtin_amdgcn_permlane16_swap(__float_as_uint(x), __float_as_uint(x), false, false); return __uint_as_float(s[0]) + __uint_as_float(s[1]); }
__device__ __forceinline__ float xor32_sum(float x) {
    const auto s = __builtin_amdgcn_permlane32_swap(__float_as_uint(x), __float_as_uint(x), false, false); return __uint_as_float(s[0]) + __uint_as_float(s[1]); }
__device__ __forceinline__ float xor16_max(float x) { const auto s = __builtin_amdgcn_permlane16_swap(__float_as_uint(x), __float_as_uint(x), false, false); return fmaxf(__uint_as_float(s[0]), __uint_as_float(s[1])); }
__device__ __forceinline__ float xor32_max(float x) { const auto s = __builtin_amdgcn_permlane32_swap(__float_as_uint(x), __float_as_uint(x), false, false); return fmaxf(__uint_as_float(s[0]), __uint_as_float(s[1])); }
__device__ __forceinline__ float wave_sum(float v) { return xor32_sum(xor16_sum(row16_sum(v))); }
__device__ __forceinline__ float wave_max(float v) { return xor32_max(xor16_max(row16_max(v))); }
__device__ __forceinline__ float sigmoidf_(float x) { return 1.f / (1.f + __expf(-x)); }
__device__ __forceinline__ float siluf_(float x) { return x / (1.f + __expf(-x)); }
__device__ __forceinline__ float gelu_tanh(float x) { const float u = 0.7978845608028654f * (x + 0.044715f * x * x * x); return 0.5f * x * (1.f + tanhf(u)); }

#define LAS __attribute__((address_space(3)))
__device__ __forceinline__ int lane_id() { return (int)__builtin_amdgcn_mbcnt_hi(~0u, __builtin_amdgcn_mbcnt_lo(~0u, 0u)); }
constexpr int NB_AS = 0, NB_WS = 4160, NB_Z = 8256, NB_Z2 = 24896, NB_LDS = 41536;

__device__ void nb_mod(const Ptrs& P, int vbx, int vby, int vt) {
    const int col = vbx * 256 + vt, row = vby;
    const float* cv = row < 4 ? P.in[IN_C] + row * DM : P.in[IN_CCTX];
    const float* W = P.in[IN_ADAW];
    float acc = 0.f;
    for (int k = 0; k < DM; ++k) acc += siluf_(cv[k]) * W[(size_t)k * 6144 + col];
    ((float*)(P.ws + WS_MODFIN))[row * 6144 + col] = acc + P.in[IN_ADAB][col];
}
__device__ void nb_biasup(const Ptrs& P, int vbx, int vby, int vt) {
    const int n = vbx * 256 + vt, b = vby;
    const float* sh2 = (const float*)(P.ws + WS_MODFIN) + b * 6144 + 3072;
    const float* W = P.in[IN_WUP];
    float acc = 0.f;
    for (int k = 0; k < DM; ++k) acc += sh2[k] * W[(size_t)k * NIN + n];
    ((float*)(P.ws + WS_BIASUP))[b * NIN + n] = acc;
}
__device__ void nb_rope(const Ptrs& P, int vbx, int vt) {
    const int i = vbx * 256 + vt;
    const int pos = i >> 4, f = i & 15;
    const float inv = powf(10000.f, -(float)(2 * f) / 32.f);
    const float ang = (float)pos * inv;
    float* tab = (float*)(P.ws + WS_ROPE);
    tab[2 * i] = cosf(ang); tab[2 * i + 1] = sinf(ang);
}
__device__ void nb_modulate(const Ptrs& P, int vbx, int vt) {
    const int r = vbx * 4 + (vt >> 6), lane = vt & 63;
    const float* xr = r < MR ? P.in[IN_X] + (size_t)r * DM : P.in[IN_CTX] + (size_t)(r - MR) * DM;
    const float* mod = (const float*)(P.ws + WS_MODFIN) + (r < MR ? r / SEQL : 4) * 6144;
    const float* w = P.in[IN_N1W];
    float v[16]; float ss = 0.f;
#pragma unroll
    for (int j = 0; j < 16; ++j) { v[j] = xr[lane + 64 * j]; ss += v[j] * v[j]; }
    const float rstd = rsqrtf(wave_sum(ss) * (1.f / DM) + EPSN);
    bf16_t* H = (bf16_t*)(P.ws + WS_RH) + (size_t)r * DM;
#pragma unroll
    for (int j = 0; j < 16; ++j) { const int k = lane + 64 * j; H[k] = f2bf(v[j] * rstd * w[k] * (1.f + mod[1024 + k]) + mod[k]); }
}
__device__ void ntile(const bf16_t* A, int lda, long row0, long rowmax, const float* W, int ldw, int col0, int K, char* lh, int zoff, int tid) {
    float (*As)[65] = (float (*)[65])(lh + NB_AS);
    float (*Ws)[64] = (float (*)[64])(lh + NB_WS);
    float (*Z)[65] = (float (*)[65])(lh + zoff);
    const int tx = tid & 15, ty = tid >> 4;
    float acc[4][4];
#pragma unroll
    for (int i = 0; i < 4; ++i)
#pragma unroll
        for (int j = 0; j < 4; ++j) acc[i][j] = 0.f;
    for (int k0 = 0; k0 < K; k0 += 16) {
        {
            const int ar = tid >> 2, ak = (tid & 3) * 4;
            long gr = row0 + ar; gr = gr < 0 ? 0 : (gr > rowmax ? rowmax : gr);
            const bf16_t* ap = A + (size_t)gr * lda + k0 + ak;
#pragma unroll
            for (int q = 0; q < 4; ++q) As[ak + q][ar] = bf2f(ap[q]);
            const int wk = tid >> 4, wc = (tid & 15) * 4;
            const float4 wv = *(const float4*)(W + (size_t)(k0 + wk) * ldw + col0 + wc);
            Ws[wk][wc] = wv.x; Ws[wk][wc + 1] = wv.y; Ws[wk][wc + 2] = wv.z; Ws[wk][wc + 3] = wv.w;
        }
        __syncthreads();
#pragma unroll
        for (int kk = 0; kk < 16; ++kk) {
            float a[4], w[4];
#pragma unroll
            for (int i = 0; i < 4; ++i) a[i] = As[kk][ty * 4 + i];
#pragma unroll
            for (int j = 0; j < 4; ++j) w[j] = Ws[kk][tx * 4 + j];
#pragma unroll
            for (int i = 0; i < 4; ++i)
#pragma unroll
                for (int j = 0; j < 4; ++j) acc[i][j] += a[i] * w[j];
        }
        __syncthreads();
    }
#pragma unroll
    for (int i = 0; i < 4; ++i)
#pragma unroll
        for (int j = 0; j < 4; ++j) Z[ty * 4 + i][tx * 4 + j] = acc[i][j];
    __syncthreads();
}
__device__ void nb_inproj(const Ptrs& P, int vbx, int vby, int tid, char* lh) {
    float (*Z)[65] = (float (*)[65])(lh + NB_Z);
    const int c0 = vbx * 64; const long r0 = (long)vby * 64;
    ntile((const bf16_t*)(P.ws + WS_RH), DM, r0, MT - 1, P.in[IN_WIN], NIN, c0, DM, lh, NB_Z, tid);
    const int lr = tid >> 2, j0 = (tid & 3) * 16;
    const int r = (int)r0 + lr;
    const bool isctx = r >= MR;
    const int b = isctx ? (r - MR) / NCTX : r / SEQL, t = isctx ? (r - MR) % NCTX : r % SEQL;
    const int key = isctx ? t : NCTX + t, chunk = isctx ? 256 + (t >> 4) : (t >> 4), sig = t & 15;
    const float* zr = Z[lr];
    if (c0 < VOFF) {
        const bool isq = c0 < KOFF;
        if (!(isq && isctx)) {
            const float* w = isq ? P.in[IN_QNW] : P.in[IN_KNW];
            float ss = 0.f;
            for (int j = 0; j < 64; ++j) ss += zr[j] * zr[j];
            const float rs = rsqrtf(ss * (1.f / 64.f) + EPSN);
            const int cc = isq ? c0 : c0 - KOFF, h = cc / 128, m = (cc / 64) & 1;
            const float* tab = (const float*)(P.ws + WS_ROPE);
            for (int d = j0; d < j0 + 16; ++d) {
                float val = zr[d] * rs * w[d];
                if (!isctx) {
                    const int half = d >> 5, dd = d & 31, i = dd & 15, second = dd >> 4;
                    const int pd = second ? d - 16 : d + 16;
                    const float pv = zr[pd] * rs * w[pd];
                    const int pos = half == 0 ? (t >> 6) : (t & 63);
                    const float cs = tab[(pos * 16 + i) * 2], sn = tab[(pos * 16 + i) * 2 + 1];
                    val = second ? (val * cs + pv * sn) : (val * cs - pv * sn);
                }
                if (isq) ((bf16_t*)(P.ws + WS_RQ))[q_idx(b, t, h, m, d)] = f2bf(val * C2);
                else ((bf16_t*)(P.ws + WS_RK))[k_idx(b, h, m, key, d)] = f2bf(val);
            }
        }
    } else if (c0 < UOFF) {
        const int cc = c0 - VOFF, h = cc / 128, dbase = cc % 128;
        for (int j = j0; j < j0 + 16; ++j) ((bf16_t*)(P.ws + WS_RV))[v_idx(b, h, key, dbase + j)] = f2bf(zr[j]);
    } else if (c0 < GOFF) {
        for (int j = j0; j < j0 + 16; ++j) { const int cc = c0 - UOFF + j; ((bf16_t*)(P.ws + WS_RU))[u_idx(b, cc >> 4, chunk, sig, cc & 15)] = f2bf(zr[j]); }
    } else if (!isctx) {
        bf16_t* G = (bf16_t*)P.out;
        for (int j = j0; j < j0 + 16; ++j) { const int cc = c0 - GOFF + j; G[(size_t)r * 2048 + cc] = f2bf(sigmoidf_(zr[j] + P.in[IN_BGATE][cc])); }
    }
    __syncthreads();
}
__device__ void nb_attn(const Ptrs& P, int item, int lane, char* lw) {
    float* p0 = (float*)lw; float* p1 = p0 + NKEY; float* qs = p1 + NKEY;
    const int b = item / (NHEAD * SEQL), h = (item / SEQL) % NHEAD, t = item % SEQL;
    bf16_t* Q = (bf16_t*)(P.ws + WS_RQ); const bf16_t* K = (const bf16_t*)(P.ws + WS_RK); const bf16_t* V = (const bf16_t*)(P.ws + WS_RV);
    qs[lane] = bf2f(Q[q_idx(b, t, h, 0, lane)]); qs[64 + lane] = bf2f(Q[q_idx(b, t, h, 1, lane)]);
    const float lam = __expf(wave_sum(P.in[IN_LQ1][lane] * P.in[IN_LK1][lane])) - __expf(wave_sum(P.in[IN_LQ2][lane] * P.in[IN_LK2][lane])) + LAM_INIT;
    const float mshift = 8.f * 1.4426950408889634f * wave_max(fabsf(P.in[IN_QNW][lane])) * wave_max(fabsf(P.in[IN_KNW][lane]));
    __builtin_amdgcn_s_waitcnt(0xc07f); __builtin_amdgcn_wave_barrier();
    float l0 = 0.f, l1 = 0.f;
    for (int i = 0; i < NKT; ++i) {
        const int key = i * 64 + lane;
#pragma unroll
        for (int m = 0; m < 2; ++m) {
            float s = 0.f;
#pragma unroll
            for (int ch = 0; ch < 8; ++ch) {
                const uint4 kv = *(const uint4*)(K + k_idx(b, h, m, key, ch * 8));
                const unsigned w[4] = {kv.x, kv.y, kv.z, kv.w};
#pragma unroll
                for (int e = 0; e < 4; ++e) { s += qs[m * 64 + ch * 8 + 2 * e] * bf2f((bf16_t)(w[e] & 0xffff)) + qs[m * 64 + ch * 8 + 2 * e + 1] * bf2f((bf16_t)(w[e] >> 16)); }
            }
            const float p = exp2f(s - mshift);
            if (m == 0) { p0[key] = p; l0 += p; } else { p1[key] = p; l1 += p; }
        }
    }
    l0 = wave_sum(l0); l1 = wave_sum(l1);
    __builtin_amdgcn_s_waitcnt(0xc07f); __builtin_amdgcn_wave_barrier();
    const float i0 = 1.f / l0, i1 = lam / l1;
    float o0 = 0.f, o1 = 0.f;
    for (int key = 0; key < NKEY; ++key) {
        const float a = p0[key] * i0 - p1[key] * i1;
        o0 += a * bf2f(V[v_idx(b, h, key, lane)]); o1 += a * bf2f(V[v_idx(b, h, key, lane + 64)]);
    }
    const float rs = rsqrtf(wave_sum(o0 * o0 + o1 * o1) * (1.f / 128.f) + EPSN) * (1.f - LAM_INIT);
    bf16_t* On = Q;
    const size_t ob = ((size_t)(b * SEQL + t)) * 1024 + h * 128;
    On[ob + lane] = f2bf(o0 * rs * P.in[IN_SUBLN][lane]); On[ob + 64 + lane] = f2bf(o1 * rs * P.in[IN_SUBLN][64 + lane]);
    __builtin_amdgcn_s_waitcnt(0xc07f); __builtin_amdgcn_wave_barrier();
}
__device__ void nb_s5(const Ptrs& P, int item, int p) {
    const int d = item & 1, bg = item >> 1, b = bg / NGRP, g = bg % NGRP;
    const int gi = (d * NGRP + g) * NST + p;
    const float lre = fminf(P.in[IN_ARE][gi], -1e-4f), lim = P.in[IN_AIM][gi], dt = __expf(P.in[IN_LOGDT][d * NGRP + g]);
    const float mag = __expf(lre * dt); float sn, cs; sincosf(lim * dt, &sn, &cs);
    const float ar = mag * cs, ai = mag * sn;
    const float nr = ar - 1.f, ni = ai, den = lre * lre + lim * lim;
    const float fr = (nr * lre + ni * lim) / den, fi = (ni * lre - nr * lim) / den;
    float bre[16], bim[16], cre[16], cim[16];
#pragma unroll
    for (int c = 0; c < 16; ++c) {
        const float br = P.in[IN_BRE][(size_t)gi * 16 + c], bi = P.in[IN_BIM][(size_t)gi * 16 + c];
        bre[c] = fr * br - fi * bi; bim[c] = fr * bi + fi * br;
        cre[c] = P.in[IN_CRE][((size_t)(d * NGRP + g) * 16 + c) * NST + p]; cim[c] = P.in[IN_CIM][((size_t)(d * NGRP + g) * 16 + c) * NST + p];
    }
    const bf16_t* U = (const bf16_t*)(P.ws + WS_RU);
    float* yt = (float*)(P.ws + (d == 0 ? WS_YTF : WS_YTB)) + (size_t)(b * NGRP + g) * SEQL * 16;
    float sr = 0.f, si = 0.f;
    for (int step = 0; step < NKEY; ++step) {
        const bool isctx = step < NCTX;
        const int idx = isctx ? step : step - NCTX;
        const int t = d == 0 ? idx : (isctx ? NCTX - 1 - idx : SEQL - 1 - idx);
        const int chunk = isctx ? 256 + (t >> 4) : (t >> 4);
        const bf16_t* up = U + u_idx(b, g, chunk, t & 15, 0);
        float bur = 0.f, bui = 0.f;
#pragma unroll
        for (int c = 0; c < 16; ++c) { const float u = bf2f(up[c]); bur += bre[c] * u; bui += bim[c] * u; }
        const float nsr = ar * sr - ai * si + bur, nsi = ar * si + ai * sr + bui;
        sr = nsr; si = nsi;
        if (!isctx) {
            float mine = 0.f;
#pragma unroll
            for (int c = 0; c < 16; ++c) { const float v = wave_sum(cre[c] * sr - cim[c] * si); if (p == c) mine = v; }
            if (p < 16) yt[(size_t)t * 16 + p] = mine;
        }
    }
}
__device__ void nb_s5fin(const Ptrs& P, int vbx, int vt) {
    const size_t i = (size_t)vbx * 256 + vt;
    const int ch = (int)(i % 512); const size_t bt = i / 512; const int b = (int)(bt / SEQL), t = (int)(bt % SEQL), g = ch >> 4, c = ch & 15;
    const float u = bf2f(((const bf16_t*)(P.ws + WS_RU))[u_idx(b, g, t >> 4, t & 15, c)]);
    const size_t yi = ((size_t)(b * NGRP + g) * SEQL + t) * 16 + c;
    const float y = P.in[IN_S5D][ch] * u + ((const float*)(P.ws + WS_YTF))[yi] + ((const float*)(P.ws + WS_YTB))[yi];
    ((bf16_t*)(P.ws + WS_HS))[i] = f2bf(gelu_tanh(y));
}
__device__ void nb_glu(const Ptrs& P, int vbx, int vby, int tid, char* lh) {
    float (*Z)[65] = (float (*)[65])(lh + NB_Z);
    const int c0 = vbx * 64; const long r0 = (long)vby * 64;
    const bf16_t* Hs = (const bf16_t*)(P.ws + WS_HS);
    ntile(Hs, S5W, r0, MR - 1, P.in[IN_GLUW], S5W, c0, S5W, lh, NB_Z, tid);
    const int lr = tid >> 2, j0 = (tid & 3) * 16; const size_t r = r0 + lr;
    for (int j = j0; j < j0 + 16; ++j) { const int c = c0 + j; ((bf16_t*)(P.ws + WS_HS2))[r * S5W + c] = f2bf(bf2f(Hs[r * S5W + c]) * sigmoidf_(Z[lr][j] + P.in[IN_GLUB][c])); }
    __syncthreads();
}
__device__ void nb_ys(const Ptrs& P, int vbx, int vby, int tid, char* lh) {
    float (*Z)[65] = (float (*)[65])(lh + NB_Z);
    const int c0 = vbx * 64; const long r0 = (long)vby * 64;
    ntile((const bf16_t*)(P.ws + WS_HS2), S5W, r0, MR - 1, P.in[IN_WBS], DM, c0, S5W, lh, NB_Z, tid);
    const int lr = tid >> 2, j0 = (tid & 3) * 16; const size_t r = r0 + lr;
    const bf16_t* G = (const bf16_t*)P.out;
    for (int j = j0; j < j0 + 16; ++j) { const int c = c0 + j; ((float*)(P.ws + WS_T))[r * DM + c] = bf2f(G[r * 2048 + c]) * Z[lr][j]; }
    __syncthreads();
}
__device__ void nb_ya(const Ptrs& P, int vbx, int vby, int tid, char* lh) {
    float (*Z)[65] = (float (*)[65])(lh + NB_Z);
    const int c0 = vbx * 64; const long r0 = (long)vby * 64;
    ntile((const bf16_t*)(P.ws + WS_RQ), DM, r0, MR - 1, P.in[IN_WBA], DM, c0, DM, lh, NB_Z, tid);
    const int lr = tid >> 2, j0 = (tid & 3) * 16; const size_t r = r0 + lr;
    const bf16_t* G = (const bf16_t*)P.out;
    for (int j = j0; j < j0 + 16; ++j) { const int c = c0 + j; ((bf16_t*)(P.ws + WS_MB))[r * DM + c] = f2bf(((const float*)(P.ws + WS_T))[r * DM + c] + bf2f(G[r * 2048 + 1024 + c]) * Z[lr][j]); }
    __syncthreads();
}
__device__ void nb_out(const Ptrs& P, int vbx, int vby, int tid, char* lh) {
    float (*Z)[65] = (float (*)[65])(lh + NB_Z);
    const int c0 = vbx * 64; const long r0 = (long)vby * 64;
    ntile((const bf16_t*)(P.ws + WS_MB), DM, r0, MR - 1, P.in[IN_WOUT], DM, c0, DM, lh, NB_Z, tid);
    const int lr = tid >> 2, j0 = (tid & 3) * 16; const size_t r = r0 + lr; const int b = (int)(r / SEQL);
    const float* mod = (const float*)(P.ws + WS_MODFIN) + b * 6144;
    float ss = 0.f;
    for (int j = j0; j < j0 + 16; ++j) {
        const int c = c0 + j;
        const float x1 = P.in[IN_X][r * DM + c] + mod[2048 + c] * Z[lr][j];
        P.out[r * DM + c] = x1;
        ((bf16_t*)(P.ws + WS_X1B))[r * DM + c] = f2bf(x1 * P.in[IN_N2W][c] * (1.f + mod[4096 + c]));
        ss += x1 * x1;
    }
    ss += __shfl_xor(ss, 1); ss += __shfl_xor(ss, 2);
    if ((tid & 3) == 0) atomicAdd((float*)(P.ws + WS_ROWSQ) + r, ss);
    __syncthreads();
}
__device__ void nb_up(const Ptrs& P, int vbx, int vby, int tid, char* lh) {
    float (*Za)[65] = (float (*)[65])(lh + NB_Z);
    float (*Zg)[65] = (float (*)[65])(lh + NB_Z2);
    const int c0 = vbx * 64;
    const int b = vby / 67, ti = vby % 67;
    const long r0 = (long)b * SEQL + 62 * ti - 1;
    const bf16_t* A = (const bf16_t*)(P.ws + WS_X1B);
    ntile(A, DM, r0, MR - 1, P.in[IN_WUP], NIN, c0, DM, lh, NB_Z, tid);
    ntile(A, DM, r0, MR - 1, P.in[IN_WUP], NIN, DFF + c0, DM, lh, NB_Z2, tid);
    const int lr = tid >> 2, j0 = (tid & 3) * 16;
    {
        const int tok = 62 * ti + lr - 1; const bool valid = tok >= 0 && tok < SEQL;
        float rstd = 0.f;
        if (valid) { const size_t r = (size_t)b * SEQL + tok; rstd = rsqrtf(((const float*)(P.ws + WS_ROWSQ))[r] * (1.f / DM) + EPSN); }
        const float* bu = (const float*)(P.ws + WS_BIASUP) + b * NIN;
        for (int j = j0; j < j0 + 16; ++j) { Za[lr][j] = valid ? rstd * Za[lr][j] + bu[c0 + j] : 0.f; Zg[lr][j] = valid ? rstd * Zg[lr][j] + bu[DFF + c0 + j] : 0.f; }
    }
    __syncthreads();
    const int tok = 62 * ti + lr - 1;
    if (lr >= 1 && lr <= 62 && tok < SEQL) {
        const float* cw = P.in[IN_CONVW]; const float* cb = P.in[IN_CONVB];
        const size_t r = (size_t)b * SEQL + tok;
        for (int j = j0; j < j0 + 16; ++j) {
            const int ca = c0 + j, cg = DFF + c0 + j;
            const float ya = cb[ca] + cw[ca] * Za[lr - 1][j] + cw[NIN + ca] * Za[lr][j] + cw[2 * NIN + ca] * Za[lr + 1][j];
            const float yg = cb[cg] + cw[cg] * Zg[lr - 1][j] + cw[NIN + cg] * Zg[lr][j] + cw[2 * NIN + cg] * Zg[lr + 1][j];
            ((bf16_t*)(P.ws + WS_ACT))[r * DFF + ca] = f2bf(siluf_(yg) * ya);
        }
    }
    __syncthreads();
}
__device__ void nb_down(const Ptrs& P, int vbx, int vby, int tid, char* lh) {
    float (*Z)[65] = (float (*)[65])(lh + NB_Z);
    const int c0 = vbx * 64; const long r0 = (long)vby * 64;
    ntile((const bf16_t*)(P.ws + WS_ACT), DFF, r0, MR - 1, P.in[IN_WDOWN], DM, c0, DFF, lh, NB_Z, tid);
    const int lr = tid >> 2, j0 = (tid & 3) * 16; const size_t r = r0 + lr; const int b = (int)(r / SEQL);
    const float* mod = (const float*)(P.ws + WS_MODFIN) + b * 6144;
    for (int j = j0; j < j0 + 16; ++j) { const int c = c0 + j; P.out[r * DM + c] = P.out[r * DM + c] + mod[5120 + c] * Z[lr][j]; }
    __syncthreads();
}
namespace pg8 {
typedef short bf16x8 __attribute__((ext_vector_type(8)));
typedef float f32x4 __attribute__((ext_vector_type(4)));
typedef unsigned u32x4 __attribute__((ext_vector_type(4)));
typedef unsigned u32x2 __attribute__((ext_vector_type(2)));
constexpr int BM = 256, BK = 64, HALF = 128, HTB = HALF * BK * 2, STAGE_BYTES = 8 * HTB;
__host__ __device__ __forceinline__ int lds_byte(int r, int c) { const int st = (r >> 4) * 2 + (c >> 5), rr = r & 15, cc = c & 31, ob = rr * 64 + cc * 2; return st * 1024 + (ob ^ (((ob >> 9) & 1) << 5)); }
__host__ __device__ __forceinline__ void stage_rc(int b, int& R, int& C) { const int st = b / 1024, sb = b % 1024, swz = sb ^ (((sb >> 9) & 1) << 5); R = (st >> 1) * 16 + swz / 64; C = (st & 1) * 32 + (swz % 64) / 2; }
__host__ __device__ __forceinline__ int perm32(int rho) { const int n = rho >> 4, i = rho & 15; return 8 * (i >> 2) + 4 * n + (i & 3); }
struct Unit { int arow, brow, pm, pn; };
struct Gemm { const bf16_t* A; const bf16_t* Bt; int K, lda, ldb; };
typedef float f32x2c __attribute__((ext_vector_type(2))); typedef __bf16 bf16x2c __attribute__((ext_vector_type(2)));
__device__ __forceinline__ unsigned cvt_pk_bf16(float lo, float hi) { const f32x2c v = {lo, hi}; const bf16x2c b = __builtin_convertvector(v, bf16x2c); return __builtin_bit_cast(unsigned, b); }

template <class Epi, class Sched, bool ALIGN_EPI, int SHR, int APERM = 0>
__device__ __forceinline__ void gemm_phase(LAS unsigned char* lds, const Gemm g, const Sched& S, const Epi& E, int wave) {
    int tid_ = wave * 64 + lane_id(); asm volatile("" : "+v"(tid_));
    const int tid = tid_, wid = __builtin_amdgcn_readfirstlane(tid >> 6), lane = tid & 63, wr = wid >> 2, wc = wid & 3, fr = lane & 15, fq = lane >> 4;
    int nt_ = g.K / BK; asm volatile("" : "+s"(nt_)); const int nt = nt_;
    unsigned voffA[2], voffB[2];
#pragma unroll
    for (int i = 0; i < 2; ++i) { int R, C; stage_rc(tid * 16 + i * 8192, R, C); const int Rb = Epi::PERM ? ((R & ~31) + perm32(R & 31)) : R;
        const int Ra = APERM ? (R & ~63) + 4 * (R & 15) + ((R >> 4) & 3) : R;
        voffA[i] = (unsigned)((Ra - SHR * (R >> 6)) * g.lda + C) * 2u; voffB[i] = (unsigned)(Rb * g.ldb + C) * 2u; }
    const size_t kstep = (size_t)(BK * 2);
    const size_t hA = (size_t)(HALF - 2 * SHR) * g.lda * 2, hB = (size_t)HALF * g.ldb * 2;
    const unsigned ldsw = (unsigned)wid * 1024u;
    const int aoff = lds_byte(wr * 64 + fr, fq * 8), boff = lds_byte(wc * 32 + fr, fq * 8);
#define PG8_SA(b, h) (((b) * 2 + (h)) * HTB)
#define PG8_SB(b, h) ((4 + (b) * 2 + (h)) * HTB)
#define PG8_STAGE(bufoff, gbase, voff) do { _Pragma("unroll") for (int _i = 0; _i < 2; ++_i) \
        __builtin_amdgcn_global_load_lds((const unsigned*)((const char*)(gbase) + (voff)[_i]), (LAS unsigned*)(lds + (bufoff) + ldsw + _i * 8192), 16, 0, 0); } while (0)
#define PG8_LDA(dst, b, h) do { _Pragma("unroll") for (int m = 0; m < 4; ++m) _Pragma("unroll") for (int k = 0; k < 2; ++k) dst[m][k] = *(const LAS bf16x8*)(lds + PG8_SA(b, h) + aoff + m * 2048 + k * 1024); } while (0)
#define PG8_LDB(dst, b, h) do { _Pragma("unroll") for (int n = 0; n < 2; ++n) _Pragma("unroll") for (int k = 0; k < 2; ++k) dst[n][k] = *(const LAS bf16x8*)(lds + PG8_SB(b, h) + boff + n * 2048 + k * 1024); } while (0)
#define PG8_MMA(ai, bj, At, Bt) do { __builtin_amdgcn_s_setprio(1); _Pragma("unroll") for (int m = 0; m < 4; ++m) _Pragma("unroll") for (int n = 0; n < 2; ++n) _Pragma("unroll") for (int k = 0; k < 2; ++k) \
        acc[ai][bj][m][n] = __builtin_amdgcn_mfma_f32_16x16x32_bf16(Bt[n][k], At[m][k], acc[ai][bj][m][n], 0, 0, 0); __builtin_amdgcn_s_setprio(0); } while (0)
#define PG8_WAIT_V(n) asm volatile("s_waitcnt vmcnt(" #n ")" ::: "memory")
#define PG8_WAIT_L(n) asm volatile("s_waitcnt lgkmcnt(" #n ")" ::: "memory")
#define PG8_BAR __builtin_amdgcn_s_barrier()
#define PG8_SCHED __builtin_amdgcn_sched_barrier(0)
    Unit cur, nxt; int ui = 0;
    if (!S.next(0, cur)) return;
    f32x4 acc[2][2][4][2];
#pragma unroll
    for (int a = 0; a < 2; ++a)
#pragma unroll
        for (int b = 0; b < 2; ++b)
#pragma unroll
            for (int m = 0; m < 4; ++m)
#pragma unroll
                for (int n = 0; n < 2; ++n) acc[a][b][m][n] = (f32x4){0.f, 0.f, 0.f, 0.f};
    bf16x8 At[4][2], B0[2][2], B1[2][2];
    const char* cA = (const char*)g.A + (long)cur.arow * g.lda * 2; const char* cB = (const char*)g.Bt + (long)cur.brow * g.ldb * 2;
    PG8_STAGE(PG8_SB(0, 0), cB, voffB); PG8_STAGE(PG8_SB(0, 1), cB + hB, voffB); PG8_STAGE(PG8_SA(0, 0), cA, voffA); PG8_STAGE(PG8_SA(0, 1), cA + hA, voffA);
    if (wr == 1) PG8_BAR;
    PG8_WAIT_V(2); PG8_BAR;
    PG8_STAGE(PG8_SB(1, 0), cB + kstep, voffB); PG8_STAGE(PG8_SA(1, 0), cA + kstep, voffA); PG8_STAGE(PG8_SB(1, 1), cB + hB + kstep, voffB);
    PG8_WAIT_V(6); PG8_BAR;
    for (;;) {
        const bool has_next = S.next(ui + 1, nxt);
        const char* nA = has_next ? (const char*)g.A + (long)nxt.arow * g.lda * 2 : cA; const char* nB = has_next ? (const char*)g.Bt + (long)nxt.brow * g.ldb * 2 : cB;
#pragma unroll 1
        for (int t = 0; t < nt; t += 2) {
            asm volatile("" : "+v"(voffA[0]), "+v"(voffA[1]), "+v"(voffB[0]), "+v"(voffB[1]));
            const bool last = (t == nt - 2);
            const char* a1 = cA + (size_t)(t + 1) * kstep;
            const char* a2 = last ? nA : cA + (size_t)(t + 2) * kstep; const char* b2 = last ? nB : cB + (size_t)(t + 2) * kstep;
            const char* a3 = a2 + kstep; const char* b3 = b2 + kstep;
            asm volatile("" : "+s"(a3), "+s"(b3));
            PG8_LDB(B0, 0, 0); PG8_LDB(B1, 0, 1); PG8_SCHED; PG8_LDA(At, 0, 0); PG8_STAGE(PG8_SA(1, 1), a1 + hA, voffA);
            PG8_WAIT_V(8); PG8_WAIT_L(0); PG8_BAR; PG8_MMA(0, 0, At, B0); PG8_MMA(0, 1, At, B1); PG8_BAR; PG8_SCHED;
            PG8_LDA(At, 0, 1); PG8_STAGE(PG8_SB(0, 0), b2, voffB); PG8_STAGE(PG8_SB(0, 1), b2 + hB, voffB); PG8_STAGE(PG8_SA(0, 0), a2, voffA);
            PG8_WAIT_V(8); PG8_WAIT_L(0); PG8_BAR; PG8_MMA(1, 0, At, B0); PG8_MMA(1, 1, At, B1); PG8_BAR; PG8_SCHED;
            PG8_LDB(B0, 1, 0); PG8_LDB(B1, 1, 1); PG8_SCHED; PG8_LDA(At, 1, 0); PG8_STAGE(PG8_SA(0, 1), a2 + hA, voffA);
            PG8_WAIT_V(8); PG8_WAIT_L(0); PG8_BAR; PG8_MMA(0, 0, At, B0); PG8_MMA(0, 1, At, B1); PG8_BAR; PG8_SCHED;
            PG8_LDA(At, 1, 1); PG8_STAGE(PG8_SB(1, 0), b3, voffB); PG8_STAGE(PG8_SB(1, 1), b3 + hB, voffB); PG8_STAGE(PG8_SA(1, 0), a3, voffA);
            PG8_WAIT_V(8); PG8_WAIT_L(0); PG8_BAR; PG8_MMA(1, 0, At, B0); PG8_MMA(1, 1, At, B1); PG8_BAR; PG8_SCHED;
        }
        if constexpr (ALIGN_EPI) { if (wr == 0) PG8_BAR; }
        { int fr_ = fr, fq_ = fq, wr_ = wr, wc_ = wc; asm volatile("" : "+v"(fr_), "+v"(fq_), "+s"(wr_), "+s"(wc_));
          E(acc, cur, wr_, wc_, fr_, fq_); }
        if (!has_next) break;
#pragma unroll
        for (int a = 0; a < 2; ++a)
#pragma unroll
            for (int b = 0; b < 2; ++b)
#pragma unroll
                for (int m = 0; m < 4; ++m)
#pragma unroll
                    for (int n = 0; n < 2; ++n) acc[a][b][m][n] = (f32x4){0.f, 0.f, 0.f, 0.f};
        cur = nxt; cA = nA; cB = nB; ++ui;
        if constexpr (ALIGN_EPI) { if (wr == 1) PG8_BAR; }
    }
    PG8_WAIT_V(0);
    if constexpr (!ALIGN_EPI) { if (wr == 0) PG8_BAR; }
    PG8_BAR;
#undef PG8_SA
#undef PG8_SB
#undef PG8_STAGE
#undef PG8_LDA
#undef PG8_LDB
#undef PG8_MMA
#undef PG8_WAIT_V
#undef PG8_WAIT_L
#undef PG8_BAR
#undef PG8_SCHED
}
}
namespace og {
using pg8::Unit; using pg8::f32x4; using pg8::u32x4; using pg8::u32x2; using pg8::cvt_pk_bf16;
__device__ __forceinline__ void grid2d(int L, int nM, int nN, int& pm, int& pn) {
    const int nwg = nM * nN; int wgid = L;
    { const int q = nwg / 8, r = nwg % 8, xcd = wgid % 8, off = wgid / 8; wgid = (xcd < r ? xcd * (q + 1) : r * (q + 1) + (xcd - r) * q) + off; }
    const int nig = 8 * nN, gid = wgid / nig, fm = gid * 8, gsz = (nM - fm) < 8 ? (nM - fm) : 8;
    pm = fm + ((wgid % nig) % gsz); pn = (wgid % nig) / gsz;
}
struct SchedMN { int nM, nN, G, c;
    __device__ __forceinline__ bool next(int i, Unit& u) const { const int L = i * G + c; if (L >= nM * nN) return false; grid2d(L, nM, nN, u.pm, u.pn); u.arow = 256 * u.pm; u.brow = 256 * u.pn; return true; } };
struct SchedIn { int G, c;
    __device__ __forceinline__ bool next(int i, Unit& u) const { const int L = i * G + c;
        if (L < 1408) { grid2d(L, 64, 22, u.pm, u.pn); } else if (L < 1448) { const int lc = L - 1408; u.pm = 64 + lc / 10; u.pn = 4 + lc % 10; } else return false;
        u.arow = 256 * u.pm; u.brow = 256 * u.pn; return true; } };
struct SchedUp { int G, c;
    __device__ __forceinline__ bool next(int i, Unit& u) const { const int L = i * G + c; if (L >= 68 * 22) return false; grid2d(L, 68, 22, u.pm, u.pn);
        u.arow = (u.pm / 17) * SEQL + 248 * (u.pm % 17) - 1; u.brow = 256 * u.pn; return true; } };
struct SchedOne { Unit v; __device__ __forceinline__ bool next(int i, Unit& u) const { if (i) return false; u = v; return true; } };

__device__ __forceinline__ u32x4 pack8(const f32x4 a, const f32x4 b) { u32x4 w; w.x = cvt_pk_bf16(a[0], a[1]); w.y = cvt_pk_bf16(a[2], a[3]); w.z = cvt_pk_bf16(b[0], b[1]); w.w = cvt_pk_bf16(b[2], b[3]); return w; }
__device__ __forceinline__ u32x2 pack4(const f32x4 a) { u32x2 w; w.x = cvt_pk_bf16(a[0], a[1]); w.y = cvt_pk_bf16(a[2], a[3]); return w; }
__device__ __forceinline__ u32x4 ld_nt(const u32x4* p) { return __builtin_nontemporal_load(p); }
__device__ __forceinline__ f32x4 ld_nt(const f32x4* p) { return __builtin_nontemporal_load(p); }
__device__ __forceinline__ f32x4 unpk_lo(const u32x4 w) { return (f32x4){__uint_as_float(w.x << 16), __uint_as_float(w.x & 0xffff0000u), __uint_as_float(w.y << 16), __uint_as_float(w.y & 0xffff0000u)}; }
__device__ __forceinline__ f32x4 unpk_hi(const u32x4 w) { return (f32x4){__uint_as_float(w.z << 16), __uint_as_float(w.z & 0xffff0000u), __uint_as_float(w.w << 16), __uint_as_float(w.w & 0xffff0000u)}; }
__device__ __forceinline__ float sigf(float x) { return __builtin_amdgcn_rcpf(1.f + __builtin_amdgcn_exp2f(-1.4426950408889634f * x)); }
__device__ __forceinline__ f32x4 sig4(const f32x4 x) { return (f32x4){sigf(x[0]), sigf(x[1]), sigf(x[2]), sigf(x[3])}; }
__device__ __forceinline__ float sigb(float a, float nb) { return __builtin_amdgcn_rcpf(1.f + __builtin_amdgcn_exp2f(__builtin_fmaf(a, -1.4426950408889634f, nb))); }
__device__ __forceinline__ f32x4 sigb4(const f32x4 a, const f32x4 nb) {
    const f32x4 t = a * -1.4426950408889634f + nb;
    const f32x4 e1 = (f32x4){__builtin_amdgcn_exp2f(t[0]), __builtin_amdgcn_exp2f(t[1]), __builtin_amdgcn_exp2f(t[2]), __builtin_amdgcn_exp2f(t[3])} + 1.f;
    return (f32x4){__builtin_amdgcn_rcpf(e1[0]), __builtin_amdgcn_rcpf(e1[1]), __builtin_amdgcn_rcpf(e1[2]), __builtin_amdgcn_rcpf(e1[3])}; }

struct EpiIn {
    static constexpr bool PERM = true;
    const Ptrs* Pp;
    __device__ __forceinline__ void operator()(const f32x4 (&acc)[2][2][4][2], const Unit& u, int wr, int wc, int fr, int fq) const {
        const Ptrs& P = *Pp;
        const bool isctx = u.pm >= 64; const int pn = u.pn;
        if (pn < 8) {
            const bool isq = pn < 4;
            const float* w = isq ? P.in[IN_QNW] : P.in[IN_KNW];
            f32x4 wv[2][2];
#pragma unroll
            for (int bj = 0; bj < 2; ++bj)
#pragma unroll
                for (int n = 0; n < 2; ++n) wv[bj][n] = *(const f32x4*)(w + 32 * bj + 16 * n + 4 * fq) * (isq ? C2 : 1.f);
            const int h = (pn & 3) * 2 + (wc >> 1), mm = wc & 1;
            const float* tab = (const float*)(P.ws + WS_ROPE);
#pragma unroll
            for (int ai = 0; ai < 2; ++ai)
#pragma unroll
                for (int m = 0; m < 4; ++m) {
                    const int r = 256 * u.pm + 128 * ai + 64 * wr + 16 * m + fr;
                    const int b = isctx ? (r - MR) / NCTX : r / SEQL, t = isctx ? (r - MR) % NCTX : r % SEQL, key = isctx ? t : NCTX + t;
                    float ss = 0.f;
#pragma unroll
                    for (int bj = 0; bj < 2; ++bj)
#pragma unroll
                        for (int n = 0; n < 2; ++n) { const f32x4 x = acc[ai][bj][m][n]; ss += (x[0] * x[0] + x[1] * x[1]) + (x[2] * x[2] + x[3] * x[3]); }
                    ss = xor32_sum(xor16_sum(ss));
                    const float rs = __builtin_amdgcn_rsqf(ss * (1.f / 64.f) + EPSN);
#pragma unroll
                    for (int bj = 0; bj < 2; ++bj) {
                        f32x4 x1 = acc[ai][bj][m][0] * rs * wv[bj][0], x2 = acc[ai][bj][m][1] * rs * wv[bj][1];
                        if (!isctx) {
                            const int pos = bj == 0 ? (t >> 6) : (t & 63);
                            const f32x4 t0 = *(const f32x4*)(tab + (pos * 16 + 4 * fq) * 2), t1 = *(const f32x4*)(tab + (pos * 16 + 4 * fq) * 2 + 4);
                            const f32x4 cs = (f32x4){t0[0], t0[2], t1[0], t1[2]}, sn = (f32x4){t0[1], t0[3], t1[1], t1[3]};
                            const f32x4 o1 = x1 * cs - x2 * sn, o2 = x2 * cs + x1 * sn;
                            x1 = o1; x2 = o2;
                        }
                        if (isq) {
                            bf16_t* q = (bf16_t*)(P.ws + WS_RQ);
                            *(u32x2*)(q + q_idx(b, t, h, mm, 32 * bj + 4 * fq)) = pack4(x1);
                            *(u32x2*)(q + q_idx(b, t, h, mm, 32 * bj + 16 + 4 * fq)) = pack4(x2);
                        } else {
                            bf16_t* k = (bf16_t*)(P.ws + WS_RK);
                            *(u32x2*)(k + k_idx(b, h, mm, key, 32 * bj + 4 * fq)) = pack4(x1);
                            *(u32x2*)(k + k_idx(b, h, mm, key, 32 * bj + 16 + 4 * fq)) = pack4(x2);
                        }
                    }
                }
        } else if (pn < 12) {
#pragma unroll
            for (int ai = 0; ai < 2; ++ai)
#pragma unroll
                for (int m = 0; m < 4; ++m) {
                    const int r = 256 * u.pm + 128 * ai + 64 * wr + 16 * m + fr;
                    const int b = isctx ? (r - MR) / NCTX : r / SEQL, t = isctx ? (r - MR) % NCTX : r % SEQL, key = isctx ? t : NCTX + t;
#pragma unroll
                    for (int bj = 0; bj < 2; ++bj)
                        *(u32x4*)((bf16_t*)(P.ws + WS_RV) + v_idx(b, 2 * (pn - 8) + bj, key, 32 * wc + 8 * fq)) = pack8(acc[ai][bj][m][0], acc[ai][bj][m][1]);
                }
        } else if (pn < 14) {
#pragma unroll
            for (int ai = 0; ai < 2; ++ai)
#pragma unroll
                for (int m = 0; m < 4; ++m) {
                    const int r = 256 * u.pm + 128 * ai + 64 * wr + 16 * m + fr;
                    const int b = isctx ? (r - MR) / NCTX : r / SEQL, t = isctx ? (r - MR) % NCTX : r % SEQL;
                    const int chunk = isctx ? 256 + (t >> 4) : (t >> 4), sig = t & 15;
#pragma unroll
                    for (int bj = 0; bj < 2; ++bj) { const int c = 256 * (pn - 12) + 128 * bj + 32 * wc + 8 * fq;
                        *(u32x4*)((bf16_t*)(P.ws + WS_RU) + u_idx(b, c >> 4, chunk, sig, c & 15)) = pack8(acc[ai][bj][m][0], acc[ai][bj][m][1]); }
                }
        } else if (!isctx) {
#pragma unroll
            for (int bj = 0; bj < 2; ++bj) {
                const int c = 256 * (pn - 14) + 128 * bj + 32 * wc + 8 * fq;
                const f32x4 b0 = *(const f32x4*)(P.in[IN_BGATE] + c) * -1.4426950408889634f, b1 = *(const f32x4*)(P.in[IN_BGATE] + c + 4) * -1.4426950408889634f;
#pragma unroll
                for (int ai = 0; ai < 2; ++ai)
#pragma unroll
                    for (int m = 0; m < 4; ++m) {
                        const int r = 256 * u.pm + 128 * ai + 64 * wr + 16 * m + fr;
                        *(u32x4*)((bf16_t*)P.out + (size_t)r * 2048 + c) = pack8(sigb4(acc[ai][bj][m][0], b0), sigb4(acc[ai][bj][m][1], b1));
                    }
            }
        }
    }
};
struct EpiGlu {
    static constexpr bool PERM = true;
    const Ptrs* Pp;
    __device__ __forceinline__ void operator()(const f32x4 (&acc)[2][2][4][2], const Unit& u, int wr, int wc, int fr, int fq) const {
        const Ptrs& P = *Pp;
#pragma unroll
        for (int bj = 0; bj < 2; ++bj) {
            const int c = 256 * u.pn + 128 * bj + 32 * wc + 8 * fq;
            const f32x4 b0 = *(const f32x4*)(P.in[IN_GLUB] + c) * -1.4426950408889634f, b1 = *(const f32x4*)(P.in[IN_GLUB] + c + 4) * -1.4426950408889634f;
#pragma unroll
            for (int ai = 0; ai < 2; ++ai)
#pragma unroll
                for (int m = 0; m < 4; ++m) {
                    const size_t r = 256 * u.pm + 128 * ai + 64 * wr + 16 * m + fr;
                    const u32x4 hs = *(const u32x4*)((const bf16_t*)(P.ws + WS_HS) + r * S5W + c);
                    *(u32x4*)((bf16_t*)(P.ws + WS_HS2) + r * S5W + c) = pack8(unpk_lo(hs) * sigb4(acc[ai][bj][m][0], b0), unpk_hi(hs) * sigb4(acc[ai][bj][m][1], b1));
                }
        }
    }
};
template <int STEP, int GO> struct EpiBranch {
    static constexpr bool PERM = true;
    const Ptrs* Pp;
    __device__ __forceinline__ void operator()(const f32x4 (&acc)[2][2][4][2], const Unit& u, int wr, int wc, int fr, int fq) const {
        const Ptrs& P = *Pp;
#pragma unroll
        for (int ai = 0; ai < 2; ++ai)
#pragma unroll
            for (int m = 0; m < 4; ++m) {
                const size_t r = 256 * u.pm + 128 * ai + 64 * wr + 16 * m + fr;
#pragma unroll
                for (int bj = 0; bj < 2; ++bj) {
                    const int c = 256 * u.pn + 128 * bj + 32 * wc + 8 * fq;
                    const u32x4 gt = *(const u32x4*)((const bf16_t*)P.out + r * 2048 + GO + c);
                    bf16_t* T = (bf16_t*)(P.ws + WS_T) + r * DM + c;
                    if (STEP == 0) { *(u32x4*)T = pack8(unpk_lo(gt) * acc[ai][bj][m][0], unpk_hi(gt) * acc[ai][bj][m][1]); }
                    else { const u32x4 tt = *(const u32x4*)T;
                        *(u32x4*)((bf16_t*)(P.ws + WS_MB) + r * DM + c) = pack8(unpk_lo(tt) + unpk_lo(gt) * acc[ai][bj][m][0], unpk_hi(tt) + unpk_hi(gt) * acc[ai][bj][m][1]); }
                }
            }
    }
};
struct EpiOut {
    static constexpr bool PERM = true;
    const Ptrs* Pp;
    __device__ __forceinline__ void operator()(const f32x4 (&acc)[2][2][4][2], const Unit& u, int wr, int wc, int fr, int fq) const {
        const Ptrs& P = *Pp;
        const int b = u.pm / 16;
        const float* mod = (const float*)(P.ws + WS_MODFIN) + b * 6144;
        f32x4 ga[2][2], sw[2][2];
#pragma unroll
        for (int bj = 0; bj < 2; ++bj)
#pragma unroll
            for (int n = 0; n < 2; ++n) { const int c = 256 * u.pn + 128 * bj + 32 * wc + 8 * fq + 4 * n;
                ga[bj][n] = *(const f32x4*)(mod + 2048 + c); sw[bj][n] = *(const f32x4*)(P.in[IN_N2W] + c) * (*(const f32x4*)(mod + 4096 + c) + 1.f); }
        float ssg[8];
#pragma unroll
        for (int ai = 0; ai < 2; ++ai)
#pragma unroll
            for (int m = 0; m < 4; ++m) {
                const size_t r = 256 * u.pm + 128 * ai + 64 * wr + 16 * m + fr;
                float ss = 0.f;
#pragma unroll
                for (int bj = 0; bj < 2; ++bj) {
                    const int c = 256 * u.pn + 128 * bj + 32 * wc + 8 * fq;
                    const f32x4 x0 = ld_nt((const f32x4*)(P.in[IN_X] + r * DM + c)) + ga[bj][0] * acc[ai][bj][m][0], x1 = ld_nt((const f32x4*)(P.in[IN_X] + r * DM + c + 4)) + ga[bj][1] * acc[ai][bj][m][1];
                    *(u32x4*)((bf16_t*)(P.ws + WS_X1R) + r * DM + c) = pack8(x0, x1);
                    *(u32x4*)((bf16_t*)(P.ws + WS_X1B) + r * DM + c) = pack8(x0 * sw[bj][0], x1 * sw[bj][1]);
                    ss += (x0[0] * x0[0] + x0[1] * x0[1]) + (x0[2] * x0[2] + x0[3] * x0[3]) + (x1[0] * x1[0] + x1[1] * x1[1]) + (x1[2] * x1[2] + x1[3] * x1[3]);
                }
                ssg[ai * 4 + m] = xor32_sum(xor16_sum(ss));
            }
        { const float v0 = fq == 0 ? ssg[0] : fq == 1 ? ssg[1] : fq == 2 ? ssg[2] : ssg[3], v1 = fq == 0 ? ssg[4] : fq == 1 ? ssg[5] : fq == 2 ? ssg[6] : ssg[7];
          float* rq = (float*)(P.ws + WS_ROWSQ) + 256 * u.pm + 64 * wr + 16 * fq + fr;
          atomicAdd(rq, v0); atomicAdd(rq + 128, v1); }
    }
};
struct EpiDown {
    static constexpr bool PERM = true;
    const Ptrs* Pp;
    __device__ __forceinline__ void operator()(const f32x4 (&acc)[2][2][4][2], const Unit& u, int wr, int wc, int fr, int fq) const {
        const Ptrs& P = *Pp;
        const float* mod = (const float*)(P.ws + WS_MODFIN) + (u.pm / 16) * 6144 + 5120;
#pragma unroll
        for (int bj = 0; bj < 2; ++bj) {
            const int c = 256 * u.pn + 128 * bj + 32 * wc + 8 * fq;
            const f32x4 g0 = *(const f32x4*)(mod + c), g1 = *(const f32x4*)(mod + c + 4);
#pragma unroll
            for (int ai = 0; ai < 2; ++ai)
#pragma unroll
                for (int m = 0; m < 4; ++m) {
                    const size_t e = (size_t)(256 * u.pm + 128 * ai + 64 * wr + 16 * m + fr) * DM + c;
                    const u32x4 xr = ld_nt((const u32x4*)((const bf16_t*)(P.ws + WS_X1R) + e));
                    float* o = P.out + e;
                    __builtin_nontemporal_store(unpk_lo(xr) + g0 * acc[ai][bj][m][0], (f32x4*)o); __builtin_nontemporal_store(unpk_hi(xr) + g1 * acc[ai][bj][m][1], (f32x4*)(o + 4));
                }
        }
    }
};
__device__ __forceinline__ float dpp_ror1(float v) { return __int_as_float(__builtin_amdgcn_mov_dpp(__float_as_int(v), 0x121, 0xf, 0xf, true)); }
__device__ __forceinline__ float dpp_rol1(float v) { return __int_as_float(__builtin_amdgcn_mov_dpp(__float_as_int(v), 0x12f, 0xf, 0xf, true)); }
__device__ __forceinline__ float dpp_shr1_zero(float v) { return __int_as_float(__builtin_amdgcn_mov_dpp(__float_as_int(v), 0x111, 0xf, 0xf, true)); }
__device__ __forceinline__ float dpp_shl1_zero(float v) { return __int_as_float(__builtin_amdgcn_mov_dpp(__float_as_int(v), 0x101, 0xf, 0xf, true)); }
__device__ __forceinline__ float dpp_shr1_keep(float old, float v) { return __int_as_float(__builtin_amdgcn_update_dpp(__float_as_int(old), __float_as_int(v), 0x111, 0xf, 0xf, false)); }
__device__ __forceinline__ float dpp_shl1_keep(float old, float v) { return __int_as_float(__builtin_amdgcn_update_dpp(__float_as_int(old), __float_as_int(v), 0x101, 0xf, 0xf, false)); }
typedef float f32x2 __attribute__((ext_vector_type(2)));
struct EpiUp {
    static constexpr bool PERM = true;
    const Ptrs* Pp;
    __device__ __forceinline__ void operator()(const f32x4 (&acc)[2][2][4][2], const Unit& u, int wr_, int wc_, int fr_, int fq_) const {
        const int ti = u.pm % 17;
        if (ti == 0 || ti == 16) run<true>(acc, u, wr_, wc_, fr_, fq_); else run<false>(acc, u, wr_, wc_, fr_, fq_);
    }
    template <bool MASK>
    __device__ __forceinline__ void run(const f32x4 (&acc)[2][2][4][2], const Unit& u, int wr_, int wc_, int fr_, int fq_) const {
        const Ptrs& P = *Pp;
        const int wr = wr_, wc = wc_, fr = fr_, fq = fq_;
        const int b = u.pm / 17, ti = u.pm % 17;
        const float* rq = (const float*)(P.ws + WS_ROWSQ) + (size_t)b * SEQL + 248 * ti + 62 * wr + 4 * fr - 1;
        const f32x4* ct = (const f32x4*)(P.ws + WS_CONVTAB) + (size_t)((((b * 22 + u.pn) * 4 + wc) * 4 + fq) * 20);
        const int ca0 = 128 * u.pn + 32 * wc + 8 * fq;
        float rstd[2][4]; bool valid[2][4];
#pragma unroll
        for (int ai = 0; ai < 2; ++ai)
#pragma unroll
            for (int m = 0; m < 4; ++m) {
                const int tok = 248 * ti + 62 * (2 * ai + wr) + 4 * fr + m - 1;
                valid[ai][m] = tok >= 0 && tok < SEQL;
                rstd[ai][m] = __builtin_amdgcn_rsqf(rq[124 * ai + m] * (1.f / DM) + EPSN);
            }
        bf16_t* ACT = (bf16_t*)(P.ws + WS_ACT);
        f32x4 nw0 = ct[0], nw1 = ct[1], nw2 = ct[2], nbb = ct[3], nbv = ct[4];
#pragma unroll
        for (int ai = 0; ai < 2; ++ai) {
            f32x2 ya[4][2][2];
#pragma unroll
            for (int bj = 0; bj < 2; ++bj)
#pragma unroll
                for (int n = 0; n < 2; ++n) {
                    const f32x4 w0 = nw0, w1 = nw1, w2 = nw2, bb = nbb, bv = nbv;
                    { const int gn = (bj * 2 + n + 1) & 3;
                      if (!(ai == 1 && bj == 1 && n == 1)) { nw0 = ct[gn * 5 + 0]; nw1 = ct[gn * 5 + 1]; nw2 = ct[gn * 5 + 2]; nbb = ct[gn * 5 + 3]; nbv = ct[gn * 5 + 4]; } }
                    __builtin_amdgcn_sched_barrier(0);
#pragma unroll
                    for (int jp = 0; jp < 2; ++jp) {
                        const f32x2 bv2 = {bv[2 * jp], bv[2 * jp + 1]}, bb2 = {bb[2 * jp], bb[2 * jp + 1]}, w02 = {w0[2 * jp], w0[2 * jp + 1]}, w12 = {w1[2 * jp], w1[2 * jp + 1]}, w22 = {w2[2 * jp], w2[2 * jp + 1]};
                        f32x2 x[4], up[4], dn[4];
#pragma unroll
                        for (int m = 0; m < 4; ++m) { const f32x2 a2 = {acc[ai][bj][m][n][2 * jp], acc[ai][bj][m][n][2 * jp + 1]}, r2 = {rstd[ai][m], rstd[ai][m]}; const f32x2 v = a2 * r2 + bv2;
                            x[m] = (!MASK || valid[ai][m]) ? v : (f32x2){0.f, 0.f}; }
                        up[0] = (f32x2){dpp_shr1_zero(x[3].x), dpp_shr1_zero(x[3].y)};
                        dn[3] = (f32x2){dpp_shl1_zero(x[0].x), dpp_shl1_zero(x[0].y)};
#pragma unroll
                        for (int m = 1; m < 4; ++m) up[m] = x[m - 1];
#pragma unroll
                        for (int m = 0; m < 3; ++m) dn[m] = x[m + 1];
#pragma unroll
                        for (int m = 0; m < 4; ++m) {
                            const f32x2 y = bb2 + w02 * up[m] + w12 * x[m] + w22 * dn[m];
                            if (bj == 0) ya[m][n][jp] = y;
                            else { const f32x2 e1 = (f32x2){__builtin_amdgcn_exp2f(-y.x), __builtin_amdgcn_exp2f(-y.y)} + 1.f; const f32x2 r = {__builtin_amdgcn_rcpf(e1.x), __builtin_amdgcn_rcpf(e1.y)};
                                ya[m][n][jp] = y * r * ya[m][n][jp]; }
                        }
                        asm volatile("" : "+v"(ya[0][n][jp]), "+v"(ya[1][n][jp]), "+v"(ya[2][n][jp]), "+v"(ya[3][n][jp]));
                        __builtin_amdgcn_sched_barrier(0);
                    }
                    asm volatile("" ::: "memory");
                }
#pragma unroll
            for (int m = 0; m < 4; ++m) {
                const int w = 4 * fr + m, tok = 248 * ti + 62 * (2 * ai + wr) + w - 1;
                u32x4 o; o.x = cvt_pk_bf16(ya[m][0][0].x, ya[m][0][0].y); o.y = cvt_pk_bf16(ya[m][0][1].x, ya[m][0][1].y); o.z = cvt_pk_bf16(ya[m][1][0].x, ya[m][1][0].y); o.w = cvt_pk_bf16(ya[m][1][1].x, ya[m][1][1].y);
                if (w >= 1 && w <= 62 && tok < SEQL) *(u32x4*)(ACT + ((size_t)b * SEQL + tok) * DFF + ca0) = o;
                __builtin_amdgcn_sched_barrier(0);
            }
        }
    }
};

__device__ __forceinline__ unsigned f2bf_u(float f) { unsigned u = __float_as_uint(f); return (u + 0x7fffu + ((u >> 16) & 1u)) >> 16; }
__device__ __forceinline__ unsigned pk2(float lo, float hi) { return f2bf_u(lo) | (f2bf_u(hi) << 16); }
template <class F>
__device__ __forceinline__ void transpose_load(const float* W, int N, int item, int lane, F srccol, float (&v_)[32]) {
    const int nblk = N / 32, kb = item / nblk, nb = item % nblk, k0 = 64 * kb, n0 = 32 * nb;
    const int col = srccol(n0 + (lane & 31));
#pragma unroll
    for (int i = 0; i < 32; ++i) v_[i] = __builtin_nontemporal_load(W + (size_t)(k0 + 2 * i + (lane >> 5)) * N + col);
}
__device__ __forceinline__ void transpose_store(int K, int N, bf16_t* WT, LAS float* scr, int item, int lane, const float (&v_)[32]) {
    const int nblk = N / 32, kb = item / nblk, nb = item % nblk, k0 = 64 * kb, n0 = 32 * nb;
#pragma unroll
    for (int i = 0; i < 32; ++i) scr[(2 * i + (lane >> 5)) * 33 + (lane & 31)] = v_[i];
    asm volatile("s_waitcnt lgkmcnt(0)" ::: "memory");
    const int c = lane & 7;
#pragma unroll
    for (int j = 0; j < 4; ++j) { const int n = (lane >> 3) + 8 * j; const LAS float* s = scr + (8 * c) * 33 + n;
        u32x4 o; o.x = cvt_pk_bf16(s[0 * 33], s[1 * 33]); o.y = cvt_pk_bf16(s[2 * 33], s[3 * 33]); o.z = cvt_pk_bf16(s[4 * 33], s[5 * 33]); o.w = cvt_pk_bf16(s[6 * 33], s[7 * 33]);
        *(u32x4*)(WT + (size_t)(n0 + n) * K + k0 + 8 * c) = o; }
    asm volatile("s_waitcnt lgkmcnt(0)" ::: "memory");
}
template <class F>
__device__ __forceinline__ void transpose_item(const float* W, int K, int N, bf16_t* WT, LAS float* scr, int item, int lane, F srccol) {
    float v_[32]; transpose_load(W, N, item, lane, srccol, v_); transpose_store(K, N, WT, scr, item, lane, v_);
}
__device__ __forceinline__ void build_convtab(const Ptrs& P, int gtid) {
    if (gtid >= 1408 * 80) return;
    const int e = gtid % 80, entry = gtid / 80, bj = e / 40, n = (e / 20) & 1, k = (e >> 2) % 5, j = e & 3;
    const int fq = entry & 3, wc = (entry >> 2) & 3, pn = (entry >> 4) % 22, b = entry / 352;
    const int col = bj * DFF + 128 * pn + 32 * wc + 8 * fq + 4 * n + j;
    const float v = k < 3 ? P.in[IN_CONVW][k * NIN + col] : (k == 3 ? P.in[IN_CONVB][col] : ((const float*)(P.ws + WS_BIASUP))[b * NIN + col]);
    ((float*)(P.ws + WS_CONVTAB))[gtid] = k <= 3 ? v * (bj ? 1.4426950408889634f : 0.6931471805599453f) : v;
}
struct ColId { __device__ __forceinline__ int operator()(int n) const { return n; } };
struct ColIn { __device__ __forceinline__ int operator()(int n) const {
        if (n >= 2048) return n; const int s = n & 255, bj = s >> 7, wc = (s >> 5) & 3, fq = (s >> 3) & 3, nn = (s >> 2) & 1, j = s & 3; return (n & ~255) + 64 * wc + 32 * bj + 16 * nn + 4 * fq + j; } };
struct ColUp { __device__ __forceinline__ int operator()(int n) const { const int pn = n >> 8, s = n & 255; return s < 128 ? 128 * pn + s : DFF + 128 * pn + (s - 128); } };
constexpr int I_IN = 16 * 176, I_UP = 16 * 176, I_DN = 44 * 32, I_OUT = 16 * 32, I_BA = 16 * 32, I_BS = 8 * 32, I_GLU = 8 * 16;
constexpr int NTR_ITEMS = I_IN + I_UP + I_DN + I_OUT + I_BA + I_BS + I_GLU;
__device__ __forceinline__ void transpose_setA(const Ptrs& P, LAS float* scr, int r, int lane) {
    if (r < I_IN) { transpose_item(P.in[IN_WIN], DM, NIN, (bf16_t*)(P.ws + WS_WIN), scr, r, lane, ColIn()); return; } r -= I_IN;
    transpose_item(P.in[IN_GLUW], S5W, S5W, (bf16_t*)(P.ws + WS_WGLU), scr, r, lane, ColId());
}
__device__ __forceinline__ void transpose_setB(const Ptrs& P, LAS float* scr, int r, int lane) {
    if (r < I_OUT) { transpose_item(P.in[IN_WOUT], DM, DM, (bf16_t*)(P.ws + WS_WOUT), scr, r, lane, ColId()); return; } r -= I_OUT;
    if (r < I_BA) { transpose_item(P.in[IN_WBA], DM, DM, (bf16_t*)(P.ws + WS_WBA), scr, r, lane, ColId()); return; } r -= I_BA;
    transpose_item(P.in[IN_WBS], S5W, DM, (bf16_t*)(P.ws + WS_WBS), scr, r, lane, ColId());
}
__device__ __forceinline__ void transpose_setC(const Ptrs& P, LAS float* scr, int r, int lane) { transpose_item(P.in[IN_WUP], DM, NIN, (bf16_t*)(P.ws + WS_WUP), scr, r, lane, ColUp()); }
__device__ __forceinline__ void transpose_setD(const Ptrs& P, LAS float* scr, int r, int lane) { transpose_item(P.in[IN_WDOWN], DFF, DM, (bf16_t*)(P.ws + WS_WDOWN), scr, r, lane, ColId()); }
constexpr int NTR_A = I_IN + I_GLU, NTR_B = I_OUT + I_BA + I_BS, NTR_C = I_UP, NTR_D = I_DN;
struct SetA {
    static constexpr int N = NTR_A;
    static __device__ __forceinline__ void load(const Ptrs& P, int r, int lane, float (&v)[32]) { if (r < I_IN) transpose_load(P.in[IN_WIN], NIN, r, lane, ColIn(), v); else transpose_load(P.in[IN_GLUW], S5W, r - I_IN, lane, ColId(), v); }
    static __device__ __forceinline__ void store(const Ptrs& P, LAS float* scr, int r, int lane, const float (&v)[32]) {
        if (r < I_IN) transpose_store(DM, NIN, (bf16_t*)(P.ws + WS_WIN), scr, r, lane, v); else transpose_store(S5W, S5W, (bf16_t*)(P.ws + WS_WGLU), scr, r - I_IN, lane, v); } };
struct SetC {
    static constexpr int N = NTR_C;
    static __device__ __forceinline__ void load(const Ptrs& P, int r, int lane, float (&v)[32]) { transpose_load(P.in[IN_WUP], NIN, r, lane, ColUp(), v); }
    static __device__ __forceinline__ void store(const Ptrs& P, LAS float* scr, int r, int lane, const float (&v)[32]) { transpose_store(DM, NIN, (bf16_t*)(P.ws + WS_WUP), scr, r, lane, v); } };
template <class Set>
__device__ __forceinline__ void transposes_pipelined(const Ptrs& P, LAS unsigned char* lds, int gw, int NGW, int wave, int lane) {
    LAS float* scr = (LAS float*)(lds + wave * 8704);
    int it = gw; if (it >= Set::N) return;
    float a[32], b[32];
    Set::load(P, it, lane, a);
    for (;;) {
        { const int nx = it + NGW; const bool hn = nx < Set::N; if (hn) Set::load(P, nx, lane, b); Set::store(P, scr, it, lane, a); if (!hn) break; it = nx; }
        { const int nx = it + NGW; const bool hn = nx < Set::N; if (hn) Set::load(P, nx, lane, a); Set::store(P, scr, it, lane, b); if (!hn) break; it = nx; }
    }
}
__device__ __forceinline__ void transposes_A(const Ptrs& P, LAS unsigned char* lds, int gw, int NGW, int wave, int lane) { transposes_pipelined<SetA>(P, lds, gw, NGW, wave, lane); }
__device__ __forceinline__ void transposes_B(const Ptrs& P, LAS unsigned char* lds, int gw, int NGW, int wave, int lane) {
    LAS float* scr = (LAS float*)(lds + wave * 8704);
    for (int it = gw; it < NTR_B; it += NGW) transpose_setB(P, scr, it, lane);
}
__device__ __forceinline__ void transposes_C(const Ptrs& P, LAS unsigned char* lds, int gw, int NGW, int wave, int lane) { transposes_pipelined<SetC>(P, lds, gw, NGW, wave, lane); }
__device__ __forceinline__ void transposes_D(const Ptrs& P, LAS unsigned char* lds, int gw, int NGW, int wave, int lane) {
    LAS float* scr = (LAS float*)(lds + wave * 8704);
    for (int it = gw; it < NTR_D; it += NGW) transpose_setD(P, scr, it, lane);
}
}
#ifndef PROBE_MFMA
#define PROBE_MFMA 0
#endif
#ifndef PROBE_EXP
#define PROBE_EXP 0
#endif
#ifndef PROBE_LDS
#define PROBE_LDS 0
#endif
namespace at {
typedef float f32x16 __attribute__((ext_vector_type(16)));
typedef short bf16x8 __attribute__((ext_vector_type(8)));
typedef short s16x4 __attribute__((ext_vector_type(4)));
typedef unsigned u32x4 __attribute__((ext_vector_type(4)));
typedef float f32x4v __attribute__((ext_vector_type(4)));
constexpr int SLOT = 32768, XOFF = 65536, WSF = 131072;
__device__ __forceinline__ int crow(int r, int hi) { return (r & 3) + 8 * (r >> 2) + 4 * hi; }
typedef float f32x2_t __attribute__((ext_vector_type(2))); typedef __bf16 bf16x2_t __attribute__((ext_vector_type(2)));
__device__ __forceinline__ unsigned cvtpk(float lo, float hi) { f32x2_t v = {lo, hi}; bf16x2_t b = __builtin_convertvector(v, bf16x2_t); return __builtin_bit_cast(unsigned, b); }
__device__ __forceinline__ s16x4 vtr(const LAS unsigned char* p) { return __builtin_bit_cast(s16x4, __builtin_amdgcn_ds_read_tr16_b64_v4i16((LAS s16x4*)p)); }
#define AT_WAITBAR(N) asm volatile("s_waitcnt vmcnt(" #N ") lgkmcnt(0)\n\ts_barrier" ::: "memory")

struct Srcs { const char* k0; const char* k1; const char* v; unsigned lo; };
__device__ __forceinline__ void glds16(const char* sbase, unsigned voff, unsigned lds_dst) { unsigned keep;
    asm volatile("s_mov_b32 %0, m0\n\ts_mov_b32 m0, %3\n\ts_nop 0\n\tglobal_load_lds_dwordx4 %1, %2\n\ts_mov_b32 m0, %0" : "=&s"(keep) : "v"(voff), "s"(sbase), "s"(lds_dst) : "memory"); }
__device__ __forceinline__ void dma_piece(unsigned lds0, const Srcs& s, int t, int slot, int wid, int pc) {
    const unsigned d = (unsigned)__builtin_amdgcn_readfirstlane((int)(lds0 + slot * SLOT + wid * 1024));
    if (pc == 0) glds16(s.k0 + (size_t)t * 8192, s.lo, d);
    else if (pc == 1) glds16(s.k1 + (size_t)t * 8192, s.lo, d + 8192);
    else if (pc == 2) glds16(s.v + (size_t)t * 16384, s.lo, d + 16384 + wid * 1024);
    else glds16(s.v + (size_t)t * 16384 + 1024, s.lo, d + 16384 + wid * 1024 + 1024);
}
__device__ __forceinline__ void dma_tile(unsigned lds0, const Srcs& s, int t, int slot, int wid) {
#pragma unroll
    for (int pc = 0; pc < 4; ++pc) dma_piece(lds0, s, t, slot, wid, pc);
}
__device__ __forceinline__ Srcs unit_srcs(const Ptrs& P, int unit, int wid, int lane) {
    const int b = unit / (NHEAD * 32), h = (unit / 32) % NHEAD;
    Srcs s;
    s.k0 = (const char*)((const bf16_t*)(P.ws + WS_RK) + k_idx(b, h, 0, 0, 0)) + wid * 1024;
    s.k1 = (const char*)((const bf16_t*)(P.ws + WS_RK) + k_idx(b, h, 1, 0, 0)) + wid * 1024;
    s.v = (const char*)((const bf16_t*)(P.ws + WS_RV) + v_idx(b, h, 0, 0)) + wid * 2048;
    s.lo = (unsigned)lane * 16u;
    return s;
}
__device__ __forceinline__ void attn_unit(const Ptrs& P, LAS unsigned char* lds, int unit, int next_unit, bool first, float lam, float mshift, int wid, bf16_t* Obase) {
    int lane_ = lane_id(); asm volatile("" : "+v"(lane_));
    const int lane = lane_, r32 = lane & 31, hi = lane >> 5;
    const int mp = wid >> 2, wq = wid & 3;
    const int b = unit / (NHEAD * 32), h = (unit / 32) % NHEAD, q0 = (unit % 32) * 128;
    const Srcs S = unit_srcs(P, unit, wid, lane);
    const unsigned lds0 = (unsigned)(uintptr_t)lds;
    if (first) { dma_tile(lds0, S, 0, 0, wid); dma_tile(lds0, S, 1, 1, wid); }
    bf16_t* Qg = (bf16_t*)(P.ws + WS_RQ);
    bf16x8 qr[4];
#pragma unroll
    for (int d0 = 0; d0 < 4; ++d0) qr[d0] = *(const bf16x8*)(Qg + q_idx(b, q0 + wq * 32 + r32, h, mp, d0 * 16 + hi * 8));
    const f32x16 zero16 = (f32x16){0.f, 0.f, 0.f, 0.f, 0.f, 0.f, 0.f, 0.f, 0.f, 0.f, 0.f, 0.f, 0.f, 0.f, 0.f, 0.f};
    f32x16 o[4];
#pragma unroll
    for (int d0 = 0; d0 < 4; ++d0) o[d0] = zero16;
    float s0 = 0.f, s1 = 0.f;
    const int koff = mp * 8192 + hi * 1024 + r32 * 16;
    const int voff = 16384 + ((lane >> 4) & 1) * 32 + (lane & 3) * 8 + (4 * hi + ((lane & 15) >> 2)) * 64;
#define AT_SB() __builtin_amdgcn_sched_barrier(0)
#define AT_VF(src, k4) (bf16x8){src[2 * (k4)][0], src[2 * (k4)][1], src[2 * (k4)][2], src[2 * (k4)][3], src[2 * (k4) + 1][0], src[2 * (k4) + 1][1], src[2 * (k4) + 1][2], src[2 * (k4) + 1][3]}
#define AT_VT(vs_, d0, j) vtr(vs_ + (d0) * 4096 + ((j) >> 1) * 1024 + ((j) & 1) * 512)
#define AT_PACK() do { _Pragma("unroll") for (int q = 0; q < 4; ++q) { pw[0][q] = cvtpk(p0[2 * q], p0[2 * q + 1]); pw[1][q] = cvtpk(p0[8 + 2 * q], p0[8 + 2 * q + 1]); pw[2][q] = cvtpk(p1[2 * q], p1[2 * q + 1]); pw[3][q] = cvtpk(p1[8 + 2 * q], p1[8 + 2 * q + 1]); } } while (0)
    AT_WAITBAR(4);
    if (2 < NKT) dma_tile(lds0, S, 2, 2, wid);
    f32x16 p0, p1; u32x4 pw[4];
    {
        const LAS unsigned char* ks = lds + koff;
        bf16x8 kf[8];
#pragma unroll
        for (int i = 0; i < 8; ++i) kf[i] = *(const LAS bf16x8*)(ks + (i >> 1) * 2048 + (i & 1) * 512);
#pragma unroll
        for (int d0 = 0; d0 < 4; ++d0) {
            p0 = __builtin_amdgcn_mfma_f32_32x32x16_bf16(kf[2 * d0], qr[d0], d0 == 0 ? zero16 : p0, 0, 0, 0);
            p1 = __builtin_amdgcn_mfma_f32_32x32x16_bf16(kf[2 * d0 + 1], qr[d0], d0 == 0 ? zero16 : p1, 0, 0, 0);
        }
#pragma unroll
        for (int r = 0; r < 16; ++r) { p0[r] = __builtin_amdgcn_exp2f(p0[r]); p1[r] = __builtin_amdgcn_exp2f(p1[r]); s0 += p0[r]; s1 += p1[r]; }
    }
    for (int t = 0; t < NKT; ++t) {
        const bool more = t + 1 < NKT;
        if (t + 2 < NKT) { AT_WAITBAR(4); } else { AT_WAITBAR(0); }
        const bool pf = t + 3 < NKT;
        const LAS unsigned char* ks = lds + ((t + 1) & 3) * SLOT + koff;
        const LAS unsigned char* vs = lds + (t & 3) * SLOT + voff;
        bf16x8 kf[8]; s16x4 va[8], vb[8];
        if (more) {
#pragma unroll
            for (int i = 0; i < 8; ++i) kf[i] = *(const LAS bf16x8*)(ks + (i >> 1) * 2048 + (i & 1) * 512);
        }
#pragma unroll
        for (int j = 0; j < 8; ++j) va[j] = AT_VT(vs, 0, j);
        AT_SB();
        AT_PACK();
        AT_SB();
        if (more) {
#pragma unroll
            for (int i = 0; i < 8; ++i) {
                if ((i & 1) == 0) p0 = __builtin_amdgcn_mfma_f32_32x32x16_bf16(kf[i], qr[i >> 1], i < 2 ? zero16 : p0, 0, 0, 0);
                else p1 = __builtin_amdgcn_mfma_f32_32x32x16_bf16(kf[i], qr[i >> 1], i < 2 ? zero16 : p1, 0, 0, 0);
                vb[i] = AT_VT(vs, 1, i);
                if ((i & 1) && pf) dma_piece(lds0, S, t + 3, (t + 3) & 3, wid, i >> 1);
                AT_SB();
            }
        } else {
#pragma unroll
            for (int j = 0; j < 8; ++j) vb[j] = AT_VT(vs, 1, j);
            AT_SB();
        }
#pragma unroll
        for (int i = 0; i < 16; ++i) {
            const int d0 = i >> 2, k4 = i & 3;
            if ((d0 & 1) == 0) o[d0] = __builtin_amdgcn_mfma_f32_32x32x16_bf16(__builtin_bit_cast(bf16x8, pw[k4]), AT_VF(va, k4), o[d0], 0, 0, 0);
            else o[d0] = __builtin_amdgcn_mfma_f32_32x32x16_bf16(__builtin_bit_cast(bf16x8, pw[k4]), AT_VF(vb, k4), o[d0], 0, 0, 0);
            if (more) {
                const int r = 2 * (i & 7);
                if (i < 8) { p0[r] = __builtin_amdgcn_exp2f(p0[r]); p0[r + 1] = __builtin_amdgcn_exp2f(p0[r + 1]); s0 += p0[r]; s1 += p0[r + 1]; }
                else { p1[r] = __builtin_amdgcn_exp2f(p1[r]); p1[r + 1] = __builtin_amdgcn_exp2f(p1[r + 1]); s0 += p1[r]; s1 += p1[r + 1]; }
            }
            if (i >= 4 && i < 8) { va[2 * (i - 4)] = AT_VT(vs, 2, 2 * (i - 4)); va[2 * (i - 4) + 1] = AT_VT(vs, 2, 2 * (i - 4) + 1); }
            if (i >= 8 && i < 12) { vb[2 * (i - 8)] = AT_VT(vs, 3, 2 * (i - 8)); vb[2 * (i - 8) + 1] = AT_VT(vs, 3, 2 * (i - 8) + 1); }
            AT_SB();
        }
    }
    float l_reg = s0 + s1;
#undef AT_VF
#undef AT_VT
#undef AT_PACK
#undef AT_SB
    AT_WAITBAR(0);
    if (next_unit >= 0) { const Srcs N = unit_srcs(P, next_unit, wid, lane); dma_tile(lds0, N, 0, 0, wid); dma_tile(lds0, N, 1, 1, wid); }
    l_reg = xor32_sum(l_reg);
    LAS float* wsf = (LAS float*)(lds + WSF) + wid * 64;
    if (hi == 0) wsf[r32] = (mp == 0 ? 1.f : lam) / l_reg;
    asm volatile("s_waitcnt lgkmcnt(0)" ::: "memory");
    float fac[16];
#pragma unroll
    for (int r = 0; r < 16; ++r) fac[r] = wsf[crow(r, hi)];
    LAS f32x4v* X = (LAS f32x4v*)(lds + XOFF) + wq * 1024;
    if (mp == 1) {
#pragma unroll
        for (int d0 = 0; d0 < 4; ++d0)
#pragma unroll
            for (int q = 0; q < 4; ++q) X[(d0 * 4 + q) * 64 + lane] = (f32x4v){o[d0][4 * q] * fac[4 * q], o[d0][4 * q + 1] * fac[4 * q + 1], o[d0][4 * q + 2] * fac[4 * q + 2], o[d0][4 * q + 3] * fac[4 * q + 3]};
    }
    AT_WAITBAR(4);
    if (mp == 0) {
        float ss[16];
#pragma unroll
        for (int r = 0; r < 16; ++r) ss[r] = 0.f;
#pragma unroll
        for (int d0 = 0; d0 < 4; ++d0)
#pragma unroll
            for (int q = 0; q < 4; ++q) { const f32x4v xv = X[(d0 * 4 + q) * 64 + lane];
#pragma unroll
                for (int j = 0; j < 4; ++j) { const int r = 4 * q + j; const float v = o[d0][r] * fac[r] - xv[j]; o[d0][r] = v; ss[r] += v * v; } }
#pragma unroll
        for (int r = 0; r < 16; ++r) {
            float s = ss[r];
            s = xor16_sum(row16_sum(s));
            ss[r] = __builtin_amdgcn_rsqf(s * (1.f / 128.f) + EPSN) * (1.f - LAM_INIT);
        }
        asm volatile("s_waitcnt lgkmcnt(0)" ::: "memory");
        LAS bf16_t* stg = (LAS bf16_t*)(lds + XOFF + wq * 16384);
#pragma unroll
        for (int d0 = 0; d0 < 4; ++d0) {
            const float sw = P.in[IN_SUBLN][d0 * 32 + r32];
#pragma unroll
            for (int r = 0; r < 16; r += 2) { const unsigned pk = cvtpk(o[d0][r] * ss[r] * sw, o[d0][r + 1] * ss[r + 1] * sw);
                stg[crow(r, hi) * 128 + d0 * 32 + r32] = (bf16_t)(pk & 0xffffu); stg[crow(r + 1, hi) * 128 + d0 * 32 + r32] = (bf16_t)(pk >> 16); }
        }
        asm volatile("s_waitcnt lgkmcnt(0)" ::: "memory");
        bf16_t* On = Obase + ((size_t)(b * SEQL + q0 + wq * 32)) * 1024 + h * 128;
#pragma unroll
        for (int i = 0; i < 8; ++i) { const int row = i * 4 + (lane >> 4), ch = lane & 15;
            const u32x4 v = *(const LAS u32x4*)(stg + row * 128 + ch * 8);
            *(u32x4*)(On + (size_t)row * 1024 + ch * 8) = v; }
    }
}
#undef AT_WAITBAR
__device__ __forceinline__ void attn_phase(const Ptrs& P, LAS unsigned char* lds, int G, int bx, int wave, bf16_t* Obase) {
    const int lane = lane_id();
    asm volatile(".rept %0\n\ts_nop 0\n\t.endr" :: "i"(PAD_ATT));
    const float lam = __expf(wave_sum(P.in[IN_LQ1][lane] * P.in[IN_LK1][lane])) - __expf(wave_sum(P.in[IN_LQ2][lane] * P.in[IN_LK2][lane])) + LAM_INIT;
    const float mshift = 8.f * 1.4426950408889634f * wave_max(fabsf(P.in[IN_QNW][lane])) * wave_max(fabsf(P.in[IN_KNW][lane]));
    const int vcu = (G % 8 == 0) ? (bx % 8) * (G / 8) + bx / 8 : bx;
    const int NU = NB * NHEAD * 32;
    bool first = true;
    for (int u = vcu; u < NU; u += G) { attn_unit(P, lds, u, u + G < NU ? u + G : -1, first, lam, mshift, wave, Obase); first = false; }
    asm volatile("s_waitcnt vmcnt(0) lgkmcnt(0)" ::: "memory");
    __syncthreads();
}
}
namespace s5 {
using pg8::Unit; using pg8::f32x4; using pg8::u32x4;
typedef float f2 __attribute__((ext_vector_type(2)));
__device__ __forceinline__ f2 cmul(f2 a, f2 b) { return (f2){a.x * b.x - a.y * b.y, a.x * b.y + a.y * b.x}; }

template <int NDL>
__device__ __forceinline__ void stage2(const LAS f2* apow, const LAS f2* BB, const LAS f2* CC, LAS float* Mt, int d, int c, int cp) {
    float acc[NDL];
#pragma unroll
    for (int j = 0; j < NDL; ++j) acc[j] = 0.f;
#pragma unroll 2
    for (int p = 0; p < 64; ++p) {
        const f2 z = cmul(CC[(d * 64 + p) * 16 + c], BB[(d * 64 + p) * 16 + cp]);
        const LAS f2* ap = apow + (d * 64 + p) * 17;
#pragma unroll
        for (int j = 0; j < NDL; ++j) { const f2 a = ap[j]; acc[j] += z.x * a.x - z.y * a.y; }
    }
#pragma unroll
    for (int j = 0; j < NDL; ++j) Mt[((d * 16 + j) * 16 + c) * 16 + cp] = acc[j];
}
__device__ void build_tables(const Ptrs& P, LAS unsigned char* lds, int item, int tid) {
    const int g = item >> 3, qt = item & 7;
    LAS f2* apow = (LAS f2*)lds;
    LAS f2* BB = (LAS f2*)(lds + 17408);
    LAS f2* CC = (LAS f2*)(lds + 33792);
    LAS float* Mt = (LAS float*)(lds + 50176);
    {
        const int dp = tid & 127, cq = tid >> 7, d = dp >> 6, p = dp & 63, gi = (d * NGRP + g) * NST + p;
        const float lre = fminf(P.in[IN_ARE][gi], -1e-4f), lim = P.in[IN_AIM][gi], dt = __expf(P.in[IN_LOGDT][d * NGRP + g]);
        f2 a1; { const float mag = __expf(lre * dt); float sn, cs; sincosf(lim * dt, &sn, &cs); a1 = (f2){mag * cs, mag * sn}; }
        if (cq == 0) { f2 pw = (f2){1.f, 0.f};
            for (int n = 0; n <= 16; ++n) { apow[(d * 64 + p) * 17 + n] = pw; if (n == 16 && qt == 0) ((f2*)(P.ws + WS_A16))[(g * 2 + d) * 64 + p] = pw; pw = cmul(pw, a1); } }
        const float nr = a1.x - 1.f, ni = a1.y, den = lre * lre + lim * lim;
        const f2 fz = (f2){(nr * lre + ni * lim) / den, (ni * lre - nr * lim) / den};
#pragma unroll
        for (int cc = 0; cc < 4; ++cc) { const int c = 4 * cq + cc;
            BB[(d * 64 + p) * 16 + c] = cmul(fz, (f2){P.in[IN_BRE][(size_t)gi * 16 + c], P.in[IN_BIM][(size_t)gi * 16 + c]});
            CC[(d * 64 + p) * 16 + c] = (f2){P.in[IN_CRE][((size_t)(d * NGRP + g) * 16 + c) * NST + p], P.in[IN_CIM][((size_t)(d * NGRP + g) * 16 + c) * NST + p]};
        }
    }
    __syncthreads();
    {
        const int d = tid >> 8, c = (tid >> 4) & 15, cp = tid & 15;
        const int ndl = d == 0 ? 2 * qt + 2 : 16 - 2 * qt;
        switch (ndl >> 1) {
            case 1: stage2<2>(apow, BB, CC, Mt, d, c, cp); break;  case 2: stage2<4>(apow, BB, CC, Mt, d, c, cp); break;
            case 3: stage2<6>(apow, BB, CC, Mt, d, c, cp); break;  case 4: stage2<8>(apow, BB, CC, Mt, d, c, cp); break;
            case 5: stage2<10>(apow, BB, CC, Mt, d, c, cp); break; case 6: stage2<12>(apow, BB, CC, Mt, d, c, cp); break;
            case 7: stage2<14>(apow, BB, CC, Mt, d, c, cp); break; default: stage2<16>(apow, BB, CC, Mt, d, c, cp); break;
        }
    }
    __syncthreads();
    bf16_t* TQ = (bf16_t*)(P.ws + WS_TQ) + (size_t)g * 256 * 512;
    for (int e = tid; e < 32 * 64; e += 512) {
        const int row = qt * 32 + (e >> 6), K0 = (e & 63) * 8, tau = row >> 4, c = row & 15;
        float v[8];
        if (K0 < 256) { const int sg = K0 >> 4, cp0 = K0 & 15;
            const LAS float* m0p = tau > sg ? Mt + ((0 * 16 + (tau - sg)) * 16 + c) * 16 + cp0 : (tau < sg ? Mt + ((1 * 16 + (sg - tau)) * 16 + c) * 16 + cp0 : Mt + (0 * 16 * 16 + c) * 16 + cp0);
#pragma unroll
            for (int j = 0; j < 8; ++j) v[j] = m0p[j];
            if (tau == sg) { const LAS float* m1p = Mt + ((1 * 16) * 16 + c) * 16 + cp0;
#pragma unroll
                for (int j = 0; j < 8; ++j) v[j] += m1p[j]; }
        } else { const int r0 = K0 - 256, d = r0 >> 7, ri = (r0 >> 6) & 1, p0 = r0 & 63;
#pragma unroll
            for (int j = 0; j < 8; ++j) { const int p = p0 + j;
                const f2 t = cmul(CC[(d * 64 + p) * 16 + c], apow[(d * 64 + p) * 17 + (d == 0 ? tau + 1 : 16 - tau)]);
                v[j] = ri == 0 ? t.x : -t.y; } }
        u32x4 o; o.x = pg8::cvt_pk_bf16(v[0], v[1]); o.y = pg8::cvt_pk_bf16(v[2], v[3]); o.z = pg8::cvt_pk_bf16(v[4], v[5]); o.w = pg8::cvt_pk_bf16(v[6], v[7]);
        *(u32x4*)(TQ + (size_t)row * 512 + K0) = o;
    }
    bf16_t* PS = (bf16_t*)(P.ws + WS_PST) + (size_t)g * 256 * 256;
    for (int e = tid; e < 32 * 32; e += 512) {
        const int r = qt * 32 + (e >> 5), K0 = (e & 31) * 8, sg = K0 >> 4, cp0 = K0 & 15, d = r >> 7, ri = (r >> 6) & 1, p = r & 63;
        const f2 ap = apow[(d * 64 + p) * 17 + (d == 0 ? 15 - sg : sg)];
        float v[8];
#pragma unroll
        for (int j = 0; j < 8; ++j) { const f2 t = cmul(ap, BB[(d * 64 + p) * 16 + cp0 + j]); v[j] = ri == 0 ? t.x : t.y; }
        u32x4 o; o.x = pg8::cvt_pk_bf16(v[0], v[1]); o.y = pg8::cvt_pk_bf16(v[2], v[3]); o.z = pg8::cvt_pk_bf16(v[4], v[5]); o.w = pg8::cvt_pk_bf16(v[6], v[7]);
        *(u32x4*)(PS + (size_t)r * 256 + K0) = o;
    }
    __syncthreads();
}

struct SchedE { int bg, g; __device__ __forceinline__ bool next(int i, Unit& u) const { if (i >= 1) return false; u.arow = bg * NCH; u.brow = g * 256; u.pm = 0; u.pn = 0; return true; } };
struct EpiE {
    static constexpr bool PERM = true;
    float* Es;
    __device__ __forceinline__ void operator()(const f32x4 (&acc)[2][2][4][2], const Unit& u, int wr, int wc, int fr, int fq) const {
#pragma unroll
        for (int ai = 0; ai < 2; ++ai)
#pragma unroll
            for (int m = 0; m < 4; ++m) {
                const int j = 256 * u.pm + 128 * ai + 64 * wr + 16 * m + fr;
                if (j < NCH) {
#pragma unroll
                    for (int bj = 0; bj < 2; ++bj) { float* e = Es + (size_t)j * 256 + 128 * bj + 32 * wc + 8 * fq; *(f32x4*)e = acc[ai][bj][m][0]; *(f32x4*)(e + 4) = acc[ai][bj][m][1]; }
                }
            }
    }
};
struct EpiY {
    static constexpr bool PERM = true;
    const Ptrs* Pp; int b, g;
    __device__ __forceinline__ void operator()(const f32x4 (&acc)[2][2][4][2], const Unit& u, int wr, int wc, int fr, int fq) const {
        const Ptrs& P = *Pp;
        const int c0 = 8 * (fq & 1);
        const f32x4 d0 = *(const f32x4*)(P.in[IN_S5D] + g * 16 + c0), d1 = *(const f32x4*)(P.in[IN_S5D] + g * 16 + c0 + 4);
#pragma unroll
        for (int ai = 0; ai < 2; ++ai)
#pragma unroll
            for (int m = 0; m < 4; ++m) {
                const int j = 128 * ai + 64 * wr + 16 * m + fr;
#pragma unroll
                for (int bj = 0; bj < 2; ++bj) {
                    const int tau = 8 * bj + 2 * wc + (fq >> 1);
                    const u32x4 uu = *(const u32x4*)((const bf16_t*)(P.ws + WS_RU) + u_idx(b, g, j, tau, c0));
                    f32x4 y0 = acc[ai][bj][m][0] + d0 * og::unpk_lo(uu), y1 = acc[ai][bj][m][1] + d1 * og::unpk_hi(uu);
                    { const f32x4 z0 = y0 * (y0 * y0 * -0.10294324f + -2.3022082f), z1 = y1 * (y1 * y1 * -0.10294324f + -2.3022082f);
                      const f32x4 e0 = (f32x4){__builtin_amdgcn_exp2f(z0[0]), __builtin_amdgcn_exp2f(z0[1]), __builtin_amdgcn_exp2f(z0[2]), __builtin_amdgcn_exp2f(z0[3])} + 1.f;
                      const f32x4 e1 = (f32x4){__builtin_amdgcn_exp2f(z1[0]), __builtin_amdgcn_exp2f(z1[1]), __builtin_amdgcn_exp2f(z1[2]), __builtin_amdgcn_exp2f(z1[3])} + 1.f;
                      y0 = y0 * (f32x4){__builtin_amdgcn_rcpf(e0[0]), __builtin_amdgcn_rcpf(e0[1]), __builtin_amdgcn_rcpf(e0[2]), __builtin_amdgcn_rcpf(e0[3])};
                      y1 = y1 * (f32x4){__builtin_amdgcn_rcpf(e1[0]), __builtin_amdgcn_rcpf(e1[1]), __builtin_amdgcn_rcpf(e1[2]), __builtin_amdgcn_rcpf(e1[3])}; }
                    *(u32x4*)((bf16_t*)(P.ws + WS_HS) + ((size_t)(b * SEQL + 16 * j + tau)) * S5W + g * 16 + c0) = og::pack8(y0, y1);
                }
            }
    }
};
__device__ __forceinline__ void scan(const Ptrs& P, int bg, int g, const float* Es, int tid) {
    if (tid >= 128) return;
    const int d = tid >> 6, p = tid & 63;
    const f2 a16 = ((const f2*)(P.ws + WS_A16))[(g * 2 + d) * 64 + p];
    const float ar = a16.x, ai = a16.y;
    const float* er = Es + d * 128 + p;
    float sr = 0.f, si = 0.f;
    {   float cx[16], cy[16];
#pragma unroll
        for (int k = 0; k < 16; ++k) { const int j = d == 0 ? 256 + k : 271 - k; cx[k] = er[(size_t)j * 256]; cy[k] = er[(size_t)j * 256 + 64]; }
#pragma unroll
        for (int k = 0; k < 16; ++k) { const float nr = ar * sr - ai * si + cx[k], ni = ar * si + ai * sr + cy[k]; sr = nr; si = ni; } }
    const long estep = d == 0 ? 256 : -256;
    const long ustep = d == 0 ? 512 : -512;
    const float* e = er + (size_t)(d == 0 ? 0 : 255) * 256;
    bf16_t* u = (bf16_t*)(P.ws + WS_RU) + (size_t)bg * NCH * 512 + 256 + d * 128 + p + (size_t)(d == 0 ? 0 : 255) * 512;
    float xa[16], ya[16], xb[16], yb[16];
#pragma unroll
    for (int k = 0; k < 16; ++k) { xa[k] = e[k * estep]; ya[k] = e[k * estep + 64]; }
#define S5_STEP(X, Y) do { const unsigned pk = pg8::cvt_pk_bf16(sr, si); u[0] = (bf16_t)(pk & 0xffffu); u[64] = (bf16_t)(pk >> 16); u += ustep; \
        const float nr = __builtin_fmaf(ar, sr, __builtin_fmaf(-ai, si, X)), ni = __builtin_fmaf(ar, si, __builtin_fmaf(ai, sr, Y)); sr = nr; si = ni; \
        asm volatile("" : "+v"(sr), "+v"(si)); } while (0)
#pragma unroll 1
    for (int k0 = 0; k0 < 256; k0 += 32) {
        e += 16 * estep;
#pragma unroll
        for (int k = 0; k < 16; ++k) { xb[k] = e[k * estep]; yb[k] = e[k * estep + 64]; }
#pragma unroll
        for (int k = 0; k < 16; ++k) S5_STEP(xa[k], ya[k]);
        e += 16 * estep;
        if (k0 + 32 < 256) {
#pragma unroll
            for (int k = 0; k < 16; ++k) { xa[k] = e[k * estep]; ya[k] = e[k * estep + 64]; }
        }
#pragma unroll
        for (int k = 0; k < 16; ++k) S5_STEP(xb[k], yb[k]);
    }
#undef S5_STEP
}
__device__ __forceinline__ void ctx_states(const Ptrs& P, int bg, int g, float* Es, int wave, int lane) {
    typedef short bf16x8 __attribute__((ext_vector_type(8)));
    const int i16 = lane & 15, kq = lane >> 4;
    const bf16_t* Ua = (const bf16_t*)(P.ws + WS_RU) + ((size_t)bg * NCH + 256 + i16) * 512 + 8 * kq;
    bf16x8 af[8];
#pragma unroll
    for (int ks = 0; ks < 8; ++ks) af[ks] = *(const bf16x8*)(Ua + 32 * ks);
#pragma unroll
    for (int q = 0; q < 2; ++q) {
        const int nt = 2 * wave + q;
        const bf16_t* Pb = (const bf16_t*)(P.ws + WS_PST) + ((size_t)g * 256 + 16 * nt + i16) * 256 + 8 * kq;
        f32x4 acc = (f32x4){0.f, 0.f, 0.f, 0.f};
#pragma unroll
        for (int ks = 0; ks < 8; ++ks) acc = __builtin_amdgcn_mfma_f32_16x16x32_bf16(af[ks], *(const bf16x8*)(Pb + 32 * ks), acc, 0, 0, 0);
#pragma unroll
        for (int reg = 0; reg < 4; ++reg) Es[(size_t)(256 + 4 * kq + reg) * 256 + 16 * nt + i16] = acc[reg];
    }
}
__device__ __forceinline__ void s5_item(const Ptrs& P, LAS unsigned char* ring, int bg, int wave) {
    const int b = bg / NGRP, g = bg % NGRP;
    float* Es = (float*)(P.ws + WS_RH) + (size_t)bg * NCH * 256;
    const bf16_t* U = (const bf16_t*)(P.ws + WS_RU);
    { int l_ = lane_id(); asm volatile("" : "+v"(l_)); ctx_states(P, bg, g, Es, wave, l_); }
    { const pg8::Gemm g1{U, (const bf16_t*)(P.ws + WS_PST), 256, 512, 256};
      pg8::gemm_phase<EpiE, SchedE, false, 0>(ring, g1, SchedE{bg, g}, EpiE{Es}, wave); }
    asm volatile("s_waitcnt vmcnt(0)" ::: "memory"); __syncthreads();
    { int t_ = wave * 64 + lane_id(); asm volatile("" : "+v"(t_)); scan(P, bg, g, Es, t_); }
    asm volatile("s_waitcnt vmcnt(0)" ::: "memory"); __syncthreads();
    { const pg8::Gemm g2{U, (const bf16_t*)(P.ws + WS_TQ), 512, 512, 512};
      og::SchedOne so; so.v.arow = bg * NCH; so.v.brow = g * 256; so.v.pm = 0; so.v.pn = 0;
      pg8::gemm_phase<EpiY, og::SchedOne, false, 0>(ring, g2, so, EpiY{&P, b, g}, wave); }
}
}
namespace p0 {
typedef float f32x4 __attribute__((ext_vector_type(4)));
typedef unsigned u32x2 __attribute__((ext_vector_type(2)));
__device__ __forceinline__ void mod_item(const Ptrs& P, LAS unsigned char* lds, int item, int half, int vt) {
    const int ct = item % 24, ks = item / 24, col = ct * 256 + vt, k0 = ks * 64;
    const float* W = P.in[IN_ADAW] + (size_t)k0 * 6144 + col;
    LAS float* sl = (LAS float*)(lds + 90112 + half * 2048);
    for (int e = vt; e < 320; e += 256) { const int r = e >> 6, k = e & 63; const float c = r < 4 ? P.in[IN_C][r * DM + k0 + k] : P.in[IN_CCTX][k0 + k];
        sl[e] = c * __builtin_amdgcn_rcpf(1.f + __builtin_amdgcn_exp2f(-1.4426950408889634f * c)); }
    __syncthreads();
    float acc[5] = {0.f, 0.f, 0.f, 0.f, 0.f};
#pragma unroll 1
    for (int kb = 0; kb < 64; kb += 16) {
    float wv[16];
#pragma unroll
    for (int k = 0; k < 16; ++k) wv[k] = __builtin_nontemporal_load(W + (size_t)(kb + k) * 6144);
#pragma unroll
    for (int kk = 0; kk < 16; ++kk) {
        const float w = wv[kk];
#pragma unroll
        for (int r = 0; r < 5; ++r) acc[r] += sl[r * 64 + kb + kk] * w;
    }
    }
    float* mod = (float*)(P.ws + WS_MODFIN);
#pragma unroll
    for (int r = 0; r < 5; ++r) atomicAdd(mod + r * 6144 + col, acc[r] + (ks == 0 ? P.in[IN_ADAB][col] : 0.f));
    __syncthreads();
}
__device__ __forceinline__ void biasup_item(const Ptrs& P, int item, int vt) {
    const int ct = item % 22, ks = item / 22, n = ct * 256 + vt, k0 = ks * 64;
    const float* W = P.in[IN_WUP] + (size_t)k0 * NIN + n;
    const float* mod = (const float*)(P.ws + WS_MODFIN) + 3072 + k0;
    float acc[4] = {0.f, 0.f, 0.f, 0.f};
#pragma unroll 1
    for (int kb = 0; kb < 64; kb += 16) {
    float wv[16];
#pragma unroll
    for (int k = 0; k < 16; ++k) wv[k] = __builtin_nontemporal_load(W + (size_t)(kb + k) * NIN);
#pragma unroll
    for (int kk = 0; kk < 16; ++kk) {
        const int k = kb + kk; const float w = wv[kk];
#pragma unroll
        for (int b = 0; b < 4; ++b) acc[b] += mod[b * 6144 + k] * w;
    }
    }
#pragma unroll
    for (int b = 0; b < 4; ++b) atomicAdd((float*)(P.ws + WS_BIASUP) + b * NIN + n, acc[b]);
}
__device__ __forceinline__ void modulate_row(const Ptrs& P, int r, int lane) {
    const float* xr = r < MR ? P.in[IN_X] + (size_t)r * DM : P.in[IN_CTX] + (size_t)(r - MR) * DM;
    const float* mod = (const float*)(P.ws + WS_MODFIN) + (r < MR ? r / SEQL : 4) * 6144;
    f32x4 v[4]; float ss = 0.f;
#pragma unroll
    for (int j = 0; j < 4; ++j) { v[j] = __builtin_nontemporal_load((const f32x4*)(xr + 256 * j + 4 * lane)); ss += (v[j][0] * v[j][0] + v[j][1] * v[j][1]) + (v[j][2] * v[j][2] + v[j][3] * v[j][3]); }
    const float rstd = __builtin_amdgcn_rsqf(wave_sum(ss) * (1.f / DM) + EPSN);
    bf16_t* H = (bf16_t*)(P.ws + WS_RH) + (size_t)r * DM;
#pragma unroll
    for (int j = 0; j < 4; ++j) { const int k = 256 * j + 4 * lane;
        const f32x4 w = *(const f32x4*)(P.in[IN_N1W] + k), sc = *(const f32x4*)(mod + 1024 + k), sh = *(const f32x4*)(mod + k);
        const f32x4 y = v[j] * rstd * w * (sc + 1.f) + sh;
        u32x2 o; o.x = pg8::cvt_pk_bf16(y[0], y[1]); o.y = pg8::cvt_pk_bf16(y[2], y[3]);
        *(u32x2*)(H + k) = o; }
}
__device__ __forceinline__ void modulate_rows(const Ptrs& P, int gw, int NGW, int lane) {
    const int per = (MT + NGW - 1) / NGW;
    int r = gw * per; const int rend = r + per < MT ? r + per : MT;
    if (r >= rend) return;
    f32x4 A[4], B[4], v[4], nv[4]; int curb = -1;
    { const float* xr = r < MR ? P.in[IN_X] + (size_t)r * DM : P.in[IN_CTX] + (size_t)(r - MR) * DM;
#pragma unroll
      for (int j = 0; j < 4; ++j) v[j] = __builtin_nontemporal_load((const f32x4*)(xr + 256 * j + 4 * lane)); }
#pragma unroll 1
    for (; r < rend; ++r) {
        if (r + 1 < rend) { const int rn = r + 1; const float* xr = rn < MR ? P.in[IN_X] + (size_t)rn * DM : P.in[IN_CTX] + (size_t)(rn - MR) * DM;
#pragma unroll
            for (int j = 0; j < 4; ++j) nv[j] = __builtin_nontemporal_load((const f32x4*)(xr + 256 * j + 4 * lane)); }
        const int b = r < MR ? r / SEQL : 4;
        if (b != curb) { curb = b; const float* mod = (const float*)(P.ws + WS_MODFIN) + b * 6144;
#pragma unroll
            for (int j = 0; j < 4; ++j) { const int k = 256 * j + 4 * lane; A[j] = *(const f32x4*)(P.in[IN_N1W] + k) * (*(const f32x4*)(mod + 1024 + k) + 1.f); B[j] = *(const f32x4*)(mod + k); } }
        float ss = 0.f;
#pragma unroll
        for (int j = 0; j < 4; ++j) ss += (v[j][0] * v[j][0] + v[j][1] * v[j][1]) + (v[j][2] * v[j][2] + v[j][3] * v[j][3]);
        const float rstd = __builtin_amdgcn_rsqf(wave_sum(ss) * (1.f / DM) + EPSN);
        bf16_t* H = (bf16_t*)(P.ws + WS_RH) + (size_t)r * DM;
#pragma unroll
        for (int j = 0; j < 4; ++j) { const int k = 256 * j + 4 * lane;
            const f32x4 y = v[j] * rstd * A[j] + B[j];
            u32x2 o; o.x = pg8::cvt_pk_bf16(y[0], y[1]); o.y = pg8::cvt_pk_bf16(y[2], y[3]);
            *(u32x2*)(H + k) = o; }
#pragma unroll
        for (int j = 0; j < 4; ++j) v[j] = nv[j];
    }
}
}

#define XB_TMO      128
#define XB_XCNT(j)  (256  + 64 * (j))
#define XB_XSUB(j)  (1280 + 64 * (j))
#define XB_XGEN(j)  (2304 + 64 * (j))
#define XB_TOP      3328
#define XB_TOPGEN   3392
#define XCD_BAR_WORDS 3456
#define XB_SPIN_CAP (1u << 22)
constexpr int CW_BAR = 4096;

__device__ __forceinline__ unsigned xb_ld(unsigned* p)              { return __hip_atomic_load(p, __ATOMIC_RELAXED, __HIP_MEMORY_SCOPE_AGENT); }
__device__ __forceinline__ unsigned xb_add(unsigned* p, unsigned v) { return __hip_atomic_fetch_add(p, v, __ATOMIC_RELAXED, __HIP_MEMORY_SCOPE_AGENT); }
__device__ __forceinline__ unsigned xb_xcc_id() { return (unsigned)__builtin_amdgcn_s_getreg((3 << 11) | 20) & 0xFu; }
#define XB_SPIN(cond, bar) do { unsigned _sp = 0; while (cond) { __builtin_amdgcn_s_sleep(1); \
    if ((++_sp & 255u) == 0u) { if (xb_ld(&(bar)[XB_TMO])) break; if (_sp > XB_SPIN_CAP) { atomicAdd(&(bar)[XB_TMO], 1u); break; } } } } while (0)
struct XcdBarrier { unsigned* bar; unsigned x; volatile LAS unsigned* st; };
__device__ __forceinline__ XcdBarrier xcd_barrier_post(unsigned* bar, volatile LAS unsigned* st, int tid) {
    XcdBarrier b; b.bar = bar; b.x = xb_xcc_id(); b.st = st;
    if (tid == 0) (void)xb_add(&bar[XB_XCNT(b.x)], 1u);
    return b;
}
__device__ __forceinline__ void xcd_barrier_complete(unsigned* bar, unsigned x, unsigned& nloc, unsigned& nx) {
    const unsigned G = gridDim.x * gridDim.y * gridDim.z;
    unsigned sum, cnt, mine, sp = 0u;
    for (;;) {
        sum = 0u; cnt = 0u; mine = 0u;
#pragma unroll
        for (unsigned j = 0; j < 16; ++j) { const unsigned c = xb_ld(&bar[XB_XCNT(j)]); sum += c; cnt += (c > 0u) ? 1u : 0u; mine = (j == x) ? c : mine; }
        if (sum == G) break;
        __builtin_amdgcn_s_sleep(1);
        if ((++sp & 255u) == 0u) { if (xb_ld(&bar[XB_TMO])) break; if (sp > XB_SPIN_CAP) { atomicAdd(&bar[XB_TMO], 1u); break; } }
    }
    nloc = mine > 0u ? mine : 1u; nx = cnt > 0u ? cnt : 1u;
}
__device__ __forceinline__ void xcd_barrier(const XcdBarrier& b, int wave) {
    const int tid0 = wave * 64 + lane_id();
    asm volatile("s_waitcnt vmcnt(0)" ::: "memory");
    __syncthreads();
    if (tid0 == 0) {
        unsigned* bar = b.bar;
        __builtin_amdgcn_s_waitcnt(0);
        unsigned nloc = b.st[0], nx = b.st[1];
        if (nloc == 0u) { xcd_barrier_complete(bar, b.x, nloc, nx); b.st[0] = nloc; b.st[1] = nx; }
        const unsigned old = xb_add(&bar[XB_XSUB(b.x)], 1u);
        const unsigned gen = old / nloc;
        if (old + 1u == (gen + 1u) * nloc) {
            __builtin_amdgcn_fence(__ATOMIC_RELEASE, "agent");
            asm volatile("s_waitcnt vmcnt(0)" ::: "memory");
            const unsigned og = xb_add(&bar[XB_TOP], 1u);
            const unsigned tg = og / nx;
            if (og + 1u == (tg + 1u) * nx) xb_add(&bar[XB_TOPGEN], 1u);
            else XB_SPIN(xb_ld(&bar[XB_TOPGEN]) == tg, bar);
            xb_add(&bar[XB_XGEN(b.x)], 1u);
            __builtin_amdgcn_fence(__ATOMIC_ACQUIRE, "agent");
            asm volatile("s_waitcnt vmcnt(0)" ::: "memory");
        } else {
            XB_SPIN(xb_ld(&bar[XB_XGEN(b.x)]) == gen, bar);
            __builtin_amdgcn_fence(__ATOMIC_ACQUIRE, "agent");
            asm volatile("s_waitcnt vmcnt(0)" ::: "memory");
        }
    }
    __syncthreads();
}

#ifndef OPT_GEMM
#define OPT_GEMM 1
#endif
#ifndef OPT_P1
#define OPT_P1 1
#endif
#ifndef OPT_P3
#define OPT_P3 1
#endif
#ifndef OPT_P4
#define OPT_P4 1
#endif
#ifndef OPT_ATTN
#define OPT_ATTN 1
#endif
#ifndef OPT_S5
#define OPT_S5 1
#endif
#ifndef OPT_P0
#define OPT_P0 1
#endif
#ifndef REP_P1
#define REP_P1 0
#endif
#ifndef REP_P4
#define REP_P4 0
#endif
#ifndef REP_S5
#define REP_S5 0
#endif
#ifndef REP_ATTN
#define REP_ATTN 0
#endif
#ifndef REP_BAR
#define REP_BAR 0
#endif
#ifndef REP_P3
#define REP_P3 0
#endif
#ifndef REP_P0
#define REP_P0 0
#endif
#ifndef USE_COOP_LAUNCH
#define USE_COOP_LAUNCH 1
#endif
#ifndef OPT_P5
#define OPT_P5 1
#endif
constexpr int LDS_BYTES = 147456;
constexpr int LDS_MISC = LDS_BYTES - 512;
struct Args { Ptrs P; int ph_lo, ph_hi; };

#define PADNOPS(n) asm volatile(".rept %0\n\ts_nop 0\n\t.endr" :: "i"(n))
__global__ void __launch_bounds__(512, 2) mega(Args a) {
    extern __shared__ __attribute__((aligned(16))) unsigned char lds[];
    const Ptrs& P = a.P;
    PADNOPS(PAD_ENTRY);
    const int wave = __builtin_amdgcn_readfirstlane(threadIdx.x >> 6);
    const int lane = lane_id(), tid = wave * 64 + lane, half = tid >> 8, vt = tid & 255;
    const int G = gridDim.x, bx = blockIdx.x;
    if (tid < 128) ((LAS unsigned*)(lds + LDS_MISC))[tid] = 0u;
    __syncthreads();
    XcdBarrier bar = xcd_barrier_post((unsigned*)(P.ws + WS_CTL) + CW_BAR, (volatile LAS unsigned*)(lds + LDS_MISC) + 8, tid);
    char* lh = (char*)lds + half * NB_LDS;
    const int lo = a.ph_lo, hi = a.ph_hi;
#define IN(k) (lo <= (k) && (k) < hi)
#define SEAM(k) do { if (IN(k) && IN((k) + 1)) xcd_barrier(bar, wave); } while (0)
#define VB2(NV) for (int v_ = 2 * bx + half; v_ < (NV); v_ += 2 * G)

    LAS unsigned char* ring = (LAS unsigned char*)lds;
#if REP_P0
    {
    if (IN(0)) {
#if OPT_P0
        VB2(24 * 16) p0::mod_item(P, ring, v_, half, vt);
#else
        VB2(120) nb_mod(P, v_ % 24, v_ / 24, vt);
#endif
        VB2(4) nb_rope(P, v_, vt);
        for (int i = bx * 512 + tid; i < MR + 512; i += G * 512) ((float*)(P.ws + WS_ROWSQ0))[i] = 0.f;
#if OPT_S5
        for (int it = bx; it < NGRP * 8; it += G) s5::build_tables(P, ring, it, tid);
#endif
#if OPT_GEMM
        og::transposes_A(P, ring, bx * 8 + wave, G * 8, wave, lane);
#endif
    }
    xcd_barrier(bar, wave);
    if (IN(1)) {
#if OPT_P0
        for (int r = bx * 8 + wave; r < MT; r += G * 8) p0::modulate_row(P, r, lane);
#else
        VB2(88) nb_biasup(P, v_ % 22, v_ / 22, vt);
        VB2(MT / 4) nb_modulate(P, v_, vt);
#endif
    }
    xcd_barrier(bar, wave);
    for (int i = bx * 512 + tid; i < (int)((768 * 1024 - 512 * 1024) / 4); i += G * 512) ((float*)(P.ws + WS_MODFIN))[i] = 0.f;
    xcd_barrier(bar, wave);
    }
#endif
    if (IN(0)) {
#if OPT_P0
        VB2(24 * 16) p0::mod_item(P, ring, v_, half, vt);
#else
        VB2(120) nb_mod(P, v_ % 24, v_ / 24, vt);
#endif
        VB2(4) nb_rope(P, v_, vt);
        for (int i = bx * 512 + tid; i < MR + 512; i += G * 512) ((float*)(P.ws + WS_ROWSQ0))[i] = 0.f;
#if OPT_S5
        for (int it = bx; it < NGRP * 8; it += G) s5::build_tables(P, ring, it, tid);
#endif
#if OPT_GEMM
        og::transposes_A(P, ring, bx * 8 + wave, G * 8, wave, lane);
#endif
    }
    SEAM(0);
    if (IN(1)) {
#if OPT_P0
        p0::modulate_rows(P, bx * 8 + wave, G * 8, lane);
#else
        VB2(88) nb_biasup(P, v_ % 22, v_ / 22, vt);
        VB2(MT / 4) nb_modulate(P, v_, vt);
#endif
    }
    SEAM(1);
    if (IN(2)) {
#if OPT_GEMM && OPT_P1
        { const pg8::Gemm g{(const bf16_t*)(P.ws + WS_RH), (const bf16_t*)(P.ws + WS_WIN), DM, DM, DM};
          for (int rep_ = 0; rep_ < 1 + REP_P1; ++rep_) pg8::gemm_phase<og::EpiIn, og::SchedIn, true, 0>(ring, g, og::SchedIn{G, bx}, og::EpiIn{&P}, wave); }
        {
            const int nshort = G - (1448 % G), first_short = 1448 % G;
            if (first_short == 0) { for (int v_ = 2 * bx + half; v_ < 22 * 16; v_ += 2 * G) p0::biasup_item(P, v_, vt); }
            else if (bx >= first_short) { for (int v_ = 2 * (bx - first_short) + half; v_ < 22 * 16; v_ += 2 * nshort) p0::biasup_item(P, v_, vt); }
            if (first_short == 0) og::transposes_B(P, ring, bx * 8 + wave, G * 8, wave, lane);
            else if (bx >= first_short) og::transposes_B(P, ring, (bx - first_short) * 8 + wave, nshort * 8, wave, lane);
        }
#else
        VB2((NIN / 64) * (MT / 64)) nb_inproj(P, v_ % (NIN / 64), v_ / (NIN / 64), vt, lh);
#endif
    }
#if REP_BAR
    for (int rb_ = 0; rb_ < 10; ++rb_) xcd_barrier(bar, wave);
#endif
    SEAM(2);
    if (IN(3)) {
#if OPT_GEMM
        og::build_convtab(P, bx * 512 + tid);
#endif
#if OPT_ATTN
#if REP_ATTN
        at::attn_phase(P, ring, G, bx, wave, (bf16_t*)(P.ws + WS_RH)); xcd_barrier(bar, wave);
#endif
        at::attn_phase(P, ring, G, bx, wave, (bf16_t*)(P.ws + WS_RQ));
#else
        if (wave < 4) for (int it = 4 * bx + wave; it < NB * NHEAD * SEQL; it += 4 * G) nb_attn(P, it, lane, (char*)lds + wave * 35328);
#endif
#if OPT_S5
        xcd_barrier(bar, wave);
        PADNOPS(PAD_WIN);
        {
            const int nS = NB * NGRP;
            const pg8::Gemm gya{(const bf16_t*)(P.ws + WS_RQ), (const bf16_t*)(P.ws + WS_WBA), DM, DM, DM};
            if (G > nS) {
                if (bx < nS) { for (int rep_ = 0; rep_ < 1 + REP_S5; ++rep_) s5::s5_item(P, ring, bx, wave); }
                else { PADNOPS(PAD_YA); pg8::gemm_phase<og::EpiBranch<0, 1024>, og::SchedMN, true, 0>(ring, gya, og::SchedMN{64, 4, G - nS, bx - nS}, og::EpiBranch<0, 1024>{&P}, wave); }
            } else {
                for (int it = bx; it < nS; it += G) s5::s5_item(P, ring, it, wave);
                pg8::gemm_phase<og::EpiBranch<0, 1024>, og::SchedMN, true, 0>(ring, gya, og::SchedMN{64, 4, G, bx}, og::EpiBranch<0, 1024>{&P}, wave);
            }
        }
#else
        xcd_barrier(bar, wave);
        for (int it = 8 * bx + wave; it < NB * NGRP * 2; it += 8 * G) nb_s5(P, it, lane);
        xcd_barrier(bar, wave);
        VB2(MR * S5W / 256) nb_s5fin(P, v_, vt);
#endif
    }
    SEAM(3);
    if (IN(4)) {
        PADNOPS(PAD_P3A);
#if OPT_GEMM && OPT_P3
        { const pg8::Gemm g{(const bf16_t*)(P.ws + WS_HS), (const bf16_t*)(P.ws + WS_WGLU), S5W, S5W, S5W};
          for (int rep_ = 0; rep_ < 1 + REP_P3; ++rep_) pg8::gemm_phase<og::EpiGlu, og::SchedMN, true, 0>(ring, g, og::SchedMN{64, 2, G, bx}, og::EpiGlu{&P}, wave);
          if (G > 128) { if (bx >= 128) og::transposes_C(P, ring, (bx - 128) * 8 + wave, (G - 128) * 8, wave, lane); }
          else og::transposes_C(P, ring, bx * 8 + wave, G * 8, wave, lane); }
#else
        VB2((S5W / 64) * (MR / 64)) nb_glu(P, v_ % (S5W / 64), v_ / (S5W / 64), vt, lh);
#endif
    }
    SEAM(4);
    if (IN(5)) {
        PADNOPS(PAD_P3B);
#if OPT_GEMM && OPT_P3
        { const pg8::Gemm g{(const bf16_t*)(P.ws + WS_HS2), (const bf16_t*)(P.ws + WS_WBS), S5W, S5W, S5W};
          pg8::gemm_phase<og::EpiBranch<1, 0>, og::SchedMN, true, 0>(ring, g, og::SchedMN{64, 4, G, bx}, og::EpiBranch<1, 0>{&P}, wave); }
#else
        VB2((DM / 64) * (MR / 64)) nb_ys(P, v_ % (DM / 64), v_ / (DM / 64), vt, lh);
        xcd_barrier(bar, wave);
        VB2((DM / 64) * (MR / 64)) nb_ya(P, v_ % (DM / 64), v_ / (DM / 64), vt, lh);
#endif
    }
    SEAM(5);
    if (IN(6)) {
        PADNOPS(PAD_P3C);
#if OPT_GEMM && OPT_P3
        { const pg8::Gemm g{(const bf16_t*)(P.ws + WS_MB), (const bf16_t*)(P.ws + WS_WOUT), DM, DM, DM};
          pg8::gemm_phase<og::EpiOut, og::SchedMN, true, 0>(ring, g, og::SchedMN{64, 4, G, bx}, og::EpiOut{&P}, wave); }
#else
        VB2((DM / 64) * (MR / 64)) nb_out(P, v_ % (DM / 64), v_ / (DM / 64), vt, lh);
#endif
    }
    SEAM(6);
    if (IN(7)) {
        PADNOPS(PAD_P4);
#if OPT_GEMM && OPT_P4
        { const pg8::Gemm g{(const bf16_t*)(P.ws + WS_X1B), (const bf16_t*)(P.ws + WS_WUP), DM, DM, DM};
          for (int rep_ = 0; rep_ < 1 + REP_P4; ++rep_) pg8::gemm_phase<og::EpiUp, og::SchedUp, true, 2, 1>(ring, g, og::SchedUp{G, bx}, og::EpiUp{&P}, wave);
          { const int first_short = (68 * 22) % G, nshort = G - first_short;
            if (first_short == 0) og::transposes_D(P, ring, bx * 8 + wave, G * 8, wave, lane);
            else if (bx >= first_short) og::transposes_D(P, ring, (bx - first_short) * 8 + wave, nshort * 8, wave, lane); } }
#else
        VB2((DFF / 64) * (NB * 67)) nb_up(P, v_ % (DFF / 64), v_ / (DFF / 64), vt, lh);
#endif
    }
    SEAM(7);
    if (IN(8)) {
        PADNOPS(PAD_P5);
#if OPT_GEMM && OPT_P5
        { const pg8::Gemm g{(const bf16_t*)(P.ws + WS_ACT), (const bf16_t*)(P.ws + WS_WDOWN), DFF, DFF, DFF};
          pg8::gemm_phase<og::EpiDown, og::SchedMN, true, 0>(ring, g, og::SchedMN{64, 4, G, bx}, og::EpiDown{&P}, wave); }
#else
        VB2((DM / 64) * (MR / 64)) nb_down(P, v_ % (DM / 64), v_ / (DM / 64), vt, lh);
#endif
    }
#undef IN
#undef SEAM
#undef VB2
}

extern "C" void kernel_launch(void* const* d_in, const int* in_sizes, int n_in, void* d_out, int out_size, void* d_ws, size_t ws_size, hipStream_t stream) {
    static int grid = 0;
    if (grid == 0) {
        if (n_in != 34 || ws_size < WS_END) { fprintf(stderr, "kernel_launch: unexpected inputs (n_in %d, ws %zu)\n", n_in, ws_size); grid = -1; return; }
        int dev = 0, cus = 0, per_cu = 0;
        if (hipGetDevice(&dev) != hipSuccess || hipDeviceGetAttribute(&cus, hipDeviceAttributeMultiprocessorCount, dev) != hipSuccess) { grid = -1; return; }
        if (hipFuncSetAttribute((const void*)mega, hipFuncAttributeMaxDynamicSharedMemorySize, LDS_BYTES) != hipSuccess) { fprintf(stderr, "kernel_launch: hipFuncSetAttribute failed\n"); grid = -1; return; }
        if (hipOccupancyMaxActiveBlocksPerMultiprocessor(&per_cu, (const void*)mega, 512, LDS_BYTES) != hipSuccess || per_cu < 1) { fprintf(stderr, "kernel_launch: occupancy query says %d\n", per_cu); (void)hipGetLastError(); per_cu = 1; }
        grid = cus;
    }
    if (grid < 0) return;
    (void)hipMemsetAsync((char*)d_ws + WS_CTL, 0, 1 * MiB, stream);
    Args a{};
    for (int i = 0; i < 34; ++i) a.P.in[i] = (const float*)d_in[i];
    a.P.out = (float*)d_out; a.P.ws = (unsigned char*)d_ws;
    a.ph_lo = 0; a.ph_hi = 9;
#if USE_COOP_LAUNCH
    void* args[] = {&a};
    hipError_t e = hipLaunchCooperativeKernel((const void*)mega, dim3(grid), dim3(512), args, LDS_BYTES, stream);
    if (e != hipSuccess) fprintf(stderr, "kernel_launch: cooperative launch failed: %s (grid %d)\n", hipGetErrorString(e), grid);
#else
    hipLaunchKernelGGL(mega, dim3(grid), dim3(512), LDS_BYTES, stream, a);
    const hipError_t e = hipPeekAtLastError();
    if (e != hipSuccess) fprintf(stderr, "kernel_launch: launch failed: %s (grid %d)\n", hipGetErrorString(e), grid);
#endif
}
```
